# Optimizing an MI355X kernel written in HIP

```python
import jax, jax.numpy as jnp
from jax import lax
import numpy as np

D_MODEL = 2048
BATCH = 16
SEQ = 2048
DEPTH = 4

MEM_LEN = 256
EPS = 1e-6

ATTN_HEAD_DIM = 64
ATTN_Q_HEADS = D_MODEL // 128
ATTN_KV_HEADS = ATTN_Q_HEADS // 4
ATTN_Q_DIM = ATTN_Q_HEADS * ATTN_HEAD_DIM
ATTN_KV_DIM = ATTN_KV_HEADS * ATTN_HEAD_DIM
WINDOW = 128

SGU_CHUNK = 128
SGU_GROUP_DIM = 128
SGU_GROUPS = D_MODEL // 256
SGU_WIDTH = SGU_GROUPS * SGU_GROUP_DIM

HGRN_HEAD_DIM = 128
HGRN_HEADS = D_MODEL // 256
HGRN_WIDTH = HGRN_HEADS * HGRN_HEAD_DIM
HGRN_CHUNK = 64

X_HEADS = 4
X_HEAD_DIM = 128
X_DIM = X_HEADS * X_HEAD_DIM

D_FF = -(-8 * D_MODEL // (3 * 256)) * 256

IN_SIZES = (ATTN_Q_DIM, ATTN_KV_DIM, ATTN_KV_DIM, SGU_WIDTH, SGU_WIDTH,
            HGRN_WIDTH, HGRN_WIDTH, HGRN_WIDTH, HGRN_WIDTH)
IN_WIDTH = sum(IN_SIZES)
N_BRANCH = 3

kernel_name = 'hybrid_swa_sgu_hgrn2_gated_trunk'


def _split_points():
    pts, acc = [], 0
    for s in IN_SIZES[:-1]:
        acc += s
        pts.append(acc)
    return pts


def rms_norm(x, g):
    xf = x.astype(jnp.float32)
    y = xf * lax.rsqrt(jnp.mean(xf * xf, axis=-1, keepdims=True) + EPS)
    return (y * g.astype(jnp.float32)).astype(x.dtype)


def layer_norm(x, g, b):
    xf = x.astype(jnp.float32)
    mu = jnp.mean(xf, axis=-1, keepdims=True)
    xc = xf - mu
    y = xc * lax.rsqrt(jnp.mean(xc * xc, axis=-1, keepdims=True) + EPS)
    return (y * g.astype(jnp.float32) + b.astype(jnp.float32)).astype(x.dtype)


def sliding_window_attention(q, k, v, sinks):
    B, S = q.shape[0], q.shape[1]
    nb = S // WINDOW
    G = ATTN_Q_HEADS // ATTN_KV_HEADS
    qb = q.reshape(B, nb, WINDOW, ATTN_KV_HEADS, G, ATTN_HEAD_DIM)

    def band(t):
        tb = t.reshape(B, nb, WINDOW, ATTN_KV_HEADS, ATTN_HEAD_DIM)
        prev = jnp.pad(tb, ((0, 0), (1, 0), (0, 0), (0, 0), (0, 0)))[:, :-1]
        return jnp.concatenate([prev, tb], axis=2)

    kb, vb = band(k), band(v)
    s = jnp.einsum('bnqkgd,bnskd->bnkgqs', qb, kb,
                   preferred_element_type=jnp.float32) * (ATTN_HEAD_DIM ** -0.5)
    t_idx = jnp.arange(WINDOW)[:, None] + WINDOW
    s_idx = jnp.arange(2 * WINDOW)[None, :]
    diff = t_idx - s_idx
    blk = jnp.arange(nb)[:, None, None]
    valid = (diff >= 0) & (diff < WINDOW) & (blk * WINDOW + s_idx - WINDOW >= 0)
    s = jnp.where(valid[None, :, None, None, :, :], s, -jnp.inf)
    sink = sinks.astype(jnp.float32).reshape(1, 1, ATTN_KV_HEADS, G, 1, 1)
    m = jnp.maximum(jnp.max(s, axis=-1, keepdims=True), sink)
    p = jnp.exp(s - m)
    p = p / (jnp.sum(p, axis=-1, keepdims=True) + jnp.exp(sink - m))
    o = jnp.einsum('bnkgqs,bnskd->bnqkgd', p.astype(v.dtype), vb)
    return o.reshape(B, S, ATTN_Q_DIM)


def chunked_spatial_gating(u, v, ln_g, ln_b, w_s, b_s):
    B, S = u.shape[0], u.shape[1]
    nc = S // SGU_CHUNK
    vn = layer_norm(v, ln_g, ln_b).reshape(B, nc, SGU_CHUNK, SGU_GROUPS, SGU_GROUP_DIM)
    w = w_s * jnp.tril(jnp.ones((SGU_CHUNK, SGU_CHUNK), dtype=w_s.dtype))[None]
    mixed = jnp.einsum('gts,bcsge->bctge', w, vn) + jnp.transpose(b_s)[None, None, :, :, None]
    return u * mixed.reshape(B, S, SGU_WIDTH)


def hgrn2(f_logit, i_in, q_in, g_out, lb, norm_g):
    B, S = q_in.shape[0], q_in.shape[1]
    H, dk, C = HGRN_HEADS, HGRN_HEAD_DIM, HGRN_CHUNK
    nc = S // C
    f = lb + (1.0 - lb) * jax.nn.sigmoid(f_logit.astype(jnp.float32))
    log_f = jnp.log(f)
    k = 1.0 - f
    qf = jax.nn.silu(q_in.astype(jnp.float32)) * (dk ** -0.5)
    vf = i_in.astype(jnp.float32)

    def to_chunks(t):
        return t.reshape(B, nc, C, H, dk).transpose(1, 0, 3, 2, 4)

    causal = jnp.tril(jnp.ones((C, C), dtype=bool))

    def step(state, inp):
        qc, kc, vc, lfc = inp
        b = jnp.cumsum(lfc, axis=2)
        o_inter = jnp.einsum('bhtd,bhde->bhte', qc * jnp.exp(b), state)
        diff = b[:, :, :, None, :] - b[:, :, None, :, :]
        decay = jnp.exp(jnp.where(causal[None, None, :, :, None], diff, -jnp.inf))
        a = jnp.einsum('bhtd,bhsd,bhtsd->bhts', qc, kc, decay)
        o_intra = jnp.einsum('bhts,bhse->bhte', a, vc)
        b_last = b[:, :, -1:, :]
        state = jnp.exp(b_last[:, :, 0, :])[..., None] * state + \
            jnp.einsum('bhsd,bhse->bhde', kc * jnp.exp(b_last - b), vc)
        return state, o_inter + o_intra

    s0 = jnp.zeros((B, H, dk, dk), jnp.float32)
    _, o = lax.scan(step, s0, (to_chunks(qf), to_chunks(k), to_chunks(vf), to_chunks(log_f)))
    o = o.transpose(1, 0, 3, 2, 4).reshape(B, S, H, dk)
    o = o * lax.rsqrt(jnp.mean(o * o, axis=-1, keepdims=True) + EPS) * norm_g.astype(jnp.float32)
    o = o.reshape(B, S, HGRN_WIDTH) * jax.nn.silu(g_out.astype(jnp.float32))
    return o.astype(q_in.dtype)


def memory_cross_attention(h, mem_n, w_q, w_kv, w_o):
    B, S = h.shape[0], h.shape[1]
    M = mem_n.shape[1]
    q = (h @ w_q).reshape(B, S, X_HEADS, X_HEAD_DIM)
    k, v = jnp.split(mem_n @ w_kv, 2, axis=-1)
    k = k.reshape(B, M, X_HEADS, X_HEAD_DIM)
    v = v.reshape(B, M, X_HEADS, X_HEAD_DIM)
    s = jnp.einsum('bqhd,bmhd->bhqm', q, k, preferred_element_type=jnp.float32) * (X_HEAD_DIM ** -0.5)
    p = jax.nn.softmax(s, axis=-1).astype(v.dtype)
    o = jnp.einsum('bhqm,bmhd->bqhd', p, v).reshape(B, S, X_DIM)
    return o @ w_o


def setup_inputs(seed: int = 0) -> dict:
    key = jax.random.key(seed)
    ks = jax.random.split(key, 32)
    L, D = DEPTH, D_MODEL
    f32 = jnp.float32

    def dense(k, shape, fan_in):
        return jax.random.normal(k, shape, f32) * (fan_in ** -0.5)

    def gain(k, shape):
        return 1.0 + 0.02 * jax.random.normal(k, shape, f32)

    return {
        'x': jax.random.normal(ks[0], (BATCH, SEQ, D), f32),
        'mem': jax.random.normal(ks[1], (BATCH, MEM_LEN, D), f32),
        'norm_mix': gain(ks[2], (L, D)),
        'w_in': dense(ks[3], (L, D, IN_WIDTH), D),
        'w_gate': dense(ks[4], (L, D, N_BRANCH * D), D),
        'sinks': 0.5 * jax.random.normal(ks[5], (L, ATTN_Q_HEADS), f32),
        'sgu_ln_g': gain(ks[6], (L, SGU_WIDTH)),
        'sgu_ln_b': 0.02 * jax.random.normal(ks[7], (L, SGU_WIDTH), f32),
        'sgu_w': dense(ks[8], (L, SGU_GROUPS, SGU_CHUNK, SGU_CHUNK), SGU_CHUNK),
        'sgu_b': 1.0 + 0.02 * jax.random.normal(ks[9], (L, SGU_GROUPS, SGU_CHUNK), f32),
        'hgrn_lb': 0.5 * jax.random.normal(ks[10], (L, HGRN_WIDTH), f32),
        'hgrn_norm': gain(ks[11], (L, HGRN_HEAD_DIM)),
        'w_br_a': dense(ks[12], (L, ATTN_Q_DIM, D), ATTN_Q_DIM),
        'w_br_b': dense(ks[13], (L, SGU_WIDTH, D), SGU_WIDTH),
        'w_br_c': dense(ks[14], (L, HGRN_WIDTH, D), HGRN_WIDTH),
        'w_out': dense(ks[15], (L, D, D), D),
        'norm_x': gain(ks[16], (L, D)),
        'mem_norm': gain(ks[17], (D,)),
        'w_xq': dense(ks[18], (L, D, X_DIM), D),
        'w_xkv': dense(ks[19], (L, D, 2 * X_DIM), D),
        'w_xo': dense(ks[20], (L, X_DIM, D), X_DIM),
        'norm_ffn': gain(ks[21], (L, D)),
        'w_ffn_in': dense(ks[22], (L, D, 2 * D_FF), D),
        'w_ffn_out': dense(ks[23], (L, D_FF, D), D_FF),
        'final_norm': gain(ks[24], (D,)),
    }


def reference(x, mem, norm_mix, w_in, w_gate, sinks, sgu_ln_g, sgu_ln_b, sgu_w, sgu_b,
              hgrn_lb, hgrn_norm, w_br_a, w_br_b, w_br_c, w_out, norm_x, mem_norm,
              w_xq, w_xkv, w_xo, norm_ffn, w_ffn_in, w_ffn_out, final_norm):
    B, S = x.shape[0], x.shape[1]
    sm = jax.nn.softmax(hgrn_lb.astype(jnp.float32), axis=0)
    lb_all = jnp.cumsum(sm, axis=0) - sm[0:1]
    mem_n = rms_norm(mem, mem_norm)
    pts = _split_points()
    for l in range(DEPTH):
        h = rms_norm(x, norm_mix[l])
        qa, ka, va, ub, vb, fc, ic, qc, gc = jnp.split(h @ w_in[l], pts, axis=-1)
        y_a = sliding_window_attention(
            qa.reshape(B, S, ATTN_Q_HEADS, ATTN_HEAD_DIM),
            ka.reshape(B, S, ATTN_KV_HEADS, ATTN_HEAD_DIM),
            va.reshape(B, S, ATTN_KV_HEADS, ATTN_HEAD_DIM), sinks[l])
        y_b = chunked_spatial_gating(jax.nn.gelu(ub), jax.nn.gelu(vb),
                                     sgu_ln_g[l], sgu_ln_b[l], sgu_w[l], sgu_b[l])
        y_c = hgrn2(fc, ic, qc, gc, lb_all[l], hgrn_norm[l])
        gate_a, gate_b, gate_c = jnp.split(jax.nn.sigmoid(h @ w_gate[l]), N_BRANCH, axis=-1)
        merged = gate_a * (y_a @ w_br_a[l]) + gate_b * (y_b @ w_br_b[l]) + gate_c * (y_c @ w_br_c[l])
        x = x + merged @ w_out[l]
        x = x + memory_cross_attention(rms_norm(x, norm_x[l]), mem_n, w_xq[l], w_xkv[l], w_xo[l])
        gt, up = jnp.split(rms_norm(x, norm_ffn[l]) @ w_ffn_in[l], 2, axis=-1)
        x = x + (jax.nn.silu(gt) * up) @ w_ffn_out[l]
    return rms_norm(x, final_norm)
```

```cpp
#define DUP_MASK 1024
#define PROBE_L2 1
#include <hip/hip_runtime.h>
#include <cstdio>
#include <cstdint>

#define LAS __attribute__((address_space(3)))
#define GAS __attribute__((address_space(1)))
typedef unsigned short bf16;
typedef short bf16x8 __attribute__((ext_vector_type(8)));
typedef float f32x4 __attribute__((ext_vector_type(4)));
typedef float f32x2 __attribute__((ext_vector_type(2)));
typedef unsigned u32x4 __attribute__((ext_vector_type(4)));
typedef unsigned u32x2 __attribute__((ext_vector_type(2)));
typedef GAS unsigned gu32;

__device__ __forceinline__ unsigned cvt_pk_bf16(float lo, float hi) { unsigned r; asm volatile("v_cvt_pk_bf16_f32 %0, %1, %2" : "=v"(r) : "v"(lo), "v"(hi)); return r; }
__device__ __forceinline__ float bf_lo(unsigned w) { return __builtin_bit_cast(float, w << 16); }
__device__ __forceinline__ float bf_hi(unsigned w) { return __builtin_bit_cast(float, w & 0xffff0000u); }
__device__ __forceinline__ float bf1(bf16 h) { return __builtin_bit_cast(float, (unsigned)h << 16); }
__device__ __forceinline__ float fast_exp(float x) { return __builtin_amdgcn_exp2f(x * 1.4426950408889634f); }
__device__ __forceinline__ float sigmoidf_(float x) { return __builtin_amdgcn_rcpf(1.0f + fast_exp(-x)); }
__device__ __forceinline__ float siluf_(float x) { return x * sigmoidf_(x); }
__device__ __forceinline__ float geluf_(float x) { return x * sigmoidf_(1.5957691216057308f * (x + 0.044715f * x * x * x)); }
__device__ __forceinline__ float wave_sum(float v) {
#pragma unroll
    for (int o = 1; o < 64; o <<= 1) v += __shfl_xor(v, o);
    return v;
}

namespace pg8 {
constexpr int BM = 256, BK = 64, HALF = 128, HTB = HALF * BK * 2, STAGE_BYTES = 8 * HTB, NXCD = 8, WGM = 8;
__host__ __device__ __forceinline__ int lds_byte(int r, int c) { const int st = (r >> 4) * 2 + (c >> 5), rr = r & 15, cc = c & 31, ob = rr * 64 + cc * 2; return st * 1024 + (ob ^ (((ob >> 9) & 1) << 5)); }
__host__ __device__ __forceinline__ void stage_rc(int b, int& R, int& C) { const int st = b / 1024, sb = b % 1024, swz = sb ^ (((sb >> 9) & 1) << 5); R = (st >> 1) * 16 + swz / 64; C = (st & 1) * 32 + (swz % 64) / 2; }
__host__ __device__ __forceinline__ int perm32(int rho) { const int n = rho >> 4, i = rho & 15; return 8 * (i >> 2) + 4 * n + (i & 3); }

struct Unit { int pm, pn, aux; const GAS char* a; const GAS char* b; };
struct GemmK { int K, lda, ldb; };

__device__ __forceinline__ void tile_of(int L, int nM, int nN, int wgm, int& pm, int& pn) {
    const int nwg = nM * nN; int wgid = L;
    { const int q = nwg / NXCD, r = nwg % NXCD, xcd = wgid % NXCD, off = wgid / NXCD; wgid = (xcd < r ? xcd * (q + 1) : r * (q + 1) + (xcd - r) * q) + off; }
    const int nig = wgm * nN, gid = wgid / nig, fm = gid * wgm, gsz = (nM - fm) < wgm ? (nM - fm) : wgm;
    pm = fm + ((wgid % nig) % gsz); pn = (wgid % nig) / gsz;
}
struct PlainOrder {
    int nM, nN, nwg, G, c, sub, wgm; const GAS char* A; const GAS char* B; size_t tA, tB, asub, bsub;
    __device__ __forceinline__ void init(int M, int N, int G_, int c_, const GAS void* A_, int lda, const GAS void* B_, int ldb, int sub_ = 1, size_t asub_ = 0, size_t bsub_ = 0, int wgm_ = WGM) {
        nM = M / BM; nN = N / BM; nwg = nM * nN; G = G_; c = c_; A = (const GAS char*)A_; B = (const GAS char*)B_; tA = (size_t)BM * lda * 2; tB = (size_t)BM * ldb * 2; sub = sub_; asub = asub_; bsub = bsub_; wgm = wgm_; }
    __device__ __forceinline__ bool next(int i, Unit& u) const {
        const int ti = i / sub, j = i - ti * sub;
        const long L = (long)ti * G + c; if (L >= nwg) return false;
        tile_of((int)L, nM, nN, wgm, u.pm, u.pn); u.aux = j;
        u.a = A + (size_t)u.pm * tA + (size_t)j * asub; u.b = B + (size_t)u.pn * tB + (size_t)j * bsub; return true;
    }
};

template <class Epi, class Sched>
__device__ __forceinline__ void gemm_phase(LAS unsigned char* lds, const GemmK g, const Sched& S, const Epi& E) {
    int tid = threadIdx.x; asm volatile("" : "+v"(tid));
    const int wid = __builtin_amdgcn_readfirstlane(tid >> 6), lane = tid & 63, wr = wid >> 2, wc = wid & 3, fr = lane & 15, fq = lane >> 4;
    const int K = g.K, nt = K / BK;
    unsigned voffA[2], voffB[2];
#pragma unroll
    for (int i = 0; i < 2; ++i) { int R, C; stage_rc(tid * 16 + i * 8192, R, C); const int Rb = Epi::PERM ? ((R & ~31) + perm32(R & 31)) : R;
        voffA[i] = (unsigned)(R * g.lda + C) * 2u; voffB[i] = (unsigned)(Rb * g.ldb + C) * 2u; }
    const size_t kstep = (size_t)(BK * 2);
    const size_t hstepA = (size_t)HALF * g.lda * 2, hstepB = (size_t)HALF * g.ldb * 2;
    const unsigned ldsw = (unsigned)wid * 1024u;
    const int aoff = lds_byte(wr * 64 + fr, fq * 8), boff = lds_byte(wc * 32 + fr, fq * 8);
#define PG8_SA(b, h) (((b) * 2 + (h)) * HTB)
#define PG8_SB(b, h) ((4 + (b) * 2 + (h)) * HTB)
#define PG8_STAGE(bufoff, gbase, voff) do { _Pragma("unroll") for (int _i = 0; _i < 2; ++_i) \
        __builtin_amdgcn_global_load_lds((const GAS unsigned*)((gbase) + (voff)[_i]), (LAS unsigned*)(lds + (bufoff) + ldsw + _i * 8192), 16, 0, 0); } while (0)
#define PG8_LDA(dst, b, h) do { _Pragma("unroll") for (int m = 0; m < 4; ++m) _Pragma("unroll") for (int k = 0; k < 2; ++k) dst[m][k] = *(const LAS bf16x8*)(lds + PG8_SA(b, h) + aoff + m * 2048 + k * 1024); } while (0)
#define PG8_LDB(dst, b, h) do { _Pragma("unroll") for (int n = 0; n < 2; ++n) _Pragma("unroll") for (int k = 0; k < 2; ++k) dst[n][k] = *(const LAS bf16x8*)(lds + PG8_SB(b, h) + boff + n * 2048 + k * 1024); } while (0)
#define PG8_MMA(ai, bj, At, Bt) do { __builtin_amdgcn_s_setprio(1); _Pragma("unroll") for (int m = 0; m < 4; ++m) _Pragma("unroll") for (int n = 0; n < 2; ++n) _Pragma("unroll") for (int k = 0; k < 2; ++k) \
        acc[ai][bj][m][n] = __builtin_amdgcn_mfma_f32_16x16x32_bf16(Bt[n][k], At[m][k], acc[ai][bj][m][n], 0, 0, 0); __builtin_amdgcn_s_setprio(0); } while (0)
#define PG8_WAIT_V(n) asm volatile("s_waitcnt vmcnt(" #n ")" ::: "memory")
#define PG8_WAIT_L(n) asm volatile("s_waitcnt lgkmcnt(" #n ")" ::: "memory")
#define PG8_BAR __builtin_amdgcn_s_barrier()
#define PG8_SCHED __builtin_amdgcn_sched_barrier(0)
    Unit cur, nxt; int ui = 0;
    if (!S.next(0, cur)) return;
    E.prep(cur, 0, tid);
    f32x4 acc[2][2][4][2];
#pragma unroll
    for (int a = 0; a < 2; ++a)
#pragma unroll
        for (int b = 0; b < 2; ++b)
#pragma unroll
            for (int m = 0; m < 4; ++m)
#pragma unroll
                for (int n = 0; n < 2; ++n) acc[a][b][m][n] = (f32x4){0.f, 0.f, 0.f, 0.f};
    bf16x8 At[4][2], B0[2][2], B1[2][2];
    const GAS char* cA = cur.a; const GAS char* cB = cur.b;
    PG8_STAGE(PG8_SB(0, 0), cB, voffB); PG8_STAGE(PG8_SB(0, 1), cB + hstepB, voffB); PG8_STAGE(PG8_SA(0, 0), cA, voffA); PG8_STAGE(PG8_SA(0, 1), cA + hstepA, voffA);
    if (wr == 1) PG8_BAR;
    PG8_WAIT_V(2); PG8_BAR;
    PG8_STAGE(PG8_SB(1, 0), cB + kstep, voffB); PG8_STAGE(PG8_SA(1, 0), cA + kstep, voffA); PG8_STAGE(PG8_SB(1, 1), cB + hstepB + kstep, voffB);
    PG8_WAIT_V(6); PG8_BAR;
    for (;;) {
        const bool has_next = S.next(ui + 1, nxt);
        const GAS char* nA = has_next ? nxt.a : cA; const GAS char* nB = has_next ? nxt.b : cB;
        for (int t = 0; t < nt; t += 2) {
            const bool last = (t == nt - 2);
            const GAS char* a1 = cA + (size_t)(t + 1) * kstep;
            const GAS char* a2 = last ? nA : cA + (size_t)(t + 2) * kstep; const GAS char* b2 = last ? nB : cB + (size_t)(t + 2) * kstep;
            const GAS char* a3 = a2 + kstep; const GAS char* b3 = b2 + kstep;
            PG8_LDB(B0, 0, 0); PG8_LDB(B1, 0, 1); PG8_SCHED; PG8_LDA(At, 0, 0); PG8_STAGE(PG8_SA(1, 1), a1 + hstepA, voffA);
            PG8_WAIT_V(8); PG8_WAIT_L(0); PG8_BAR; PG8_MMA(0, 0, At, B0); PG8_MMA(0, 1, At, B1); PG8_BAR; PG8_SCHED;
            PG8_LDA(At, 0, 1); PG8_STAGE(PG8_SB(0, 0), b2, voffB); PG8_STAGE(PG8_SB(0, 1), b2 + hstepB, voffB); PG8_STAGE(PG8_SA(0, 0), a2, voffA);
            PG8_WAIT_V(8); PG8_WAIT_L(0); PG8_BAR; PG8_MMA(1, 0, At, B0); PG8_MMA(1, 1, At, B1); PG8_BAR; PG8_SCHED;
            PG8_LDB(B0, 1, 0); PG8_LDB(B1, 1, 1); PG8_SCHED; PG8_LDA(At, 1, 0); PG8_STAGE(PG8_SA(0, 1), a2 + hstepA, voffA);
            PG8_WAIT_V(8); PG8_WAIT_L(0); PG8_BAR; PG8_MMA(0, 0, At, B0); PG8_MMA(0, 1, At, B1); PG8_BAR; PG8_SCHED;
            PG8_LDA(At, 1, 1); PG8_STAGE(PG8_SB(1, 0), b3, voffB); PG8_STAGE(PG8_SB(1, 1), b3 + hstepB, voffB); PG8_STAGE(PG8_SA(1, 0), a3, voffA);
            PG8_WAIT_V(8); PG8_WAIT_L(0); PG8_BAR; PG8_MMA(1, 0, At, B0); PG8_MMA(1, 1, At, B1); PG8_BAR; PG8_SCHED;
        }
        if (wr == 0) PG8_BAR;
        E(acc, cur, wr, wc, fr, fq, ui & 1);
        if (has_next) E.prep(nxt, (ui + 1) & 1, tid);
        if (!has_next) break;
        if (!Epi::keep(cur)) {
#pragma unroll
        for (int a = 0; a < 2; ++a)
#pragma unroll
            for (int b = 0; b < 2; ++b)
#pragma unroll
                for (int m = 0; m < 4; ++m)
#pragma unroll
                    for (int n = 0; n < 2; ++n) acc[a][b][m][n] = (f32x4){0.f, 0.f, 0.f, 0.f};
        }
        cur = nxt; cA = nA; cB = nB; ++ui;
        if (wr == 1) PG8_BAR;
    }
    PG8_WAIT_V(0);
    PG8_BAR;
#undef PG8_SA
#undef PG8_SB
#undef PG8_STAGE
#undef PG8_LDA
#undef PG8_LDB
#undef PG8_MMA
#undef PG8_WAIT_V
#undef PG8_WAIT_L
#undef PG8_BAR
#undef PG8_SCHED
}
}
constexpr int NB = 16, SEQ = 2048, DM = 2048, T = NB * SEQ, NL = 4, MEML = 256, MT = NB * MEML;
constexpr int INW = 7680, GW = 6144, NCAT = INW + GW, XD = 512, DFF = 5632, YW = 3072;
constexpr int C_QA = 0, C_KA = 1024, C_VA = 1280, C_UB = 1536, C_VB = 2560, C_FC = 3584, C_IC = 4608, C_QC = 5632, C_GC = 6656;
constexpr float EPS = 1e-6f;
constexpr float LOG2E = 1.4426950408889634f;
constexpr int NWAVES = 8, NTHR = NWAVES * 64;

constexpr size_t MiB = 1u << 20;
constexpr size_t WS_CTL = 0, CTL_ZERO_BYTES = 1 * MiB;
constexpr size_t WS_WCAT = 1 * MiB;
constexpr size_t WS_WBR = WS_WCAT + 54 * MiB;
constexpr size_t WS_WOUT = WS_WBR + 12 * MiB;
constexpr size_t WS_WXQ = WS_WOUT + 8 * MiB;
constexpr size_t WS_WXO = WS_WXQ + 2 * MiB;
constexpr size_t WS_WF1 = WS_WXO + 2 * MiB;
constexpr size_t WS_WF2 = WS_WF1 + 44 * MiB;
constexpr size_t WS_WXKV = WS_WF2 + 22 * MiB;
constexpr size_t WS_MEMN = WS_WXKV + 16 * MiB;
constexpr size_t WS_KV = WS_MEMN + 16 * MiB;
constexpr size_t WS_H = WS_KV + 32 * MiB;
constexpr size_t WS_PROJ = WS_H + 128 * MiB;
constexpr size_t WS_GATE = WS_PROJ + 480 * MiB;
constexpr size_t WS_Y = WS_GATE + 384 * MiB;
constexpr size_t WS_SS = WS_Y + 192 * MiB;
constexpr size_t WS_END = WS_SS + 1 * MiB;
constexpr int CW_TMO = 0, CW_BAR = 4096, CW_Q = 8192;

constexpr int RING_BYTES = 143360;
constexpr int LDSCTL_OFF = RING_BYTES, LDS_RED = LDSCTL_OFF + 1024, LDS_RSTD = LDS_RED + 4096, LDS_BYTES = 155648;

#define RLX_AGENT __ATOMIC_RELAXED, __HIP_MEMORY_SCOPE_AGENT
#define LDS_WAIT() asm volatile("s_waitcnt lgkmcnt(0)" ::: "memory")
#define VM_WAIT() asm volatile("s_waitcnt vmcnt(0)" ::: "memory")

#define XB_TMO      128
#define XB_XCNT(j)  (256  + 64 * (j))
#define XB_XSUB(j)  (1280 + 64 * (j))
#define XB_XGEN(j)  (2304 + 64 * (j))
#define XB_TOP      3328
#define XB_TOPGEN   3392
#define XCD_BAR_WORDS 3456
#define XB_SPIN_CAP (1u << 18)
__device__ __forceinline__ unsigned xb_ld(unsigned* p)              { return __hip_atomic_load(p, __ATOMIC_RELAXED, __HIP_MEMORY_SCOPE_AGENT); }
__device__ __forceinline__ unsigned xb_add(unsigned* p, unsigned v) { return __hip_atomic_fetch_add(p, v, __ATOMIC_RELAXED, __HIP_MEMORY_SCOPE_AGENT); }
__device__ __forceinline__ unsigned xb_xcc_id() { return (unsigned)__builtin_amdgcn_s_getreg((3 << 11) | 20) & 0xFu; }
#define XB_SPIN(cond, bar) do { unsigned _sp = 0; while (cond) { __builtin_amdgcn_s_sleep(1); \
    if ((++_sp & 255u) == 0u) { if (xb_ld(&(bar)[XB_TMO])) break; if (_sp > XB_SPIN_CAP) { atomicAdd(&(bar)[XB_TMO], 1u); break; } } } } while (0)
struct XcdBarrier { unsigned* bar; unsigned x; volatile LAS unsigned* st; };
__device__ __forceinline__ XcdBarrier xcd_barrier_post(unsigned* bar, volatile LAS unsigned* st) {
    XcdBarrier b; b.bar = bar; b.x = xb_xcc_id(); b.st = st;
    if (threadIdx.x == 0) (void)xb_add(&bar[XB_XCNT(b.x)], 1u);
    return b;
}
__device__ __forceinline__ void xcd_barrier_complete(unsigned* bar, unsigned x, unsigned& nloc, unsigned& nx) {
    const unsigned G = gridDim.x * gridDim.y * gridDim.z;
    unsigned sum, cnt, mine, sp = 0u;
    for (;;) {
        sum = 0u; cnt = 0u; mine = 0u;
#pragma unroll
        for (unsigned j = 0; j < 16; ++j) { const unsigned c = xb_ld(&bar[XB_XCNT(j)]); sum += c; cnt += (c > 0u) ? 1u : 0u; mine = (j == x) ? c : mine; }
        if (sum == G) break;
        __builtin_amdgcn_s_sleep(1);
        if ((++sp & 255u) == 0u) { if (xb_ld(&bar[XB_TMO])) break; if (sp > XB_SPIN_CAP) { atomicAdd(&bar[XB_TMO], 1u); break; } }
    }
    nloc = mine > 0u ? mine : 1u; nx = cnt > 0u ? cnt : 1u;
}
__device__ __forceinline__ void xcd_barrier(const XcdBarrier& b) {
    asm volatile("s_waitcnt vmcnt(0)" ::: "memory");
    __syncthreads();
    if (threadIdx.x == 0) {
        unsigned* bar = b.bar;
        __builtin_amdgcn_s_waitcnt(0);
        unsigned nloc = b.st[0], nx = b.st[1];
        if (nloc == 0u) { xcd_barrier_complete(bar, b.x, nloc, nx); b.st[0] = nloc; b.st[1] = nx; }
        const unsigned old = xb_add(&bar[XB_XSUB(b.x)], 1u);
        const unsigned gen = old / nloc;
        if (old + 1u == (gen + 1u) * nloc) {
            __builtin_amdgcn_fence(__ATOMIC_RELEASE, "agent");
            asm volatile("s_waitcnt vmcnt(0)" ::: "memory");
            const unsigned og = xb_add(&bar[XB_TOP], 1u);
            const unsigned tg = og / nx;
            if (og + 1u == (tg + 1u) * nx) xb_add(&bar[XB_TOPGEN], 1u);
            else XB_SPIN(xb_ld(&bar[XB_TOPGEN]) == tg, bar);
            __builtin_amdgcn_fence(__ATOMIC_ACQUIRE, "agent");
            xb_add(&bar[XB_XGEN(b.x)], 1u);
            asm volatile("s_waitcnt vmcnt(0)" ::: "memory");
        } else {
            XB_SPIN(xb_ld(&bar[XB_XGEN(b.x)]) == gen, bar);
            __builtin_amdgcn_fence(__ATOMIC_ACQUIRE, "agent");
            asm volatile("s_waitcnt vmcnt(0)" ::: "memory");
        }
    }
    __syncthreads();
}

struct RowScale {
    const GAS float* ss; LAS float* tab;
    __device__ __forceinline__ void prep(const pg8::Unit& u, int buf, int tid) const {
        if (tid < 256) { const GAS f32x4* p = (const GAS f32x4*)(ss + ((size_t)u.pm * 256 + tid) * 8); const f32x4 a = p[0], b = p[1];
            tab[buf * 256 + tid] = __builtin_amdgcn_rsqf(((a.x + a.y) + (a.z + a.w) + (b.x + b.y) + (b.z + b.w)) * (1.f / DM) + EPS); }
    }
    __device__ __forceinline__ float get(int buf, int row) const { return tab[buf * 256 + row]; }
};
struct EpiCat {
    static constexpr bool PERM = true; static __device__ __forceinline__ bool keep(const pg8::Unit&) { return false; }
    GAS bf16* proj; GAS bf16* gate; RowScale rs;
    __device__ __forceinline__ void prep(const pg8::Unit& u, int buf, int tid) const { rs.prep(u, buf, tid); }
    __device__ __forceinline__ void operator()(f32x4 (&acc)[2][2][4][2], const pg8::Unit& u, int wr, int wc, int fr, int fq, int buf) const {
        int colt = u.pn * 256; GAS char* base; int ldc; bool sig;
        if (colt < INW) { base = (GAS char*)proj; ldc = INW; sig = false; } else { base = (GAS char*)gate; ldc = GW; colt -= INW; sig = true; }
        const unsigned toff = (unsigned)((wr * 64 + fr) * ldc + wc * 32 + 8 * fq) * 2u;
#pragma unroll
        for (int ai = 0; ai < 2; ++ai)
#pragma unroll
            for (int m = 0; m < 4; ++m) { GAS char* ub = base + ((size_t)(u.pm * 256 + ai * 128 + m * 16) * ldc + colt) * 2;
                const float rsd = rs.get(buf, ai * 128 + wr * 64 + m * 16 + fr);
#pragma unroll
                for (int bj = 0; bj < 2; ++bj) { f32x4 v0 = acc[ai][bj][m][0] * rsd, v1 = acc[ai][bj][m][1] * rsd;
                    if (sig) {
#pragma unroll
                        for (int e = 0; e < 4; ++e) { v0[e] = fmaxf(sigmoidf_(v0[e]), 1e-20f); v1[e] = fmaxf(sigmoidf_(v1[e]), 1e-20f); } }
                    u32x4 w; w.x = cvt_pk_bf16(v0[0], v0[1]); w.y = cvt_pk_bf16(v0[2], v0[3]); w.z = cvt_pk_bf16(v1[0], v1[1]); w.w = cvt_pk_bf16(v1[2], v1[3]);
                    *(GAS u32x4*)(ub + bj * 256 + toff) = w; } }
    }
};
template <bool SCALE> struct EpiPlain {
    static constexpr bool PERM = true; static __device__ __forceinline__ bool keep(const pg8::Unit&) { return false; }
    GAS bf16* O; int ldc; RowScale rs;
    __device__ __forceinline__ void prep(const pg8::Unit& u, int buf, int tid) const { if (SCALE) rs.prep(u, buf, tid); }
    __device__ __forceinline__ void operator()(f32x4 (&acc)[2][2][4][2], const pg8::Unit& u, int wr, int wc, int fr, int fq, int buf) const {
        const unsigned toff = (unsigned)((wr * 64 + fr) * ldc + wc * 32 + 8 * fq) * 2u;
#pragma unroll
        for (int ai = 0; ai < 2; ++ai)
#pragma unroll
            for (int m = 0; m < 4; ++m) { GAS char* ub = (GAS char*)O + ((size_t)(u.pm * 256 + ai * 128 + m * 16) * ldc + u.pn * 256) * 2;
                const float rsd = SCALE ? rs.get(buf, ai * 128 + wr * 64 + m * 16 + fr) : 1.f;
#pragma unroll
                for (int bj = 0; bj < 2; ++bj) { const f32x4 v0 = acc[ai][bj][m][0] * rsd, v1 = acc[ai][bj][m][1] * rsd;
                    u32x4 w; w.x = cvt_pk_bf16(v0[0], v0[1]); w.y = cvt_pk_bf16(v0[2], v0[3]); w.z = cvt_pk_bf16(v1[0], v1[1]); w.w = cvt_pk_bf16(v1[2], v1[3]);
                    *(GAS u32x4*)(ub + bj * 256 + toff) = w; } }
    }
};
struct EpiResid {
    static constexpr bool PERM = false; static __device__ __forceinline__ bool keep(const pg8::Unit&) { return false; }
    const GAS float* src; GAS float* dst; GAS bf16* xb; GAS float* ss; LAS float* red;
    __device__ __forceinline__ void prep(const pg8::Unit&, int, int) const {}
    __device__ __forceinline__ void operator()(f32x4 (&acc)[2][2][4][2], const pg8::Unit& u, int wr, int wc, int fr, int fq, int) const {
        const unsigned toff_ = (unsigned)((wr * 64 + fr) * DM + wc * 32 + 4 * fq) * 4u;
#pragma unroll
        for (int ai = 0; ai < 2; ++ai) {
            unsigned toff = toff_; asm volatile("" : "+v"(toff));
            f32x4 sv[4][2][2];
#pragma unroll
            for (int m = 0; m < 4; ++m) { const GAS char* us = (const GAS char*)src + ((size_t)(u.pm * 256 + ai * 128 + m * 16) * DM + u.pn * 256) * 4;
#pragma unroll
                for (int bj = 0; bj < 2; ++bj)
#pragma unroll
                    for (int n = 0; n < 2; ++n) sv[m][bj][n] = *(const GAS f32x4*)(us + bj * 512 + n * 64 + toff); }
#pragma unroll
            for (int m = 0; m < 4; ++m) { const size_t uo = ((size_t)(u.pm * 256 + ai * 128 + m * 16) * DM + u.pn * 256) * 4;
                GAS char* ud = (GAS char*)dst + uo; GAS char* ux = (GAS char*)xb + (uo >> 1);
                float q = 0.f;
#pragma unroll
                for (int bj = 0; bj < 2; ++bj)
#pragma unroll
                    for (int n = 0; n < 2; ++n) { const int o = bj * 512 + n * 64; const f32x4 v = sv[m][bj][n] + acc[ai][bj][m][n]; *(GAS f32x4*)(ud + o + toff) = v;
                        if (xb) { u32x2 w; w.x = cvt_pk_bf16(v.x, v.y); w.y = cvt_pk_bf16(v.z, v.w); *(GAS u32x2*)(ux + ((o + toff) >> 1)) = w; q += (v.x * v.x + v.y * v.y) + (v.z * v.z + v.w * v.w); } }
                if (xb) { q += __shfl_xor(q, 16); q += __shfl_xor(q, 32); if (fq == 0) red[wc * 256 + ai * 128 + wr * 64 + m * 16 + fr] = q; } }
            asm volatile("" ::: "memory"); }
        if (xb) { asm volatile("s_waitcnt lgkmcnt(0)" ::: "memory"); __builtin_amdgcn_s_barrier();
            const int t = threadIdx.x; if (t < 256) ss[((size_t)u.pm * 256 + t) * 8 + u.pn] = (red[t] + red[256 + t]) + (red[512 + t] + red[768 + t]); }
    }
};
struct EpiSwiglu {
    static constexpr bool PERM = true; static __device__ __forceinline__ bool keep(const pg8::Unit&) { return false; }
    GAS bf16* O; RowScale rs;
    __device__ __forceinline__ void prep(const pg8::Unit& u, int buf, int tid) const { rs.prep(u, buf, tid); }
    __device__ __forceinline__ void operator()(f32x4 (&acc)[2][2][4][2], const pg8::Unit& u, int wr, int wc, int fr, int fq, int buf) const {
        const unsigned toff = (unsigned)((wr * 64 + fr) * DFF + wc * 32 + 8 * fq) * 2u;
#pragma unroll
        for (int ai = 0; ai < 2; ++ai)
#pragma unroll
            for (int m = 0; m < 4; ++m) { GAS char* ub = (GAS char*)O + ((size_t)(u.pm * 256 + ai * 128 + m * 16) * DFF + u.pn * 128) * 2;
                f32x4 v0, v1; const float rsd = rs.get(buf, ai * 128 + wr * 64 + m * 16 + fr);
#pragma unroll
                for (int e = 0; e < 4; ++e) { v0[e] = siluf_(acc[ai][0][m][0][e] * rsd) * (acc[ai][1][m][0][e] * rsd); v1[e] = siluf_(acc[ai][0][m][1][e] * rsd) * (acc[ai][1][m][1][e] * rsd); }
                u32x4 w; w.x = cvt_pk_bf16(v0[0], v0[1]); w.y = cvt_pk_bf16(v0[2], v0[3]); w.z = cvt_pk_bf16(v1[0], v1[1]); w.w = cvt_pk_bf16(v1[2], v1[3]);
                *(GAS u32x4*)(ub + toff) = w; }
    }
};
struct EpiBranch {
    static constexpr bool PERM = true; static __device__ __forceinline__ bool keep(const pg8::Unit& u) { return u.aux < 2; }
    const GAS bf16* gate; GAS bf16* merged;
    __device__ __forceinline__ void prep(const pg8::Unit&, int, int) const {}
    __device__ __forceinline__ void operator()(f32x4 (&acc)[2][2][4][2], const pg8::Unit& u, int wr, int wc, int fr, int fq, int) const {
        const int j = u.aux;
        const unsigned toffg_ = (unsigned)((wr * 64 + fr) * GW + wc * 32 + 8 * fq) * 2u, toffm_ = (unsigned)((wr * 64 + fr) * DM + wc * 32 + 8 * fq) * 2u;
#pragma unroll
        for (int ai = 0; ai < 2; ++ai) {
            unsigned toffg = toffg_, toffm = toffm_; asm volatile("" : "+v"(toffg), "+v"(toffm));
            u32x4 gw[4][2], gn[4][2];
#pragma unroll
            for (int m = 0; m < 4; ++m) { const GAS char* ug = (const GAS char*)gate + ((size_t)(u.pm * 256 + ai * 128 + m * 16) * GW + j * DM + u.pn * 256) * 2;
#pragma unroll
                for (int bj = 0; bj < 2; ++bj) { gw[m][bj] = *(const GAS u32x4*)(ug + bj * 256 + toffg); if (j < 2) gn[m][bj] = *(const GAS u32x4*)(ug + DM * 2 + bj * 256 + toffg); } }
#pragma unroll
            for (int m = 0; m < 4; ++m) { GAS char* um = (GAS char*)merged + ((size_t)(u.pm * 256 + ai * 128 + m * 16) * DM + u.pn * 256) * 2;
#pragma unroll
                for (int bj = 0; bj < 2; ++bj) { const u32x4 g0 = gw[m][bj];
                    float s[8] = {bf_lo(g0.x), bf_hi(g0.x), bf_lo(g0.y), bf_hi(g0.y), bf_lo(g0.z), bf_hi(g0.z), bf_lo(g0.w), bf_hi(g0.w)};
                    if (j < 2) { const u32x4 g1 = gn[m][bj];
                        const float d[8] = {bf_lo(g1.x), bf_hi(g1.x), bf_lo(g1.y), bf_hi(g1.y), bf_lo(g1.z), bf_hi(g1.z), bf_lo(g1.w), bf_hi(g1.w)};
#pragma unroll
                        for (int e = 0; e < 8; ++e) s[e] = s[e] * __builtin_amdgcn_rcpf(d[e]); }
                    f32x4 v0 = acc[ai][bj][m][0], v1 = acc[ai][bj][m][1];
                    v0[0] *= s[0]; v0[1] *= s[1]; v0[2] *= s[2]; v0[3] *= s[3]; v1[0] *= s[4]; v1[1] *= s[5]; v1[2] *= s[6]; v1[3] *= s[7];
                    if (j < 2) { acc[ai][bj][m][0] = v0; acc[ai][bj][m][1] = v1; }
                    else { u32x4 w; w.x = cvt_pk_bf16(v0[0], v0[1]); w.y = cvt_pk_bf16(v0[2], v0[3]); w.z = cvt_pk_bf16(v1[0], v1[1]); w.w = cvt_pk_bf16(v1[2], v1[3]);
                        *(GAS u32x4*)(um + bj * 256 + toffm) = w; } } }
            asm volatile("" ::: "memory"); }
    }
};

__device__ __forceinline__ void tr_item(const GAS float* W, int N, GAS bf16* WT, int ldd, int k0, int n0, int drow0, LAS float* scr, int lane, const GAS float* gain = nullptr) {
    const float gv = gain ? gain[k0 + lane] : 1.f;
#pragma unroll 8
    for (int i = 0; i < 32; ++i) { const int kk = 2 * i + (lane >> 5); scr[kk * 33 + (lane & 31)] = W[(size_t)(k0 + kk) * N + n0 + (lane & 31)] * __shfl(gv, kk); }
    LDS_WAIT(); asm volatile("" ::: "memory");
    const int c = lane & 7;
#pragma unroll
    for (int j = 0; j < 4; ++j) { const int n = (lane >> 3) + 8 * j; const LAS float* s = scr + (8 * c) * 33 + n;
        u32x4 o; o.x = cvt_pk_bf16(s[0 * 33], s[1 * 33]); o.y = cvt_pk_bf16(s[2 * 33], s[3 * 33]); o.z = cvt_pk_bf16(s[4 * 33], s[5 * 33]); o.w = cvt_pk_bf16(s[6 * 33], s[7 * 33]);
        *(GAS u32x4*)(WT + (size_t)(drow0 + n) * ldd + k0 + 8 * c) = o; }
    LDS_WAIT(); asm volatile("" ::: "memory");
}
__device__ __forceinline__ void rms_row_bf16(const GAS float* xrow, const f32x4 (&gv)[8], GAS bf16* orow, int lane) {
    const GAS f32x4* xr = (const GAS f32x4*)xrow + lane;
    f32x4 v[8]; float s = 0.f;
#pragma unroll
    for (int j = 0; j < 8; ++j) { v[j] = xr[64 * j]; s += (v[j].x * v[j].x + v[j].y * v[j].y) + (v[j].z * v[j].z + v[j].w * v[j].w); }
    const float rstd = __builtin_amdgcn_rsqf(wave_sum(s) * (1.f / DM) + EPS);
    GAS u32x2* o8 = (GAS u32x2*)orow + lane;
#pragma unroll
    for (int j = 0; j < 8; ++j) { const f32x4 y = v[j] * rstd * gv[j]; u32x2 w; w.x = cvt_pk_bf16(y.x, y.y); w.y = cvt_pk_bf16(y.z, y.w); o8[64 * j] = w; }
}
__device__ __forceinline__ void norm_phase(const GAS float* src, const GAS float* gain, GAS bf16* dst, int nrows, int gw, int NGW, int lane) {
    f32x4 gv[8];
#pragma unroll
    for (int j = 0; j < 8; ++j) gv[j] = ((const GAS f32x4*)gain)[lane + 64 * j];
    for (int m = gw; m < nrows; m += NGW) rms_row_bf16(src + (size_t)m * DM, gv, dst + (size_t)m * DM, lane);
}
__device__ __forceinline__ void xb_phase(const GAS float* src, GAS bf16* xb, GAS float* ss, int gw, int NGW, int lane) {
    for (int m = gw; m < T; m += NGW) {
        const GAS f32x4* xr = (const GAS f32x4*)(src + (size_t)m * DM) + lane; GAS u32x2* o8 = (GAS u32x2*)(xb + (size_t)m * DM) + lane;
        f32x4 v[8]; float q[8];
#pragma unroll
        for (int j = 0; j < 8; ++j) { v[j] = xr[64 * j]; q[j] = (v[j].x * v[j].x + v[j].y * v[j].y) + (v[j].z * v[j].z + v[j].w * v[j].w); }
#pragma unroll
        for (int j = 0; j < 8; ++j) { u32x2 w; w.x = cvt_pk_bf16(v[j].x, v[j].y); w.y = cvt_pk_bf16(v[j].z, v[j].w); o8[64 * j] = w; }
#pragma unroll
        for (int o = 1; o < 64; o <<= 1)
#pragma unroll
            for (int j = 0; j < 8; ++j) q[j] += __shfl_xor(q[j], o);
        if (lane == 0) { GAS f32x4* sp = (GAS f32x4*)(ss + (size_t)m * 8); sp[0] = (f32x4){q[0], q[1], q[2], q[3]}; sp[1] = (f32x4){q[4], q[5], q[6], q[7]}; }
    }
}
__device__ __forceinline__ void final_norm_phase(GAS float* x, const GAS float* gain, const GAS float* ss, int gw, int NGW, int lane) {
    f32x4 gv[8];
#pragma unroll
    for (int j = 0; j < 8; ++j) gv[j] = ((const GAS f32x4*)gain)[lane + 64 * j];
    for (int m = gw; m < T; m += NGW) {
        GAS f32x4* xr = (GAS f32x4*)(x + (size_t)m * DM) + lane;
        const GAS f32x4* sp = (const GAS f32x4*)(ss + (size_t)m * 8); const f32x4 a = sp[0], b = sp[1];
        const float rstd = __builtin_amdgcn_rsqf(((a.x + a.y) + (a.z + a.w) + (b.x + b.y) + (b.z + b.w)) * (1.f / DM) + EPS);
        f32x4 v[8];
#pragma unroll
        for (int j = 0; j < 8; ++j) v[j] = xr[64 * j];
#pragma unroll
        for (int j = 0; j < 8; ++j) xr[64 * j] = v[j] * rstd * gv[j];
    }
}
typedef short s16x4 __attribute__((ext_vector_type(4)));
__device__ __forceinline__ s16x4 tr_read(const LAS unsigned char* p) { return __builtin_bit_cast(s16x4, __builtin_amdgcn_ds_read_tr16_b64_v4i16((LAS s16x4*)p)); }
template <int HD, bool SWA>
__device__ __forceinline__ void attn_wave32(const LAS unsigned char* Ks, int kstr, const LAS unsigned char* Vt, int vstr, const bf16x8 (&qf)[2][HD / 32], f32x4 (&o)[2][HD / 16],
                                            float m0, float l0, float c2, int kt_lo, int kt_hi, int t0, bool first_blk, int lane) {
    const int fr = lane & 15, g = lane >> 4;
    float mrow[2] = {m0, m0}, lrow[2] = {l0, l0};
#pragma unroll
    for (int mt = 0; mt < 2; ++mt)
#pragma unroll
        for (int dt = 0; dt < HD / 16; ++dt) o[mt][dt] = (f32x4){0.f, 0.f, 0.f, 0.f};
    for (int kt = kt_lo; kt <= kt_hi; ++kt) {
        f32x4 s[2][4];
#pragma unroll
        for (int mt = 0; mt < 2; ++mt)
#pragma unroll
            for (int nt = 0; nt < 4; ++nt) s[mt][nt] = (f32x4){0.f, 0.f, 0.f, 0.f};
#pragma unroll
        for (int nt = 0; nt < 4; ++nt)
#pragma unroll
            for (int kk = 0; kk < HD / 32; ++kk) {
                const bf16x8 kf = *(const LAS bf16x8*)(Ks + (kt * 64 + nt * 16 + fr) * kstr + (kk * 32 + g * 8) * 2);
#pragma unroll
                for (int mt = 0; mt < 2; ++mt) s[mt][nt] = __builtin_amdgcn_mfma_f32_16x16x32_bf16(kf, qf[mt][kk], s[mt][nt], 0, 0, 0);
            }
#pragma unroll
        for (int mt = 0; mt < 2; ++mt) {
            float rm = -INFINITY;
#pragma unroll
            for (int nt = 0; nt < 4; ++nt)
#pragma unroll
                for (int e = 0; e < 4; ++e) {
                    float v = s[mt][nt][e] * c2;
                    if (SWA) { const int sidx = kt * 64 + nt * 16 + g * 4 + e, t = t0 + mt * 16 + fr;
                        const bool valid = (sidx > t) && (sidx <= t + 128) && (!first_blk || sidx >= 128); v = valid ? v : -INFINITY; }
                    s[mt][nt][e] = v; rm = fmaxf(rm, v);
                }
            rm = fmaxf(rm, __shfl_xor(rm, 16)); rm = fmaxf(rm, __shfl_xor(rm, 32));
            const float mn = fmaxf(mrow[mt], rm);
            const float alpha = __builtin_amdgcn_exp2f(mrow[mt] - mn);
            float rs = 0.f;
#pragma unroll
            for (int nt = 0; nt < 4; ++nt)
#pragma unroll
                for (int e = 0; e < 4; ++e) { const float p = __builtin_amdgcn_exp2f(s[mt][nt][e] - mn); s[mt][nt][e] = p; rs += p; }
            rs += __shfl_xor(rs, 16); rs += __shfl_xor(rs, 32);
            lrow[mt] = lrow[mt] * alpha + rs; mrow[mt] = mn;
#pragma unroll
            for (int dt = 0; dt < HD / 16; ++dt) o[mt][dt] *= alpha;
        }
        bf16x8 pf[2][2];
#pragma unroll
        for (int mt = 0; mt < 2; ++mt)
#pragma unroll
            for (int k2 = 0; k2 < 2; ++k2) {
                u32x4 w; w.x = cvt_pk_bf16(s[mt][2 * k2][0], s[mt][2 * k2][1]); w.y = cvt_pk_bf16(s[mt][2 * k2][2], s[mt][2 * k2][3]);
                w.z = cvt_pk_bf16(s[mt][2 * k2 + 1][0], s[mt][2 * k2 + 1][1]); w.w = cvt_pk_bf16(s[mt][2 * k2 + 1][2], s[mt][2 * k2 + 1][3]);
                pf[mt][k2] = __builtin_bit_cast(bf16x8, w);
            }
#pragma unroll
        for (int dt = 0; dt < HD / 16; ++dt)
#pragma unroll
            for (int k2 = 0; k2 < 2; ++k2) {
                const LAS unsigned char* vblk = Vt + (kt * 64 + k2 * 32 + g * 4 + (fr >> 2)) * vstr + (dt * 16 + (fr & 3) * 4) * 2;
                const s16x4 lo = tr_read(vblk), hi = tr_read(vblk + 16 * vstr);
                const bf16x8 vf = __builtin_shufflevector(lo, hi, 0, 1, 2, 3, 4, 5, 6, 7);
#pragma unroll
                for (int mt = 0; mt < 2; ++mt) o[mt][dt] = __builtin_amdgcn_mfma_f32_16x16x32_bf16(vf, pf[mt][k2], o[mt][dt], 0, 0, 0);
            }
    }
#pragma unroll
    for (int mt = 0; mt < 2; ++mt) { const float inv = 1.0f / lrow[mt];
#pragma unroll
        for (int dt = 0; dt < HD / 16; ++dt) o[mt][dt] *= inv; }
}

__device__ __forceinline__ void vt_scatter(LAS unsigned char* Vt, int vstr, int d0, int key, u32x4 v) {
    LAS unsigned char* p = Vt + d0 * vstr + key * 2;
    *(LAS bf16*)(p + 0 * vstr) = (bf16)(v.x & 0xffffu); *(LAS bf16*)(p + 1 * vstr) = (bf16)(v.x >> 16);
    *(LAS bf16*)(p + 2 * vstr) = (bf16)(v.y & 0xffffu); *(LAS bf16*)(p + 3 * vstr) = (bf16)(v.y >> 16);
    *(LAS bf16*)(p + 4 * vstr) = (bf16)(v.z & 0xffffu); *(LAS bf16*)(p + 5 * vstr) = (bf16)(v.z >> 16);
    *(LAS bf16*)(p + 6 * vstr) = (bf16)(v.w & 0xffffu); *(LAS bf16*)(p + 7 * vstr) = (bf16)(v.w >> 16);
}

__device__ __forceinline__ void swa_unit(int unit, const GAS bf16* proj, const GAS float* sinks_l, GAS bf16* Y, LAS unsigned char* lds, int tid) {
    const int b = unit >> 6, kvh = (unit >> 4) & 3, blk = unit & 15;
    const int lane = tid & 63, w = __builtin_amdgcn_readfirstlane(tid >> 6), fr = lane & 15, g = lane >> 4;
    constexpr int KSTR = 144, VSTR = 160;
    LAS unsigned char* Ks = lds; LAS unsigned char* Vt = lds + 256 * KSTR;
    __syncthreads();
#pragma unroll
    for (int i = 0; i < 4; ++i) { const int c = tid + NTHR * i, key = c >> 3, part = c & 7;
        const int tok = (blk == 0) ? (key & 127) : (blk - 1) * 128 + key;
        const GAS bf16* src = proj + (size_t)(b * SEQ + tok) * INW + kvh * 64 + part * 8;
        const u32x4 kv = *(const GAS u32x4*)(src + C_KA); const u32x4 vv = *(const GAS u32x4*)(src + C_VA);
        *(LAS u32x4*)(Ks + key * KSTR + part * 16) = kv; *(LAS u32x4*)(Vt + key * VSTR + part * 16) = vv; }
    __syncthreads();
    const int head = kvh * 4 + (w >> 1), half = w & 1;
    const float sink2 = sinks_l[head] * LOG2E;
    for (int pass = 0; pass < 2; ++pass) {
        const int t0 = half * 64 + pass * 32;
        bf16x8 qf[2][2];
#pragma unroll
        for (int mt = 0; mt < 2; ++mt)
#pragma unroll
            for (int kk = 0; kk < 2; ++kk) qf[mt][kk] = *(const GAS bf16x8*)(proj + (size_t)(b * SEQ + blk * 128 + t0 + mt * 16 + fr) * INW + C_QA + head * 64 + kk * 32 + g * 8);
        int kt_lo = (t0 + 1) >> 6; const int kt_hi = (t0 + 159) >> 6; if (blk == 0 && kt_lo < 2) kt_lo = 2;
        f32x4 o[2][4];
        attn_wave32<64, true>(Ks, KSTR, Vt, VSTR, qf, o, sink2, 1.0f, 0.125f * LOG2E, kt_lo, kt_hi, t0, blk == 0, lane);
#pragma unroll
        for (int mt = 0; mt < 2; ++mt)
#pragma unroll
            for (int dt = 0; dt < 4; ++dt) { u32x2 wv; wv.x = cvt_pk_bf16(o[mt][dt][0], o[mt][dt][1]); wv.y = cvt_pk_bf16(o[mt][dt][2], o[mt][dt][3]);
                *(GAS u32x2*)(Y + (size_t)(b * SEQ + blk * 128 + t0 + mt * 16 + fr) * YW + head * 64 + dt * 16 + g * 4) = wv; }
    }
}

__device__ __forceinline__ void xattn_unit(int unit, int l, const GAS bf16* KV, const GAS bf16* XQ, GAS bf16* XO, LAS unsigned char* lds, int tid) {
    const int b = unit >> 5, head = (unit >> 3) & 3, qb = unit & 7;
    const int lane = tid & 63, w = __builtin_amdgcn_readfirstlane(tid >> 6), fr = lane & 15, g = lane >> 4;
    constexpr int KSTR = 272, VSTR = 288;
    LAS unsigned char* Ks = lds; LAS unsigned char* Vt = lds + 256 * KSTR;
    __syncthreads();
#pragma unroll
    for (int i = 0; i < 8; ++i) { const int c = tid + NTHR * i, key = c >> 4, part = c & 15;
        const GAS bf16* src = KV + (size_t)(b * MEML + key) * 4096 + l * 1024 + head * 128 + part * 8;
        const u32x4 kv = *(const GAS u32x4*)src; const u32x4 vv = *(const GAS u32x4*)(src + 512);
        *(LAS u32x4*)(Ks + key * KSTR + part * 16) = kv; *(LAS u32x4*)(Vt + key * VSTR + part * 16) = vv; }
    __syncthreads();
    const size_t row0 = (size_t)b * SEQ + qb * 256 + w * 32;
    bf16x8 qf[2][4];
#pragma unroll
    for (int mt = 0; mt < 2; ++mt)
#pragma unroll
        for (int kk = 0; kk < 4; ++kk) qf[mt][kk] = *(const GAS bf16x8*)(XQ + (row0 + mt * 16 + fr) * XD + head * 128 + kk * 32 + g * 8);
    f32x4 o[2][8];
    attn_wave32<128, false>(Ks, KSTR, Vt, VSTR, qf, o, -INFINITY, 0.0f, 0.08838834764831845f * LOG2E, 0, 3, 0, false, lane);
#pragma unroll
    for (int mt = 0; mt < 2; ++mt)
#pragma unroll
        for (int dt = 0; dt < 8; ++dt) { u32x2 wv; wv.x = cvt_pk_bf16(o[mt][dt][0], o[mt][dt][1]); wv.y = cvt_pk_bf16(o[mt][dt][2], o[mt][dt][3]);
            *(GAS u32x2*)(XO + (row0 + mt * 16 + fr) * XD + head * 128 + dt * 16 + g * 4) = wv; }
}

__device__ __forceinline__ void sgu_unit(int unit, const GAS bf16* proj, const GAS float* ln_g, const GAS float* ln_b, const GAS float* sw, const GAS float* sb, GAS bf16* Y, LAS unsigned char* lds, int tid) {
    const int b = unit >> 4, c = unit & 15;
    const int lane = tid & 63, w = __builtin_amdgcn_readfirstlane(tid >> 6), fr = lane & 15, g = lane >> 4;
    constexpr int VSTR = 288, WSTR = 272;
    LAS unsigned char* VN = lds; LAS unsigned char* Ws = lds + 128 * VSTR; LAS float* stat = (LAS float*)(lds + 128 * VSTR + 128 * WSTR);
    const size_t tok0 = (size_t)b * SEQ + c * 128;
    __syncthreads();
    for (int bt = 0; bt < 2; ++bt) {
        u32x4 a0[8], a1[8];
#pragma unroll
        for (int i = 0; i < 8; ++i) { const GAS bf16* src = proj + (tok0 + w * 16 + bt * 8 + i) * INW + C_VB + lane * 16; a0[i] = *(const GAS u32x4*)src; a1[i] = *(const GAS u32x4*)(src + 8); }
        float s1[8], s2[8];
#pragma unroll
        for (int i = 0; i < 8; ++i) { float x[16];
            x[0] = geluf_(bf_lo(a0[i].x)); x[1] = geluf_(bf_hi(a0[i].x)); x[2] = geluf_(bf_lo(a0[i].y)); x[3] = geluf_(bf_hi(a0[i].y));
            x[4] = geluf_(bf_lo(a0[i].z)); x[5] = geluf_(bf_hi(a0[i].z)); x[6] = geluf_(bf_lo(a0[i].w)); x[7] = geluf_(bf_hi(a0[i].w));
            x[8] = geluf_(bf_lo(a1[i].x)); x[9] = geluf_(bf_hi(a1[i].x)); x[10] = geluf_(bf_lo(a1[i].y)); x[11] = geluf_(bf_hi(a1[i].y));
            x[12] = geluf_(bf_lo(a1[i].z)); x[13] = geluf_(bf_hi(a1[i].z)); x[14] = geluf_(bf_lo(a1[i].w)); x[15] = geluf_(bf_hi(a1[i].w));
            float p1 = 0.f, p2 = 0.f;
#pragma unroll
            for (int e = 0; e < 16; ++e) { p1 += x[e]; p2 += x[e] * x[e]; }
            s1[i] = p1; s2[i] = p2; }
#pragma unroll
        for (int o = 1; o < 64; o <<= 1)
#pragma unroll
            for (int i = 0; i < 8; ++i) { s1[i] += __shfl_xor(s1[i], o); s2[i] += __shfl_xor(s2[i], o); }
        if (lane < 8) { float m1 = s1[0], m2 = s2[0];
#pragma unroll
            for (int i = 1; i < 8; ++i) { m1 = (lane == i) ? s1[i] : m1; m2 = (lane == i) ? s2[i] : m2; }
            const float mean = m1 * (1.f / 1024.f); const float var = fmaxf(m2 * (1.f / 1024.f) - mean * mean, 0.f);
            const int s = w * 16 + bt * 8 + lane; stat[2 * s] = mean; stat[2 * s + 1] = __builtin_amdgcn_rsqf(var + EPS); }
    }
    u32x4 va[4]; f32x4 wv[8]; u32x2 uu[8];
#define SGU_LOAD(gg) do { _Pragma("unroll") for (int i = 0; i < 4; ++i) { const int cc = tid + NTHR * i, s = cc >> 4, part = cc & 15; va[i] = *(const GAS u32x4*)(proj + (tok0 + s) * INW + C_VB + (gg) * 128 + part * 8); } \
        _Pragma("unroll") for (int i = 0; i < 8; ++i) { const int idx = tid + NTHR * i; wv[i] = *(const GAS f32x4*)(sw + (size_t)(gg) * 16384 + idx * 4); } \
        _Pragma("unroll") for (int et = 0; et < 8; ++et) uu[et] = *(const GAS u32x2*)(proj + (tok0 + w * 16 + fr) * INW + C_UB + (gg) * 128 + et * 16 + g * 4); } while (0)
    SGU_LOAD(0);
    __syncthreads();
    for (int grp = 0; grp < 8; ++grp) {
#pragma unroll
        for (int i = 0; i < 4; ++i) { const int cc = tid + NTHR * i, s = cc >> 4, part = cc & 15; const int ch = grp * 128 + part * 8;
            const f32x4 g0 = *(const GAS f32x4*)(ln_g + ch), g1 = *(const GAS f32x4*)(ln_g + ch + 4), b0 = *(const GAS f32x4*)(ln_b + ch), b1 = *(const GAS f32x4*)(ln_b + ch + 4);
            const float mean = stat[2 * s], rstd = stat[2 * s + 1]; const u32x4 a0 = va[i];
            float y[8];
            y[0] = (geluf_(bf_lo(a0.x)) - mean) * rstd * g0.x + b0.x; y[1] = (geluf_(bf_hi(a0.x)) - mean) * rstd * g0.y + b0.y;
            y[2] = (geluf_(bf_lo(a0.y)) - mean) * rstd * g0.z + b0.z; y[3] = (geluf_(bf_hi(a0.y)) - mean) * rstd * g0.w + b0.w;
            y[4] = (geluf_(bf_lo(a0.z)) - mean) * rstd * g1.x + b1.x; y[5] = (geluf_(bf_hi(a0.z)) - mean) * rstd * g1.y + b1.y;
            y[6] = (geluf_(bf_lo(a0.w)) - mean) * rstd * g1.z + b1.z; y[7] = (geluf_(bf_hi(a0.w)) - mean) * rstd * g1.w + b1.w;
            u32x4 pk; pk.x = cvt_pk_bf16(y[0], y[1]); pk.y = cvt_pk_bf16(y[2], y[3]); pk.z = cvt_pk_bf16(y[4], y[5]); pk.w = cvt_pk_bf16(y[6], y[7]);
            *(LAS u32x4*)(VN + s * VSTR + part * 16) = pk; }
#pragma unroll
        for (int i = 0; i < 8; ++i) { const int idx = tid + NTHR * i, t = idx >> 5, s4 = (idx & 31) * 4; f32x4 x = wv[i];
            x.x = (s4 + 0 <= t) ? x.x : 0.f; x.y = (s4 + 1 <= t) ? x.y : 0.f; x.z = (s4 + 2 <= t) ? x.z : 0.f; x.w = (s4 + 3 <= t) ? x.w : 0.f;
            u32x2 pk; pk.x = cvt_pk_bf16(x.x, x.y); pk.y = cvt_pk_bf16(x.z, x.w);
            *(LAS u32x2*)(Ws + t * WSTR + s4 * 2) = pk; }
        u32x2 uc[8];
#pragma unroll
        for (int et = 0; et < 8; ++et) uc[et] = uu[et];
        __syncthreads();
        if (grp + 1 < 8) SGU_LOAD(grp + 1);
        f32x4 acc[8];
#pragma unroll
        for (int et = 0; et < 8; ++et) acc[et] = (f32x4){0.f, 0.f, 0.f, 0.f};
        const int nkk = ((w * 16 + 15) >> 5) + 1;
        for (int kk = 0; kk < nkk; ++kk) {
            const LAS unsigned char* wrow = Ws + (w * 16 + fr) * WSTR + (kk * 32 + g * 4) * 2;
            const u32x2 ylo = *(const LAS u32x2*)wrow, yhi = *(const LAS u32x2*)(wrow + 32);
            u32x4 yw; yw.x = ylo.x; yw.y = ylo.y; yw.z = yhi.x; yw.w = yhi.y; const bf16x8 yf = __builtin_bit_cast(bf16x8, yw);
#pragma unroll
            for (int et = 0; et < 8; ++et) { const LAS unsigned char* vblk = VN + (kk * 32 + g * 4 + (fr >> 2)) * VSTR + (et * 16 + (fr & 3) * 4) * 2;
                const s16x4 lo = tr_read(vblk), hi = tr_read(vblk + 16 * VSTR);
                acc[et] = __builtin_amdgcn_mfma_f32_16x16x32_bf16(__builtin_shufflevector(lo, hi, 0, 1, 2, 3, 4, 5, 6, 7), yf, acc[et], 0, 0, 0); }
        }
        const int t = w * 16 + fr; const float bias = sb[grp * 128 + t];
#pragma unroll
        for (int et = 0; et < 8; ++et) { const int ch = grp * 128 + et * 16 + g * 4; const u32x2 u2 = uc[et];
            const float o0 = geluf_(bf_lo(u2.x)) * (acc[et][0] + bias), o1 = geluf_(bf_hi(u2.x)) * (acc[et][1] + bias), o2 = geluf_(bf_lo(u2.y)) * (acc[et][2] + bias), o3 = geluf_(bf_hi(u2.y)) * (acc[et][3] + bias);
            u32x2 wo; wo.x = cvt_pk_bf16(o0, o1); wo.y = cvt_pk_bf16(o2, o3);
            *(GAS u32x2*)(Y + (tok0 + t) * YW + 1024 + ch) = wo; }
        __syncthreads();
    }
#undef SGU_LOAD
}

__device__ __forceinline__ void hgrn_unit(int unit, int l, const GAS bf16* proj, const GAS float* hgrn_lb, const GAS float* norm_g, GAS bf16* Y, LAS unsigned char* lds, int tid) {
    const int b = unit >> 3, h = unit & 7;
    const int lane = tid & 63, w = __builtin_amdgcn_readfirstlane(tid >> 6), fr = lane & 15, g = lane >> 4;
    const int d = tid & 127, J = tid >> 7, Ju = w >> 1;
    constexpr int RS = 272, TS = 144;
    LAS unsigned char* U = lds; LAS unsigned char* Wm = lds + 17408; LAS unsigned char* Qe = lds + 60928; LAS unsigned char* KeT = lds + 78336; LAS unsigned char* VT = lds + 96768;
    LAS unsigned char* Am = lds + 115200; LAS float* Gs = (LAS float*)(lds + 124416); LAS float* DEC = (LAS float*)(lds + 126464); LAS float* SS = (LAS float*)(lds + 126976);
    const int ch = h * 128 + d;
    float lb;
    { const float v0 = hgrn_lb[ch], v1 = hgrn_lb[1024 + ch], v2 = hgrn_lb[2048 + ch], v3 = hgrn_lb[3072 + ch];
      const float mx = fmaxf(fmaxf(v0, v1), fmaxf(v2, v3));
      const float e0 = __expf(v0 - mx), e1 = __expf(v1 - mx), e2 = __expf(v2 - mx), e3 = __expf(v3 - mx); const float inv = 1.0f / (e0 + e1 + e2 + e3);
      lb = (l >= 1 ? e1 * inv : 0.f) + (l >= 2 ? e2 * inv : 0.f) + (l >= 3 ? e3 * inv : 0.f); }
    __syncthreads();
    for (int i = tid; i < 9216 / 4; i += NTHR) ((LAS unsigned*)Am)[i] = 0u;
    f32x4 st[8];
#pragma unroll
    for (int dt = 0; dt < 8; ++dt) st[dt] = (f32x4){0.f, 0.f, 0.f, 0.f};
    const int wbase[4] = {0, 16, 48, 96};
    const int base_J = (J == 0) ? 0 : (J == 1) ? 16 : (J == 2) ? 48 : 96;
    (void)wbase;
    const GAS bf16* pb = proj + (size_t)b * SEQ * INW;
    const f32x4 ngv = *(const GAS f32x4*)(norm_g + w * 16 + g * 4);
    unsigned fraw[16], qraw[16], iraw[16];
#define HG_LOAD(cc) do { unsigned lo_ = (unsigned)lane * 2u; asm volatile("" : "+v"(lo_)); \
        const GAS char* cb_ = (const GAS char*)pb + ((size_t)((cc) * 64 + 16 * Ju) * INW + h * 128 + (w & 1) * 64) * 2; \
        _Pragma("unroll") for (int tt = 0; tt < 16; ++tt) { const GAS char* rb_ = cb_ + (size_t)tt * (INW * 2); \
        fraw[tt] = *(const GAS bf16*)(rb_ + C_FC * 2 + lo_); qraw[tt] = *(const GAS bf16*)(rb_ + C_QC * 2 + lo_); iraw[tt] = *(const GAS bf16*)(rb_ + C_IC * 2 + lo_); } } while (0)
    HG_LOAD(0);
    for (int c = 0; c < 32; ++c) {
        const int tok0 = c * 64;
        float f[16], qs[16]; unsigned vraw[8];
        {
            float gp = 1.f;
#pragma unroll
            for (int tt = 0; tt < 16; ++tt) {
                const float fl = __builtin_bit_cast(float, fraw[tt] << 16), qv = __builtin_bit_cast(float, qraw[tt] << 16); const unsigned iv = iraw[tt];
                f[tt] = lb + (1.f - lb) * sigmoidf_(fl); qs[tt] = siluf_(qv) * 0.08838834764831845f; gp *= f[tt];
                if (tt & 1) vraw[tt >> 1] |= iv << 16; else vraw[tt >> 1] = iv; }
            Gs[J * 128 + d] = gp;
        }
        __syncthreads();
        {
            const float G0 = Gs[d], G1 = Gs[128 + d], G2 = Gs[256 + d], G3 = Gs[384 + d];
            const float EJ = (J == 0) ? 1.f : (J == 1) ? G0 : (J == 2) ? G0 * G1 : G0 * G1 * G2;
            const float TJ = (J == 0) ? G1 * G2 * G3 : (J == 1) ? G2 * G3 : (J == 2) ? G3 : 1.f;
            if (J == 0) DEC[d] = G0 * G1 * G2 * G3;
            *(LAS u32x4*)(VT + d * TS + J * 32) = (u32x4){vraw[0], vraw[1], vraw[2], vraw[3]};
            *(LAS u32x4*)(VT + d * TS + J * 32 + 16) = (u32x4){vraw[4], vraw[5], vraw[6], vraw[7]};
            float p = 1.f;
#pragma unroll
            for (int tt = 0; tt < 16; ++tt) { p *= f[tt]; const float u = qs[tt] * p; const int t = 16 * J + tt;
                *(LAS bf16*)(U + t * RS + d * 2) = (bf16)(cvt_pk_bf16(u, 0.f) & 0xffffu);
                *(LAS bf16*)(Qe + t * RS + d * 2) = (bf16)(cvt_pk_bf16(u * EJ, 0.f) & 0xffffu);
                const float kd = (1.f - f[tt]) / fmaxf(p, 1e-30f);
                *(LAS bf16*)(Wm + (base_J + t) * RS + d * 2) = (bf16)(cvt_pk_bf16(kd, 0.f) & 0xffffu); }
            float sfx = 1.f; unsigned kep[8];
#pragma unroll
            for (int tt = 15; tt >= 0; --tt) { const float ks = (1.f - f[tt]) * sfx; sfx *= f[tt]; const int t = 16 * J + tt;
                if (J == 0) { *(LAS bf16*)(Wm + (16 + t) * RS + d * 2) = (bf16)(cvt_pk_bf16(ks, 0.f) & 0xffffu);
                              *(LAS bf16*)(Wm + (48 + t) * RS + d * 2) = (bf16)(cvt_pk_bf16(ks * G1, 0.f) & 0xffffu);
                              *(LAS bf16*)(Wm + (96 + t) * RS + d * 2) = (bf16)(cvt_pk_bf16(ks * G1 * G2, 0.f) & 0xffffu); }
                else if (J == 1) { *(LAS bf16*)(Wm + (48 + t) * RS + d * 2) = (bf16)(cvt_pk_bf16(ks, 0.f) & 0xffffu);
                                   *(LAS bf16*)(Wm + (96 + t) * RS + d * 2) = (bf16)(cvt_pk_bf16(ks * G2, 0.f) & 0xffffu); }
                else if (J == 2) { *(LAS bf16*)(Wm + (96 + t) * RS + d * 2) = (bf16)(cvt_pk_bf16(ks, 0.f) & 0xffffu); }
                const unsigned kb = cvt_pk_bf16(ks * TJ, 0.f) & 0xffffu;
                if (tt & 1) kep[tt >> 1] = kb << 16; else kep[tt >> 1] |= kb; }
            *(LAS u32x4*)(KeT + d * TS + J * 32) = (u32x4){kep[0], kep[1], kep[2], kep[3]};
            *(LAS u32x4*)(KeT + d * TS + J * 32 + 16) = (u32x4){kep[4], kep[5], kep[6], kep[7]};
        }
        __syncthreads();
        if (c + 1 < 32) HG_LOAD(c + 1);
        __builtin_amdgcn_sched_barrier(0);
        for (int ti = w; ti < 10; ti += 8) {
            const int I = (ti == 0) ? 0 : (ti < 3) ? 1 : (ti < 6) ? 2 : 3; const int Jt = ti - ((I * (I + 1)) >> 1);
            const int bI = (I == 0) ? 0 : (I == 1) ? 16 : (I == 2) ? 48 : 96;
            f32x4 a = (f32x4){0.f, 0.f, 0.f, 0.f};
#pragma unroll
            for (int kk = 0; kk < 4; ++kk) { const bf16x8 xf = *(const LAS bf16x8*)(Wm + (bI + 16 * Jt + fr) * RS + (kk * 32 + g * 8) * 2);
                const bf16x8 yf = *(const LAS bf16x8*)(U + (16 * I + fr) * RS + (kk * 32 + g * 8) * 2);
                a = __builtin_amdgcn_mfma_f32_16x16x32_bf16(xf, yf, a, 0, 0, 0); }
            if (Jt == I) {
#pragma unroll
                for (int e = 0; e < 4; ++e) a[e] = (4 * g + e > fr) ? 0.f : a[e]; }
            u32x2 pk; pk.x = cvt_pk_bf16(a[0], a[1]); pk.y = cvt_pk_bf16(a[2], a[3]);
            *(LAS u32x2*)(Am + (16 * I + fr) * TS + (16 * Jt + 4 * g) * 2) = pk;
        }
        f32x4 o[4];
#pragma unroll
        for (int tt = 0; tt < 4; ++tt) o[tt] = (f32x4){0.f, 0.f, 0.f, 0.f};
#pragma unroll
        for (int kk = 0; kk < 4; ++kk) {
            u32x4 sw; sw.x = cvt_pk_bf16(st[2 * kk][0], st[2 * kk][1]); sw.y = cvt_pk_bf16(st[2 * kk][2], st[2 * kk][3]);
            sw.z = cvt_pk_bf16(st[2 * kk + 1][0], st[2 * kk + 1][1]); sw.w = cvt_pk_bf16(st[2 * kk + 1][2], st[2 * kk + 1][3]);
            const bf16x8 sx = __builtin_bit_cast(bf16x8, sw);
#pragma unroll
            for (int tt = 0; tt < 4; ++tt) { const LAS unsigned char* qrow = Qe + (16 * tt + fr) * RS + (kk * 32 + g * 4) * 2;
                const u32x2 lo = *(const LAS u32x2*)qrow, hi = *(const LAS u32x2*)(qrow + 32);
                u32x4 qw; qw.x = lo.x; qw.y = lo.y; qw.z = hi.x; qw.w = hi.y;
                o[tt] = __builtin_amdgcn_mfma_f32_16x16x32_bf16(sx, __builtin_bit_cast(bf16x8, qw), o[tt], 0, 0, 0); }
        }
        __syncthreads();
        u32x2 ggv[4];
#pragma unroll
        for (int tt = 0; tt < 4; ++tt) ggv[tt] = *(const GAS u32x2*)(proj + ((size_t)b * SEQ + tok0 + 16 * tt + fr) * INW + C_GC + h * 128 + w * 16 + g * 4);
        bf16x8 vfr[2];
#pragma unroll
        for (int kk = 0; kk < 2; ++kk) vfr[kk] = *(const LAS bf16x8*)(VT + (16 * w + fr) * TS + (kk * 32 + g * 8) * 2);
#pragma unroll
        for (int tt = 0; tt < 4; ++tt)
#pragma unroll
            for (int kk = 0; kk < 2; ++kk) if (kk <= (tt >> 1)) {
                const bf16x8 yf = *(const LAS bf16x8*)(Am + (16 * tt + fr) * TS + (kk * 32 + g * 8) * 2);
                o[tt] = __builtin_amdgcn_mfma_f32_16x16x32_bf16(vfr[kk], yf, o[tt], 0, 0, 0); }
#pragma unroll
        for (int dt = 0; dt < 8; ++dt) { const f32x4 dec = *(const LAS f32x4*)(DEC + 16 * dt + 4 * g); st[dt] *= dec;
#pragma unroll
            for (int kk = 0; kk < 2; ++kk) { const bf16x8 xf = *(const LAS bf16x8*)(KeT + (16 * dt + fr) * TS + (kk * 32 + g * 8) * 2);
                st[dt] = __builtin_amdgcn_mfma_f32_16x16x32_bf16(xf, vfr[kk], st[dt], 0, 0, 0); } }
#pragma unroll
        for (int tt = 0; tt < 4; ++tt) { float q2 = o[tt][0] * o[tt][0] + o[tt][1] * o[tt][1] + o[tt][2] * o[tt][2] + o[tt][3] * o[tt][3];
            q2 += __shfl_xor(q2, 16); q2 += __shfl_xor(q2, 32);
            if (g == 0) SS[w * 64 + 16 * tt + fr] = q2; }
        __syncthreads();
#pragma unroll
        for (int tt = 0; tt < 4; ++tt) { const int t = 16 * tt + fr; float tot = 0.f;
#pragma unroll
            for (int ww = 0; ww < 8; ++ww) tot += SS[ww * 64 + t];
            const float rstd = __builtin_amdgcn_rsqf(tot * (1.f / 128.f) + EPS);
            const size_t tok = (size_t)b * SEQ + tok0 + t; const int e0 = h * 128 + w * 16 + g * 4;
            const u32x2 gg = ggv[tt];
            const float y0 = o[tt][0] * rstd * ngv.x * siluf_(bf_lo(gg.x)), y1 = o[tt][1] * rstd * ngv.y * siluf_(bf_hi(gg.x));
            const float y2 = o[tt][2] * rstd * ngv.z * siluf_(bf_lo(gg.y)), y3 = o[tt][3] * rstd * ngv.w * siluf_(bf_hi(gg.y));
            u32x2 wv; wv.x = cvt_pk_bf16(y0, y1); wv.y = cvt_pk_bf16(y2, y3);
            *(GAS u32x2*)(Y + tok * YW + 2048 + e0) = wv; }
    }
#undef HG_LOAD
}
#ifndef MK_MULTI
#define MK_MULTI 0
#endif
#ifndef PH_MASK
#define PH_MASK 0xFFFFF
#endif
#define HASP(p) (((PH_MASK) >> (p)) & 1)
#ifndef DUP_MASK
#define DUP_MASK 0
#endif
#define DUPP(p) (((DUP_MASK) >> (p)) & 1)
constexpr int NPH_LAYER = 12, NPH = NL * NPH_LAYER + 1;
struct Args { const float* in[25]; float* out; unsigned char* ws; int ph_lo, ph_hi; };
enum { I_X = 0, I_MEM, I_NORM_MIX, I_W_IN, I_W_GATE, I_SINKS, I_SGU_LN_G, I_SGU_LN_B, I_SGU_W, I_SGU_B, I_HGRN_LB, I_HGRN_NORM, I_W_BR_A, I_W_BR_B, I_W_BR_C, I_W_OUT, I_NORM_X, I_MEM_NORM,
       I_W_XQ, I_W_XKV, I_W_XO, I_NORM_FFN, I_W_FFN_IN, I_W_FFN_OUT, I_FINAL_NORM };

#define CIN(i) ((const GAS float*)(((uintptr_t)(unsigned)__builtin_amdgcn_readfirstlane((int)lctl[17 + 2 * (i)]) << 32) | (uintptr_t)(unsigned)__builtin_amdgcn_readfirstlane((int)lctl[16 + 2 * (i)])))
__device__ __forceinline__ void conv_phase(volatile LAS unsigned* lctl, int l, GAS unsigned char* ws, LAS float* scr, int gw, int NGW, int lane) {
    constexpr int I_IN = 32 * 240, I_GT = 32 * 192, I_BR = 16 * 64, I_OUT = 32 * 64, I_XQ = 32 * 16, I_XO = 8 * 64, I_F1 = 32 * 352, I_F2 = 88 * 64;
    constexpr int NITEMS = I_IN + I_GT + 3 * I_BR + I_OUT + I_XQ + I_XO + I_F1 + I_F2;
    GAS bf16* cWcat = (GAS bf16*)(ws + WS_WCAT); GAS bf16* cWbr = (GAS bf16*)(ws + WS_WBR); GAS bf16* cWout = (GAS bf16*)(ws + WS_WOUT); GAS bf16* cWxq = (GAS bf16*)(ws + WS_WXQ); GAS bf16* cWxo = (GAS bf16*)(ws + WS_WXO);
    GAS bf16* cWf1 = (GAS bf16*)(ws + WS_WF1); GAS bf16* cWf2 = (GAS bf16*)(ws + WS_WF2);
    for (int it = gw; it < NITEMS; it += NGW) {
        int r = it;
        if (r < I_IN) { const int kb = r / 240, nb = r % 240; tr_item(CIN(I_W_IN) + (size_t)l * DM * INW, INW, cWcat, DM, 64 * kb, 32 * nb, 32 * nb, scr, lane, CIN(I_NORM_MIX) + l * DM); continue; } r -= I_IN;
        if (r < I_GT) { const int kb = r / 192, nb = r % 192; tr_item(CIN(I_W_GATE) + (size_t)l * DM * GW, GW, cWcat, DM, 64 * kb, 32 * nb, INW + 32 * nb, scr, lane, CIN(I_NORM_MIX) + l * DM); continue; } r -= I_GT;
        if (r < 3 * I_BR) { const int j = r / I_BR, q = r % I_BR, kb = q / 64, nb = q % 64;
            tr_item(CIN(I_W_BR_A + j) + (size_t)l * 1024 * DM, DM, cWbr + (size_t)j * DM * 1024, 1024, 64 * kb, 32 * nb, 32 * nb, scr, lane); continue; } r -= 3 * I_BR;
        if (r < I_OUT) { const int kb = r / 64, nb = r % 64; tr_item(CIN(I_W_OUT) + (size_t)l * DM * DM, DM, cWout, DM, 64 * kb, 32 * nb, 32 * nb, scr, lane); continue; } r -= I_OUT;
        if (r < I_XQ) { const int kb = r / 16, nb = r % 16; tr_item(CIN(I_W_XQ) + (size_t)l * DM * XD, XD, cWxq, DM, 64 * kb, 32 * nb, 32 * nb, scr, lane, CIN(I_NORM_X) + l * DM); continue; } r -= I_XQ;
        if (r < I_XO) { const int kb = r / 64, nb = r % 64; tr_item(CIN(I_W_XO) + (size_t)l * XD * DM, DM, cWxo, XD, 64 * kb, 32 * nb, 32 * nb, scr, lane); continue; } r -= I_XO;
        if (r < I_F1) { const int kb = r / 352, nb = r % 352; const int n0 = 32 * nb; const int cc = (n0 < DFF) ? n0 : n0 - DFF; const int drow = 256 * (cc >> 7) + (cc & 127) + ((n0 < DFF) ? 0 : 128);
            tr_item(CIN(I_W_FFN_IN) + (size_t)l * DM * 2 * DFF, 2 * DFF, cWf1, DM, 64 * kb, n0, drow, scr, lane, CIN(I_NORM_FFN) + l * DM); continue; } r -= I_F1;
        { const int kb = r / 64, nb = r % 64; tr_item(CIN(I_W_FFN_OUT) + (size_t)l * DFF * DM, DM, cWf2, DFF, 64 * kb, 32 * nb, 32 * nb, scr, lane); }
    }
    if (l == 0) {
        GAS bf16* cWxkv = (GAS bf16*)(ws + WS_WXKV);
        for (int it = gw; it < 4 * 1024; it += NGW) { const int ll = it >> 10, q = it & 1023, kb = q >> 5, nb = q & 31;
            tr_item(CIN(I_W_XKV) + (size_t)ll * DM * 1024, 1024, cWxkv, DM, 64 * kb, 32 * nb, ll * 1024 + 32 * nb, scr, lane); }
        norm_phase(CIN(I_MEM), CIN(I_MEM_NORM), (GAS bf16*)(ws + WS_MEMN), MT, gw, NGW, lane);
    }
}

__global__ void __launch_bounds__(NTHR, 2) fwd_kernel(Args a) {
    extern __shared__ __attribute__((aligned(16))) unsigned char lds_raw[];
    LAS unsigned char* lds = (LAS unsigned char*)lds_raw;
    volatile LAS unsigned* lctl = (volatile LAS unsigned*)(lds + LDSCTL_OFF);
    const int tid0 = threadIdx.x;
    const int G = gridDim.x, bx = blockIdx.x;
    unsigned* ctl0 = (unsigned*)(a.ws + WS_CTL);
    for (int u = tid0; u < (LDS_BYTES - LDSCTL_OFF) / 4; u += NTHR) lctl[u] = 0u;
    __syncthreads();
    if (tid0 < 25) { lctl[16 + 2 * tid0] = (unsigned)(uintptr_t)a.in[tid0]; lctl[17 + 2 * tid0] = (unsigned)((uintptr_t)a.in[tid0] >> 32); }
    if (tid0 == 0) { lctl[8] = (unsigned)(uintptr_t)a.ws; lctl[9] = (unsigned)((uintptr_t)a.ws >> 32); lctl[10] = (unsigned)(uintptr_t)a.out; lctl[11] = (unsigned)((uintptr_t)a.out >> 32); }
    __syncthreads();
    const int lo = a.ph_lo, hi = a.ph_hi;
    XcdBarrier bar; bar.bar = ctl0 + CW_BAR; bar.x = 0; bar.st = nullptr;
    if (hi - lo > 1) bar = xcd_barrier_post(ctl0 + CW_BAR, lctl);
#define IN(k) (lo <= (k) && (k) < hi)
#define SEAM(k) do { if (IN(k) && IN((k) + 1)) xcd_barrier(bar); } while (0)

#define OPQ_PTR(TY, w) ((TY)(((uintptr_t)(unsigned)__builtin_amdgcn_readfirstlane((int)lctl[(w) + 1]) << 32) | (uintptr_t)(unsigned)__builtin_amdgcn_readfirstlane((int)lctl[(w)])))
#define PH_BEGIN int tid = threadIdx.x; asm volatile("" : "+v"(tid)); \
        GAS unsigned char* ws = OPQ_PTR(GAS unsigned char*, 8); GAS float* out = OPQ_PTR(GAS float*, 10); const int lane = tid & 63, wave = __builtin_amdgcn_readfirstlane(tid >> 6); const int gw = bx * NWAVES + wave, NGW = G * NWAVES; \
        (void)ws; (void)out; (void)lane; (void)gw; (void)NGW;
#define WSP(off) ((GAS bf16*)(ws + (off)))
#define GIN(i) OPQ_PTR(const GAS float*, 16 + 2 * (i))
    for (int l = 0; l < NL; ++l) {
        const int pb = l * NPH_LAYER;
        if (HASP(0) && IN(pb + 0)) for (int rep = 0; rep <= DUPP(0); ++rep) { if (rep) xcd_barrier(bar); PH_BEGIN
            conv_phase(lctl, l, ws, (LAS float*)(lds + wave * 16384), gw, NGW, lane);
            if (l == 0) xb_phase(GIN(I_X), WSP(WS_H), (GAS float*)(ws + WS_SS), gw, NGW, lane);
        }
        SEAM(pb + 0);
        if (HASP(1) && IN(pb + 1)) for (int rep = 0; rep <= DUPP(1); ++rep) { if (rep) xcd_barrier(bar); PH_BEGIN
            { pg8::PlainOrder S; S.init(T, NCAT, G, bx, WSP(WS_H), DM, WSP(WS_WCAT), DM); EpiCat E{WSP(WS_PROJ), WSP(WS_GATE), RowScale{(const GAS float*)(ws + WS_SS), (LAS float*)(lds + LDS_RSTD)}};
              pg8::gemm_phase(lds, pg8::GemmK{DM, DM, DM}, S, E); }
            if (l == 0) { pg8::PlainOrder S; S.init(MT, 4096, G, bx, WSP(WS_MEMN), DM, WSP(WS_WXKV), DM); EpiPlain<false> E{WSP(WS_KV), 4096, RowScale{nullptr, nullptr}};
              pg8::gemm_phase(lds, pg8::GemmK{DM, DM, DM}, S, E); }
        }
        SEAM(pb + 1);
        if (HASP(2) && IN(pb + 2)) for (int rep = 0; rep <= DUPP(2); ++rep) { if (rep) xcd_barrier(bar);
            for (int r2 = 0; r2 <= DUPP(16); ++r2) { PH_BEGIN unsigned* q = (unsigned*)(a.ws + WS_CTL) + CW_Q + 256 * l + 16 * rep + 8 * r2;
              for (;;) { __syncthreads(); if (tid == 0) lctl[4] = xb_add(q, 1u); __syncthreads(); const int idx = (int)lctl[4]; if (idx >= NB * 8) break;
                hgrn_unit(idx, l, WSP(WS_PROJ), GIN(I_HGRN_LB), GIN(I_HGRN_NORM) + l * 128, WSP(WS_Y), lds, tid); } }
            for (int r2 = 0; r2 <= DUPP(17); ++r2) { PH_BEGIN unsigned* q = (unsigned*)(a.ws + WS_CTL) + CW_Q + 256 * l + 16 * rep + 8 * r2;
              for (;;) { __syncthreads(); if (tid == 0) lctl[4] = xb_add(q + 64, 1u); __syncthreads(); const int idx = (int)lctl[4]; if (idx >= NB * 64) break;
                swa_unit(idx, WSP(WS_PROJ), GIN(I_SINKS) + l * 16, WSP(WS_Y), lds, tid); } }
            for (int r2 = 0; r2 <= DUPP(18); ++r2) { PH_BEGIN unsigned* q = (unsigned*)(a.ws + WS_CTL) + CW_Q + 256 * l + 16 * rep + 8 * r2;
              for (;;) { __syncthreads(); if (tid == 0) lctl[4] = xb_add(q + 128, 1u); __syncthreads(); const int idx = (int)lctl[4]; if (idx >= NB * 16) break;
                sgu_unit(idx, WSP(WS_PROJ), GIN(I_SGU_LN_G) + l * 1024, GIN(I_SGU_LN_B) + l * 1024, GIN(I_SGU_W) + (size_t)l * 8 * 16384, GIN(I_SGU_B) + l * 1024, WSP(WS_Y), lds, tid); } }
            __syncthreads();
        }
        SEAM(pb + 2);
        if (HASP(3) && IN(pb + 3)) for (int rep = 0; rep <= DUPP(3); ++rep) { if (rep) xcd_barrier(bar); PH_BEGIN
            pg8::PlainOrder S; S.init(T, DM, G, bx, WSP(WS_Y), YW, WSP(WS_WBR), 1024, 3, (size_t)1024 * 2, (size_t)DM * 1024 * 2);
            EpiBranch E{WSP(WS_GATE), WSP(WS_PROJ)};
            pg8::gemm_phase(lds, pg8::GemmK{1024, YW, 1024}, S, E);
        }
        SEAM(pb + 3);
        if (HASP(4) && IN(pb + 4)) for (int rep = 0; rep <= DUPP(4); ++rep) { if (rep) xcd_barrier(bar); PH_BEGIN
            pg8::PlainOrder S; S.init(T, DM, G, bx, WSP(WS_PROJ), DM, WSP(WS_WOUT), DM); EpiResid E{(l == 0) ? GIN(I_X) : out, rep ? (GAS float*)(ws + WS_GATE) : out, rep ? (GAS bf16*)nullptr : WSP(WS_H), (GAS float*)(ws + WS_SS), (LAS float*)(lds + LDS_RED)};
            pg8::gemm_phase(lds, pg8::GemmK{DM, DM, DM}, S, E);
        }
        SEAM(pb + 4);
        if (HASP(6) && IN(pb + 6)) for (int rep = 0; rep <= DUPP(6); ++rep) { if (rep) xcd_barrier(bar); PH_BEGIN
            pg8::PlainOrder S; S.init(T, XD, G, bx, WSP(WS_H), DM, WSP(WS_WXQ), DM); EpiPlain<true> E{WSP(WS_Y), XD, RowScale{(const GAS float*)(ws + WS_SS), (LAS float*)(lds + LDS_RSTD)}};
            pg8::gemm_phase(lds, pg8::GemmK{DM, DM, DM}, S, E);
        }
        SEAM(pb + 6);
        if (HASP(7) && IN(pb + 7)) for (int rep = 0; rep <= DUPP(7); ++rep) { if (rep) xcd_barrier(bar); PH_BEGIN for (int u = bx; u < NB * 32; u += G) xattn_unit(u, l, WSP(WS_KV), WSP(WS_Y), WSP(WS_Y + 32 * MiB), lds, tid); __syncthreads(); }
        SEAM(pb + 7);
        if (HASP(8) && IN(pb + 8)) for (int rep = 0; rep <= DUPP(8); ++rep) { if (rep) xcd_barrier(bar); PH_BEGIN
            pg8::PlainOrder S; S.init(T, DM, G, bx, WSP(WS_Y + 32 * MiB), XD, WSP(WS_WXO), XD); EpiResid E{out, rep ? (GAS float*)(ws + WS_GATE) : out, rep ? (GAS bf16*)nullptr : WSP(WS_H), (GAS float*)(ws + WS_SS), (LAS float*)(lds + LDS_RED)};
            pg8::gemm_phase(lds, pg8::GemmK{XD, XD, XD}, S, E);
        }
        SEAM(pb + 8);
        if (HASP(10) && IN(pb + 10)) for (int rep = 0; rep <= DUPP(10); ++rep) { if (rep) xcd_barrier(bar); PH_BEGIN
            pg8::PlainOrder S; S.init(T, 2 * DFF, G, bx, WSP(WS_H), DM, WSP(WS_WF1), DM); EpiSwiglu E{rep ? WSP(WS_GATE) : WSP(WS_PROJ), RowScale{(const GAS float*)(ws + WS_SS), (LAS float*)(lds + LDS_RSTD)}};
#ifdef PROBE_L2
            if (rep) { S.tA = 0; S.tB = 0; }
#endif
            pg8::gemm_phase(lds, pg8::GemmK{DM, DM, DM}, S, E);
        }
        SEAM(pb + 10);
        if (HASP(11) && IN(pb + 11)) for (int rep = 0; rep <= DUPP(11); ++rep) { if (rep) xcd_barrier(bar); PH_BEGIN
            pg8::PlainOrder S; S.init(T, DM, G, bx, WSP(WS_PROJ), DFF, WSP(WS_WF2), DFF); EpiResid E{out, rep ? (GAS float*)(ws + WS_GATE) : out, rep ? (GAS bf16*)nullptr : WSP(WS_H), (GAS float*)(ws + WS_SS), (LAS float*)(lds + LDS_RED)};
            pg8::gemm_phase(lds, pg8::GemmK{DFF, DFF, DFF}, S, E);
        }
        SEAM(pb + 11);
    }
    if (HASP(12) && IN(NPH - 1)) { const int lane = tid0 & 63, wave = __builtin_amdgcn_readfirstlane(tid0 >> 6); final_norm_phase((GAS float*)a.out, GIN(I_FINAL_NORM), (const GAS float*)(a.ws + WS_SS), bx * NWAVES + wave, G * NWAVES, lane); }
#undef IN
#undef SEAM
#undef PH_BEGIN
#undef OPQ_PTR
#undef WSP
#undef GIN
}

extern "C" void kernel_launch(void* const* d_in, const int* in_sizes, int n_in, void* d_out, int out_size, void* d_ws, size_t ws_size, hipStream_t stream) {
    static int grid = 0;
    if (grid == 0) {
        if (n_in != 25 || out_size != T * DM || ws_size < WS_END) { fprintf(stderr, "kernel_launch: unexpected shapes (n_in %d, out %d, ws %zu, need %zu)\n", n_in, out_size, ws_size, (size_t)WS_END); grid = -1; return; }
        int dev = 0, cus = 0, per_cu = 0;
        if (hipGetDevice(&dev) != hipSuccess || hipDeviceGetAttribute(&cus, hipDeviceAttributeMultiprocessorCount, dev) != hipSuccess) { grid = -1; return; }
        if (hipFuncSetAttribute((const void*)fwd_kernel, hipFuncAttributeMaxDynamicSharedMemorySize, LDS_BYTES) != hipSuccess) { fprintf(stderr, "kernel_launch: hipFuncSetAttribute failed\n"); grid = -1; return; }
        if (hipOccupancyMaxActiveBlocksPerMultiprocessor(&per_cu, (const void*)fwd_kernel, NTHR, LDS_BYTES) != hipSuccess || per_cu < 1)
            fprintf(stderr, "kernel_launch: occupancy query reports %d workgroups per CU\n", per_cu);
        (void)hipGetLastError();
        grid = cus;
    }
    if (grid < 0) return;
    if (hipMemsetAsync((char*)d_ws + WS_CTL, 0, CTL_ZERO_BYTES, stream) != hipSuccess) return;
    Args a{};
    for (int i = 0; i < 25; ++i) a.in[i] = (const float*)d_in[i];
    a.out = (float*)d_out; a.ws = (unsigned char*)d_ws;
#if MK_MULTI
    for (int p = 0; p < NPH; ++p) { a.ph_lo = p; a.ph_hi = p + 1; hipLaunchKernelGGL(fwd_kernel, dim3(grid), dim3(NTHR), LDS_BYTES, stream, a); }
#else
    a.ph_lo = 0; a.ph_hi = NPH;
    hipLaunchKernelGGL(fwd_kernel, dim3(grid), dim3(NTHR), LDS_BYTES, stream, a);
#endif
}
```

```cpp
#include <hip/hip_runtime.h>
#include <cstdio>
#include <cstdint>

#define LAS __attribute__((address_space(3)))
#define GAS __attribute__((address_space(1)))
typedef unsigned short bf16;
typedef short bf16x8 __attribute__((ext_vector_type(8)));
typedef float f32x4 __attribute__((ext_vector_type(4)));
typedef float f32x2 __attribute__((ext_vector_type(2)));
typedef unsigned u32x4 __attribute__((ext_vector_type(4)));
typedef unsigned u32x2 __attribute__((ext_vector_type(2)));
typedef GAS unsigned gu32;

__device__ __forceinline__ unsigned cvt_pk_bf16(float lo, float hi) { unsigned r; asm volatile("v_cvt_pk_bf16_f32 %0, %1, %2" : "=v"(r) : "v"(lo), "v"(hi)); return r; }
__device__ __forceinline__ float bf_lo(unsigned w) { return __builtin_bit_cast(float, w << 16); }
__device__ __forceinline__ float bf_hi(unsigned w) { return __builtin_bit_cast(float, w & 0xffff0000u); }
__device__ __forceinline__ float bf1(bf16 h) { return __builtin_bit_cast(float, (unsigned)h << 16); }
__device__ __forceinline__ float fast_exp(float x) { return __builtin_amdgcn_exp2f(x * 1.4426950408889634f); }
__device__ __forceinline__ float sigmoidf_(float x) { return __builtin_amdgcn_rcpf(1.0f + fast_exp(-x)); }
__device__ __forceinline__ float siluf_(float x) { return x * sigmoidf_(x); }
__device__ __forceinline__ float geluf_(float x) { return x * sigmoidf_(1.5957691216057308f * (x + 0.044715f * x * x * x)); }
__device__ __forceinline__ float wave_sum(float v) {
#pragma unroll
    for (int o = 1; o < 64; o <<= 1) v += __shfl_xor(v, o);
    return v;
}

typedef _Float16 f16x8 __attribute__((ext_vector_type(8)));
typedef _Float16 f16x4 __attribute__((ext_vector_type(4)));
typedef _Float16 f16x2 __attribute__((ext_vector_type(2)));
template <bool F16> __device__ __forceinline__ f32x4 mma16(bf16x8 a, bf16x8 b, f32x4 c) {
    if constexpr (F16) return __builtin_amdgcn_mfma_f32_16x16x32_f16(__builtin_bit_cast(f16x8, a), __builtin_bit_cast(f16x8, b), c, 0, 0, 0);
    else return __builtin_amdgcn_mfma_f32_16x16x32_bf16(a, b, c, 0, 0, 0);
}
__device__ __forceinline__ unsigned cvt_pk_f16(float lo, float hi) { f16x2 h; h.x = (_Float16)lo; h.y = (_Float16)hi; return __builtin_bit_cast(unsigned, h); }
__device__ __forceinline__ float h_lo(unsigned w) { return (float)__builtin_bit_cast(f16x2, w).x; }
__device__ __forceinline__ float h_hi(unsigned w) { return (float)__builtin_bit_cast(f16x2, w).y; }
namespace pg8 {
constexpr int BM = 256, BK = 64, HALF = 128, HTB = HALF * BK * 2, STAGE_BYTES = 8 * HTB, NXCD = 8, WGM = 8;
__host__ __device__ __forceinline__ int lds_byte(int r, int c) { const int st = (r >> 4) * 2 + (c >> 5), rr = r & 15, cc = c & 31, ob = rr * 64 + cc * 2; return st * 1024 + (ob ^ (((ob >> 9) & 1) << 5)); }
__host__ __device__ __forceinline__ void stage_rc(int b, int& R, int& C) { const int st = b / 1024, sb = b % 1024, swz = sb ^ (((sb >> 9) & 1) << 5); R = (st >> 1) * 16 + swz / 64; C = (st & 1) * 32 + (swz % 64) / 2; }
__host__ __device__ __forceinline__ int perm32(int rho) { const int n = rho >> 4, i = rho & 15; return 8 * (i >> 2) + 4 * n + (i & 3); }

struct Unit { int pm, pn, aux; const GAS char* a; const GAS char* b; };
struct GemmK { int K, lda, ldb; };

__device__ __forceinline__ void tile_of(int L, int nM, int nN, int wgm, int& pm, int& pn) {
    const int nwg = nM * nN; int wgid = L;
    { const int q = nwg / NXCD, r = nwg % NXCD, xcd = wgid % NXCD, off = wgid / NXCD; wgid = (xcd < r ? xcd * (q + 1) : r * (q + 1) + (xcd - r) * q) + off; }
    const int nig = wgm * nN, gid = wgid / nig, fm = gid * wgm, gsz = (nM - fm) < wgm ? (nM - fm) : wgm;
    pm = fm + ((wgid % nig) % gsz); pn = (wgid % nig) / gsz;
}
struct PlainOrder {
    int nM, nN, nwg, G, c, sub, wgm; const GAS char* A; const GAS char* B; size_t tA, tB, asub, bsub;
    __device__ __forceinline__ void init(int M, int N, int G_, int c_, const GAS void* A_, int lda, const GAS void* B_, int ldb, int sub_ = 1, size_t asub_ = 0, size_t bsub_ = 0, int wgm_ = WGM) {
        nM = M / BM; nN = N / BM; nwg = nM * nN; G = G_; c = c_; A = (const GAS char*)A_; B = (const GAS char*)B_; tA = (size_t)BM * lda * 2; tB = (size_t)BM * ldb * 2; sub = sub_; asub = asub_; bsub = bsub_; wgm = wgm_; }
    __device__ __forceinline__ bool next(int i, Unit& u) const {
        const int ti = i / sub, j = i - ti * sub;
        const long L = (long)ti * G + c; if (L >= nwg) return false;
        tile_of((int)L, nM, nN, wgm, u.pm, u.pn); u.aux = j;
        u.a = A + (size_t)u.pm * tA + (size_t)j * asub; u.b = B + (size_t)u.pn * tB + (size_t)j * bsub; return true;
    }
};

template <class Epi, class Sched>
__device__ __forceinline__ void gemm_phase(LAS unsigned char* lds, const GemmK g, const Sched& S, const Epi& E) {
    int tid = threadIdx.x; asm volatile("" : "+v"(tid));
    const int wid = __builtin_amdgcn_readfirstlane(tid >> 6), lane = tid & 63, wr = wid >> 2, wc = wid & 3, fr = lane & 15, fq = lane >> 4;
    const int K = g.K, nt = K / BK;
    unsigned voffA[2], voffB[2];
#pragma unroll
    for (int i = 0; i < 2; ++i) { int R, C; stage_rc(tid * 16 + i * 8192, R, C); const int Rb = Epi::PERM ? ((R & ~31) + perm32(R & 31)) : R;
        voffA[i] = (unsigned)(R * g.lda + C) * 2u; voffB[i] = (unsigned)(Rb * g.ldb + C) * 2u; }
    const size_t kstep = (size_t)(BK * 2);
    const size_t hstepA = (size_t)HALF * g.lda * 2, hstepB = (size_t)HALF * g.ldb * 2;
    const unsigned ldsw = (unsigned)wid * 1024u;
    const int aoff = lds_byte(wr * 64 + fr, fq * 8), boff = lds_byte(wc * 32 + fr, fq * 8);
#define PG8_SA(b, h) (((b) * 2 + (h)) * HTB)
#define PG8_SB(b, h) ((4 + (b) * 2 + (h)) * HTB)
#define PG8_STAGE(bufoff, gbase, voff) do { _Pragma("unroll") for (int _i = 0; _i < 2; ++_i) \
        __builtin_amdgcn_global_load_lds((const GAS unsigned*)((gbase) + (voff)[_i]), (LAS unsigned*)(lds + (bufoff) + ldsw + _i * 8192), 16, 0, 0); } while (0)
#define PG8_LDA(dst, b, h) do { _Pragma("unroll") for (int m = 0; m < 4; ++m) _Pragma("unroll") for (int k = 0; k < 2; ++k) dst[m][k] = *(const LAS bf16x8*)(lds + PG8_SA(b, h) + aoff + m * 2048 + k * 1024); } while (0)
#define PG8_LDB(dst, b, h) do { _Pragma("unroll") for (int n = 0; n < 2; ++n) _Pragma("unroll") for (int k = 0; k < 2; ++k) dst[n][k] = *(const LAS bf16x8*)(lds + PG8_SB(b, h) + boff + n * 2048 + k * 1024); } while (0)
#define PG8_MMA(ai, bj, At, Bt) do { __builtin_amdgcn_s_setprio(1); _Pragma("unroll") for (int m = 0; m < 4; ++m) _Pragma("unroll") for (int n = 0; n < 2; ++n) _Pragma("unroll") for (int k = 0; k < 2; ++k) \
        acc[ai][bj][m][n] = mma16<Epi::F16>(Bt[n][k], At[m][k], acc[ai][bj][m][n]); __builtin_amdgcn_s_setprio(0); } while (0)
#define PG8_WAIT_V(n) asm volatile("s_waitcnt vmcnt(" #n ")" ::: "memory")
#define PG8_WAIT_L(n) asm volatile("s_waitcnt lgkmcnt(" #n ")" ::: "memory")
#define PG8_BAR __builtin_amdgcn_s_barrier()
#define PG8_SCHED __builtin_amdgcn_sched_barrier(0)
    Unit cur, nxt; int ui = 0;
    if (!S.next(0, cur)) return;
    E.prep(cur, 0, tid);
    f32x4 acc[2][2][4][2];
#pragma unroll
    for (int a = 0; a < 2; ++a)
#pragma unroll
        for (int b = 0; b < 2; ++b)
#pragma unroll
            for (int m = 0; m < 4; ++m)
#pragma unroll
                for (int n = 0; n < 2; ++n) acc[a][b][m][n] = (f32x4){0.f, 0.f, 0.f, 0.f};
    bf16x8 At[4][2], B0[2][2], B1[2][2];
    const GAS char* cA = cur.a; const GAS char* cB = cur.b;
    PG8_STAGE(PG8_SB(0, 0), cB, voffB); PG8_STAGE(PG8_SB(0, 1), cB + hstepB, voffB); PG8_STAGE(PG8_SA(0, 0), cA, voffA); PG8_STAGE(PG8_SA(0, 1), cA + hstepA, voffA);
    if (wr == 1) PG8_BAR;
    PG8_WAIT_V(2); PG8_BAR;
    PG8_STAGE(PG8_SB(1, 0), cB + kstep, voffB); PG8_STAGE(PG8_SA(1, 0), cA + kstep, voffA); PG8_STAGE(PG8_SB(1, 1), cB + hstepB + kstep, voffB);
    PG8_WAIT_V(6); PG8_BAR;
    for (;;) {
        const bool has_next = S.next(ui + 1, nxt);
        const GAS char* nA = has_next ? nxt.a : cA; const GAS char* nB = has_next ? nxt.b : cB;
        for (int t = 0; t < nt; t += 2) {
            const bool last = (t == nt - 2);
            const GAS char* a1 = cA + (size_t)(t + 1) * kstep;
            const GAS char* a2 = last ? nA : cA + (size_t)(t + 2) * kstep; const GAS char* b2 = last ? nB : cB + (size_t)(t + 2) * kstep;
            const GAS char* a3 = a2 + kstep; const GAS char* b3 = b2 + kstep;
            PG8_LDB(B0, 0, 0); PG8_LDB(B1, 0, 1); PG8_SCHED; PG8_LDA(At, 0, 0); PG8_STAGE(PG8_SA(1, 1), a1 + hstepA, voffA);
            PG8_WAIT_V(8); PG8_WAIT_L(0); PG8_BAR; PG8_MMA(0, 0, At, B0); PG8_MMA(0, 1, At, B1); PG8_BAR; PG8_SCHED;
            PG8_LDA(At, 0, 1); PG8_STAGE(PG8_SB(0, 0), b2, voffB); PG8_STAGE(PG8_SB(0, 1), b2 + hstepB, voffB); PG8_STAGE(PG8_SA(0, 0), a2, voffA);
            PG8_WAIT_V(8); PG8_WAIT_L(0); PG8_BAR; PG8_MMA(1, 0, At, B0); PG8_MMA(1, 1, At, B1); PG8_BAR; PG8_SCHED;
            PG8_LDB(B0, 1, 0); PG8_LDB(B1, 1, 1); PG8_SCHED; PG8_LDA(At, 1, 0); PG8_STAGE(PG8_SA(0, 1), a2 + hstepA, voffA);
            PG8_WAIT_V(8); PG8_WAIT_L(0); PG8_BAR; PG8_MMA(0, 0, At, B0); PG8_MMA(0, 1, At, B1); PG8_BAR; PG8_SCHED;
            PG8_LDA(At, 1, 1); PG8_STAGE(PG8_SB(1, 0), b3, voffB); PG8_STAGE(PG8_SB(1, 1), b3 + hstepB, voffB); PG8_STAGE(PG8_SA(1, 0), a3, voffA);
            PG8_WAIT_V(8); PG8_WAIT_L(0); PG8_BAR; PG8_MMA(1, 0, At, B0); PG8_MMA(1, 1, At, B1); PG8_BAR; PG8_SCHED;
        }
        if (wr == 0) PG8_BAR;
        E(acc, cur, wr, wc, fr, fq, ui & 1);
        if (has_next) E.prep(nxt, (ui + 1) & 1, tid);
        if (!has_next) break;
        if (!Epi::keep(cur)) {
#pragma unroll
        for (int a = 0; a < 2; ++a)
#pragma unroll
            for (int b = 0; b < 2; ++b)
#pragma unroll
                for (int m = 0; m < 4; ++m)
#pragma unroll
                    for (int n = 0; n < 2; ++n) acc[a][b][m][n] = (f32x4){0.f, 0.f, 0.f, 0.f};
        }
        cur = nxt; cA = nA; cB = nB; ++ui;
        if (wr == 1) PG8_BAR;
    }
    PG8_WAIT_V(0);
    PG8_BAR;
#undef PG8_SA
#undef PG8_SB
#undef PG8_STAGE
#undef PG8_LDA
#undef PG8_LDB
#undef PG8_MMA
#undef PG8_WAIT_V
#undef PG8_WAIT_L
#undef PG8_BAR
#undef PG8_SCHED
}
}
constexpr int NB = 16, SEQ = 2048, DM = 2048, T = NB * SEQ, NL = 4, MEML = 256, MT = NB * MEML;
constexpr int INW = 7680, GW = 6144, NCAT = INW + GW, XD = 512, DFF = 5632, YW = 3072;
constexpr int C_QA = 0, C_KA = 1024, C_VA = 1280, C_UB = 1536, C_VB = 2560, C_FC = 3584, C_IC = 4608, C_QC = 5632, C_GC = 6656;
constexpr float EPS = 1e-6f;
constexpr float LOG2E = 1.4426950408889634f;
constexpr int NWAVES = 8, NTHR = NWAVES * 64;

constexpr size_t MiB = 1u << 20;
constexpr size_t WS_CTL = 0, CTL_ZERO_BYTES = 1 * MiB;
constexpr size_t WS_WCAT = 1 * MiB;
constexpr size_t WS_WBR = WS_WCAT + 54 * MiB;
constexpr size_t WS_WOUT = WS_WBR + 12 * MiB;
constexpr size_t WS_WXQ = WS_WOUT + 8 * MiB;
constexpr size_t WS_WXO = WS_WXQ + 2 * MiB;
constexpr size_t WS_WF1 = WS_WXO + 2 * MiB;
constexpr size_t WS_WF2 = WS_WF1 + 44 * MiB;
constexpr size_t WS_WXKV = WS_WF2 + 22 * MiB;
constexpr size_t WS_MEMN = WS_WXKV + 16 * MiB;
constexpr size_t WS_KV = WS_MEMN + 16 * MiB;
constexpr size_t WS_H = WS_KV + 32 * MiB;
constexpr size_t WS_PROJ = WS_H + 128 * MiB;
constexpr size_t PJ_QKV = 0, PJ_UB = 96 * MiB, PJ_VB = 160 * MiB, PJ_HB = 224 * MiB  , PJ_STAT = 480 * MiB;
constexpr int QKVW = 1536;
constexpr size_t WS_GATE = WS_PROJ + 484 * MiB;
constexpr size_t WS_Y = WS_GATE + 384 * MiB;
constexpr size_t WS_SS = WS_Y + 192 * MiB;
constexpr size_t WS_END = WS_SS + 1 * MiB;
constexpr int CW_TMO = 0, CW_BAR = 4096, CW_Q = 8192;

constexpr int RING_BYTES = 143360;
constexpr int LDSCTL_OFF = RING_BYTES, LDS_RED = LDSCTL_OFF + 1024, LDS_RSTD = LDS_RED + 4096, LDS_BYTES = 155648;

#define RLX_AGENT __ATOMIC_RELAXED, __HIP_MEMORY_SCOPE_AGENT
#define LDS_WAIT() asm volatile("s_waitcnt lgkmcnt(0)" ::: "memory")
#define VM_WAIT() asm volatile("s_waitcnt vmcnt(0)" ::: "memory")

#define XB_TMO      128
#define XB_XCNT(j)  (256  + 64 * (j))
#define XB_XSUB(j)  (1280 + 64 * (j))
#define XB_XGEN(j)  (2304 + 64 * (j))
#define XB_TOP      3328
#define XB_TOPGEN   3392
#define XCD_BAR_WORDS 3456
#define XB_SPIN_CAP (1u << 18)
__device__ __forceinline__ unsigned xb_ld(unsigned* p)              { return __hip_atomic_load(p, __ATOMIC_RELAXED, __HIP_MEMORY_SCOPE_AGENT); }
__device__ __forceinline__ unsigned xb_add(unsigned* p, unsigned v) { return __hip_atomic_fetch_add(p, v, __ATOMIC_RELAXED, __HIP_MEMORY_SCOPE_AGENT); }
__device__ __forceinline__ unsigned xb_xcc_id() { return (unsigned)__builtin_amdgcn_s_getreg((3 << 11) | 20) & 0xFu; }
#define XB_SPIN(cond, bar) do { unsigned _sp = 0; while (cond) { __builtin_amdgcn_s_sleep(1); \
    if ((++_sp & 255u) == 0u) { if (xb_ld(&(bar)[XB_TMO])) break; if (_sp > XB_SPIN_CAP) { atomicAdd(&(bar)[XB_TMO], 1u); break; } } } } while (0)
struct XcdBarrier { unsigned* bar; unsigned x; volatile LAS unsigned* st; };
__device__ __forceinline__ XcdBarrier xcd_barrier_post(unsigned* bar, volatile LAS unsigned* st) {
    XcdBarrier b; b.bar = bar; b.x = xb_xcc_id(); b.st = st;
    if (threadIdx.x == 0) (void)xb_add(&bar[XB_XCNT(b.x)], 1u);
    return b;
}
__device__ __forceinline__ void xcd_barrier_complete(unsigned* bar, unsigned x, unsigned& nloc, unsigned& nx) {
    const unsigned G = gridDim.x * gridDim.y * gridDim.z;
    unsigned sum, cnt, mine, sp = 0u;
    for (;;) {
        sum = 0u; cnt = 0u; mine = 0u;
#pragma unroll
        for (unsigned j = 0; j < 16; ++j) { const unsigned c = xb_ld(&bar[XB_XCNT(j)]); sum += c; cnt += (c > 0u) ? 1u : 0u; mine = (j == x) ? c : mine; }
        if (sum == G) break;
        __builtin_amdgcn_s_sleep(1);
        if ((++sp & 255u) == 0u) { if (xb_ld(&bar[XB_TMO])) break; if (sp > XB_SPIN_CAP) { atomicAdd(&bar[XB_TMO], 1u); break; } }
    }
    nloc = mine > 0u ? mine : 1u; nx = cnt > 0u ? cnt : 1u;
}
__device__ __forceinline__ void xcd_barrier(const XcdBarrier& b) {
    asm volatile("s_waitcnt vmcnt(0)" ::: "memory");
    __syncthreads();
    if (threadIdx.x == 0) {
        unsigned* bar = b.bar;
        __builtin_amdgcn_s_waitcnt(0);
        unsigned nloc = b.st[0], nx = b.st[1];
        if (nloc == 0u) { xcd_barrier_complete(bar, b.x, nloc, nx); b.st[0] = nloc; b.st[1] = nx; }
        const unsigned old = xb_add(&bar[XB_XSUB(b.x)], 1u);
        const unsigned gen = old / nloc;
        if (old + 1u == (gen + 1u) * nloc) {
            __builtin_amdgcn_fence(__ATOMIC_RELEASE, "agent");
            asm volatile("s_waitcnt vmcnt(0)" ::: "memory");
            const unsigned og = xb_add(&bar[XB_TOP], 1u);
            const unsigned tg = og / nx;
            if (og + 1u == (tg + 1u) * nx) xb_add(&bar[XB_TOPGEN], 1u);
            else XB_SPIN(xb_ld(&bar[XB_TOPGEN]) == tg, bar);
            __builtin_amdgcn_fence(__ATOMIC_ACQUIRE, "agent");
            xb_add(&bar[XB_XGEN(b.x)], 1u);
            asm volatile("s_waitcnt vmcnt(0)" ::: "memory");
        } else {
            XB_SPIN(xb_ld(&bar[XB_XGEN(b.x)]) == gen, bar);
            __builtin_amdgcn_fence(__ATOMIC_ACQUIRE, "agent");
            asm volatile("s_waitcnt vmcnt(0)" ::: "memory");
        }
    }
    __syncthreads();
}

struct RowScale {
    const GAS float* ss; LAS float* tab;
    __device__ __forceinline__ void prep(const pg8::Unit& u, int buf, int tid) const {
        if (tid < 256) { const GAS f32x4* p = (const GAS f32x4*)(ss + ((size_t)u.pm * 256 + tid) * 8); const f32x4 a = p[0], b = p[1];
            tab[buf * 256 + tid] = __builtin_amdgcn_rsqf(((a.x + a.y) + (a.z + a.w) + (b.x + b.y) + (b.z + b.w)) * (1.f / DM) + EPS); }
    }
    __device__ __forceinline__ float get(int buf, int row) const { return tab[buf * 256 + row]; }
};
struct EpiCat {
    static constexpr bool PERM = true, F16 = true; static __device__ __forceinline__ bool keep(const pg8::Unit&) { return false; }
    GAS unsigned char* pj; GAS bf16* gate; RowScale rs;
    __device__ __forceinline__ void prep(const pg8::Unit& u, int buf, int tid) const { rs.prep(u, buf, tid); }
    __device__ __forceinline__ void operator()(f32x4 (&acc)[2][2][4][2], const pg8::Unit& u, int wr, int wc, int fr, int fq, int buf) const {
        const int pn = u.pn; GAS char* base; int ldc, colt; size_t bjs = 256, rowbase = (size_t)u.pm * 256; int kind;
        float c1 = 1.f, c3 = 0.f, sc = 1.f, flo = -INFINITY; bool usex = true;
        if (pn < 6) { base = (GAS char*)pj + PJ_QKV; ldc = QKVW; colt = pn * 256; kind = 0; }
        else if (pn < 14) { base = (GAS char*)pj + (pn < 10 ? PJ_UB : PJ_VB); ldc = 1024; colt = ((pn - 6) & 3) * 256; kind = 0; }
        else if (pn < 30) { const int seg = (pn - 14) >> 2, hp = (pn - 14) & 3, b = u.pm >> 3, t0 = (u.pm & 7) * 256;
            base = (GAS char*)pj + PJ_HB + (size_t)seg * (64 * MiB) + ((size_t)((b * 8 + 2 * hp) * SEQ + t0) * 128) * 2; ldc = 128; colt = 0; bjs = (size_t)SEQ * 128 * 2; rowbase = 0;
            kind = 0; }
        else { base = (GAS char*)gate; ldc = GW; colt = (pn - 30) * 256; kind = 1; usex = false; flo = 1e-20f; }
        const unsigned toff = (unsigned)((wr * 64 + fr) * ldc + wc * 32 + 8 * fq) * 2u;
#pragma unroll
        for (int ai = 0; ai < 2; ++ai)
#pragma unroll
            for (int m = 0; m < 4; ++m) { GAS char* ub = base + ((rowbase + ai * 128 + m * 16) * ldc + colt) * 2;
                const float rsd = rs.get(buf, ai * 128 + wr * 64 + m * 16 + fr);
                float s1 = 0.f, s2 = 0.f;
#pragma unroll
                for (int bj = 0; bj < 2; ++bj) { f32x4 v0 = acc[ai][bj][m][0] * rsd, v1 = acc[ai][bj][m][1] * rsd;
                    if (kind) {
#pragma unroll
                        for (int e = 0; e < 4; ++e) {
                            { const float x = v0[e]; const float sg = __builtin_amdgcn_rcpf(1.0f + __builtin_amdgcn_exp2f(-LOG2E * x * (c1 + c3 * x * x))); v0[e] = fmaxf((usex ? x : 1.f) * sg * sc, flo); }
                            { const float x = v1[e]; const float sg = __builtin_amdgcn_rcpf(1.0f + __builtin_amdgcn_exp2f(-LOG2E * x * (c1 + c3 * x * x))); v1[e] = fmaxf((usex ? x : 1.f) * sg * sc, flo); }
                            if (kind == 2) { s1 += v0[e] + v1[e]; s2 += v0[e] * v0[e] + v1[e] * v1[e]; } } }
                    u32x4 w; w.x = cvt_pk_bf16(v0[0], v0[1]); w.y = cvt_pk_bf16(v0[2], v0[3]); w.z = cvt_pk_bf16(v1[0], v1[1]); w.w = cvt_pk_bf16(v1[2], v1[3]);
                    *(GAS u32x4*)(ub + bj * bjs + toff) = w; }
                if (kind == 2) { s1 += __shfl_xor(s1, 16); s1 += __shfl_xor(s1, 32); s2 += __shfl_xor(s2, 16); s2 += __shfl_xor(s2, 32);
                    if (fq == 0) *(GAS f32x2*)((GAS float*)(pj + PJ_STAT) + ((size_t)u.pm * 256 + ai * 128 + wr * 64 + m * 16 + fr) * 32 + (pn - 10) * 8 + wc * 2) = (f32x2){s1, s2}; } }
    }
};
template <bool SCALE> struct EpiPlain {
    static constexpr bool PERM = true, F16 = SCALE;     static __device__ __forceinline__ bool keep(const pg8::Unit&) { return false; }
    GAS bf16* O; int ldc; RowScale rs;
    __device__ __forceinline__ void prep(const pg8::Unit& u, int buf, int tid) const { if (SCALE) rs.prep(u, buf, tid); }
    __device__ __forceinline__ void operator()(f32x4 (&acc)[2][2][4][2], const pg8::Unit& u, int wr, int wc, int fr, int fq, int buf) const {
        const unsigned toff = (unsigned)((wr * 64 + fr) * ldc + wc * 32 + 8 * fq) * 2u;
#pragma unroll
        for (int ai = 0; ai < 2; ++ai)
#pragma unroll
            for (int m = 0; m < 4; ++m) { GAS char* ub = (GAS char*)O + ((size_t)(u.pm * 256 + ai * 128 + m * 16) * ldc + u.pn * 256) * 2;
                const float rsd = SCALE ? rs.get(buf, ai * 128 + wr * 64 + m * 16 + fr) : 1.f;
#pragma unroll
                for (int bj = 0; bj < 2; ++bj) { const f32x4 v0 = acc[ai][bj][m][0] * rsd, v1 = acc[ai][bj][m][1] * rsd;
                    u32x4 w; w.x = cvt_pk_bf16(v0[0], v0[1]); w.y = cvt_pk_bf16(v0[2], v0[3]); w.z = cvt_pk_bf16(v1[0], v1[1]); w.w = cvt_pk_bf16(v1[2], v1[3]);
                    *(GAS u32x4*)(ub + bj * 256 + toff) = w; } }
    }
};
struct EpiResid {
    static constexpr bool PERM = true, F16 = false; static __device__ __forceinline__ bool keep(const pg8::Unit&) { return false; }
    const GAS unsigned short* src; GAS unsigned short* dst; GAS float* ss; LAS float* red;
    __device__ __forceinline__ void prep(const pg8::Unit&, int, int) const {}
    __device__ __forceinline__ void operator()(f32x4 (&acc)[2][2][4][2], const pg8::Unit& u, int wr, int wc, int fr, int fq, int) const {
        const unsigned toff_ = (unsigned)((wr * 64 + fr) * DM + wc * 32 + 8 * fq) * 2u;
#pragma unroll
        for (int ai = 0; ai < 2; ++ai) {
            unsigned toff = toff_; asm volatile("" : "+v"(toff));
            u32x4 sv[4][2];
#pragma unroll
            for (int m = 0; m < 4; ++m) { const GAS char* us = (const GAS char*)src + ((size_t)(u.pm * 256 + ai * 128 + m * 16) * DM + u.pn * 256) * 2;
#pragma unroll
                for (int bj = 0; bj < 2; ++bj) sv[m][bj] = *(const GAS u32x4*)(us + bj * 256 + toff); }
#pragma unroll
            for (int m = 0; m < 4; ++m) { GAS char* ud = (GAS char*)dst + ((size_t)(u.pm * 256 + ai * 128 + m * 16) * DM + u.pn * 256) * 2;
                float q = 0.f;
#pragma unroll
                for (int bj = 0; bj < 2; ++bj) { const u32x4 x = sv[m][bj]; const f32x4 a0 = acc[ai][bj][m][0], a1 = acc[ai][bj][m][1];
                    const float v0 = h_lo(x.x) + a0[0], v1 = h_hi(x.x) + a0[1], v2 = h_lo(x.y) + a0[2], v3 = h_hi(x.y) + a0[3], v4 = h_lo(x.z) + a1[0], v5 = h_hi(x.z) + a1[1], v6 = h_lo(x.w) + a1[2], v7 = h_hi(x.w) + a1[3];
                    u32x4 w; w.x = cvt_pk_f16(v0, v1); w.y = cvt_pk_f16(v2, v3); w.z = cvt_pk_f16(v4, v5); w.w = cvt_pk_f16(v6, v7);
                    *(GAS u32x4*)(ud + bj * 256 + toff) = w;
                    q += ((v0 * v0 + v1 * v1) + (v2 * v2 + v3 * v3)) + ((v4 * v4 + v5 * v5) + (v6 * v6 + v7 * v7)); }
                if (ss) { q += __shfl_xor(q, 16); q += __shfl_xor(q, 32); if (fq == 0) red[wc * 256 + ai * 128 + wr * 64 + m * 16 + fr] = q; } }
            asm volatile("" ::: "memory"); }
        if (ss) { asm volatile("s_waitcnt lgkmcnt(0)" ::: "memory"); __builtin_amdgcn_s_barrier();
            const int t = threadIdx.x; if (t < 256) ss[((size_t)u.pm * 256 + t) * 8 + u.pn] = (red[t] + red[256 + t]) + (red[512 + t] + red[768 + t]); }
    }
};
struct EpiSwiglu {
    static constexpr bool PERM = true, F16 = true; static __device__ __forceinline__ bool keep(const pg8::Unit&) { return false; }
    GAS bf16* O; RowScale rs;
    __device__ __forceinline__ void prep(const pg8::Unit& u, int buf, int tid) const { rs.prep(u, buf, tid); }
    __device__ __forceinline__ void operator()(f32x4 (&acc)[2][2][4][2], const pg8::Unit& u, int wr, int wc, int fr, int fq, int buf) const {
        const unsigned toff = (unsigned)((wr * 64 + fr) * DFF + wc * 32 + 8 * fq) * 2u;
#pragma unroll
        for (int ai = 0; ai < 2; ++ai)
#pragma unroll
            for (int m = 0; m < 4; ++m) { GAS char* ub = (GAS char*)O + ((size_t)(u.pm * 256 + ai * 128 + m * 16) * DFF + u.pn * 128) * 2;
                f32x4 v0, v1; const float rsd = rs.get(buf, ai * 128 + wr * 64 + m * 16 + fr);
#pragma unroll
                for (int e = 0; e < 4; ++e) { v0[e] = siluf_(acc[ai][0][m][0][e] * rsd) * (acc[ai][1][m][0][e] * rsd); v1[e] = siluf_(acc[ai][0][m][1][e] * rsd) * (acc[ai][1][m][1][e] * rsd); }
                u32x4 w; w.x = cvt_pk_bf16(v0[0], v0[1]); w.y = cvt_pk_bf16(v0[2], v0[3]); w.z = cvt_pk_bf16(v1[0], v1[1]); w.w = cvt_pk_bf16(v1[2], v1[3]);
                *(GAS u32x4*)(ub + toff) = w; }
    }
};
struct EpiBranch {
    static constexpr bool PERM = true, F16 = false; static __device__ __forceinline__ bool keep(const pg8::Unit& u) { return u.aux < 2; }
    const GAS bf16* gate; GAS bf16* merged;
    __device__ __forceinline__ void prep(const pg8::Unit&, int, int) const {}
    __device__ __forceinline__ void operator()(f32x4 (&acc)[2][2][4][2], const pg8::Unit& u, int wr, int wc, int fr, int fq, int) const {
        const int j = u.aux;
        const unsigned toffg_ = (unsigned)((wr * 64 + fr) * GW + wc * 32 + 8 * fq) * 2u, toffm_ = (unsigned)((wr * 64 + fr) * DM + wc * 32 + 8 * fq) * 2u;
#pragma unroll
        for (int ai = 0; ai < 2; ++ai) {
            unsigned toffg = toffg_, toffm = toffm_; asm volatile("" : "+v"(toffg), "+v"(toffm));
            u32x4 gw[4][2], gn[4][2];
#pragma unroll
            for (int m = 0; m < 4; ++m) { const GAS char* ug = (const GAS char*)gate + ((size_t)(u.pm * 256 + ai * 128 + m * 16) * GW + j * DM + u.pn * 256) * 2;
#pragma unroll
                for (int bj = 0; bj < 2; ++bj) { gw[m][bj] = *(const GAS u32x4*)(ug + bj * 256 + toffg); if (j < 2) gn[m][bj] = *(const GAS u32x4*)(ug + DM * 2 + bj * 256 + toffg); } }
#pragma unroll
            for (int m = 0; m < 4; ++m) { GAS char* um = (GAS char*)merged + ((size_t)(u.pm * 256 + ai * 128 + m * 16) * DM + u.pn * 256) * 2;
#pragma unroll
                for (int bj = 0; bj < 2; ++bj) { const u32x4 g0 = gw[m][bj];
                    float s[8] = {bf_lo(g0.x), bf_hi(g0.x), bf_lo(g0.y), bf_hi(g0.y), bf_lo(g0.z), bf_hi(g0.z), bf_lo(g0.w), bf_hi(g0.w)};
                    if (j < 2) { const u32x4 g1 = gn[m][bj];
                        const float d[8] = {bf_lo(g1.x), bf_hi(g1.x), bf_lo(g1.y), bf_hi(g1.y), bf_lo(g1.z), bf_hi(g1.z), bf_lo(g1.w), bf_hi(g1.w)};
#pragma unroll
                        for (int e = 0; e < 8; ++e) s[e] = s[e] * __builtin_amdgcn_rcpf(d[e]); }
                    f32x4 v0 = acc[ai][bj][m][0], v1 = acc[ai][bj][m][1];
                    v0[0] *= s[0]; v0[1] *= s[1]; v0[2] *= s[2]; v0[3] *= s[3]; v1[0] *= s[4]; v1[1] *= s[5]; v1[2] *= s[6]; v1[3] *= s[7];
                    if (j < 2) { acc[ai][bj][m][0] = v0; acc[ai][bj][m][1] = v1; }
                    else { u32x4 w; w.x = cvt_pk_bf16(v0[0], v0[1]); w.y = cvt_pk_bf16(v0[2], v0[3]); w.z = cvt_pk_bf16(v1[0], v1[1]); w.w = cvt_pk_bf16(v1[2], v1[3]);
                        *(GAS u32x4*)(um + bj * 256 + toffm) = w; } } }
            asm volatile("" ::: "memory"); }
    }
};

__device__ __forceinline__ void tr_item(const GAS float* W, int N, GAS bf16* WT, int ldd, int k0, int n0, int drow0, LAS float* scr, int lane, const GAS float* gain = nullptr) {
    const float gv = gain ? gain[k0 + lane] : 1.f;
#pragma unroll 8
    for (int i = 0; i < 32; ++i) { const int kk = 2 * i + (lane >> 5); scr[kk * 33 + (lane & 31)] = W[(size_t)(k0 + kk) * N + n0 + (lane & 31)] * __shfl(gv, kk); }
    LDS_WAIT(); asm volatile("" ::: "memory");
    const int c = lane & 7;
#pragma unroll
    for (int j = 0; j < 4; ++j) { const int n = (lane >> 3) + 8 * j; const LAS float* s = scr + (8 * c) * 33 + n;
        u32x4 o;
        if (gain) { o.x = cvt_pk_f16(s[0 * 33], s[1 * 33]); o.y = cvt_pk_f16(s[2 * 33], s[3 * 33]); o.z = cvt_pk_f16(s[4 * 33], s[5 * 33]); o.w = cvt_pk_f16(s[6 * 33], s[7 * 33]); }
        else { o.x = cvt_pk_bf16(s[0 * 33], s[1 * 33]); o.y = cvt_pk_bf16(s[2 * 33], s[3 * 33]); o.z = cvt_pk_bf16(s[4 * 33], s[5 * 33]); o.w = cvt_pk_bf16(s[6 * 33], s[7 * 33]); }
        *(GAS u32x4*)(WT + (size_t)(drow0 + n) * ldd + k0 + 8 * c) = o; }
    LDS_WAIT(); asm volatile("" ::: "memory");
}
__device__ __forceinline__ void rms_row_bf16(const GAS float* xrow, const f32x4 (&gv)[8], GAS bf16* orow, int lane) {
    const GAS f32x4* xr = (const GAS f32x4*)xrow + lane;
    f32x4 v[8]; float s = 0.f;
#pragma unroll
    for (int j = 0; j < 8; ++j) { v[j] = xr[64 * j]; s += (v[j].x * v[j].x + v[j].y * v[j].y) + (v[j].z * v[j].z + v[j].w * v[j].w); }
    const float rstd = __builtin_amdgcn_rsqf(wave_sum(s) * (1.f / DM) + EPS);
    GAS u32x2* o8 = (GAS u32x2*)orow + lane;
#pragma unroll
    for (int j = 0; j < 8; ++j) { const f32x4 y = v[j] * rstd * gv[j]; u32x2 w; w.x = cvt_pk_bf16(y.x, y.y); w.y = cvt_pk_bf16(y.z, y.w); o8[64 * j] = w; }
}
__device__ __forceinline__ void norm_phase(const GAS float* src, const GAS float* gain, GAS bf16* dst, int nrows, int gw, int NGW, int lane) {
    f32x4 gv[8];
#pragma unroll
    for (int j = 0; j < 8; ++j) gv[j] = ((const GAS f32x4*)gain)[lane + 64 * j];
    for (int m = gw; m < nrows; m += NGW) rms_row_bf16(src + (size_t)m * DM, gv, dst + (size_t)m * DM, lane);
}
__device__ __forceinline__ void xb_phase(const GAS float* src, GAS bf16* xb, GAS float* ss, int gw, int NGW, int lane) {
    for (int m = gw; m < T; m += NGW) {
        const GAS f32x4* xr = (const GAS f32x4*)(src + (size_t)m * DM) + lane; GAS u32x2* o8 = (GAS u32x2*)(xb + (size_t)m * DM) + lane;
        f32x4 v[8]; float q[8];
#pragma unroll
        for (int j = 0; j < 8; ++j) { v[j] = xr[64 * j]; q[j] = (v[j].x * v[j].x + v[j].y * v[j].y) + (v[j].z * v[j].z + v[j].w * v[j].w); }
#pragma unroll
        for (int j = 0; j < 8; ++j) { u32x2 w; w.x = cvt_pk_f16(v[j].x, v[j].y); w.y = cvt_pk_f16(v[j].z, v[j].w); o8[64 * j] = w; }
#pragma unroll
        for (int o = 1; o < 64; o <<= 1)
#pragma unroll
            for (int j = 0; j < 8; ++j) q[j] += __shfl_xor(q[j], o);
        if (lane == 0) { GAS f32x4* sp = (GAS f32x4*)(ss + (size_t)m * 8); sp[0] = (f32x4){q[0], q[1], q[2], q[3]}; sp[1] = (f32x4){q[4], q[5], q[6], q[7]}; }
    }
}
__device__ __forceinline__ void final_norm_phase(const GAS unsigned short* xh, GAS float* out, const GAS float* gain, const GAS float* ss, int gw, int NGW, int lane) {
    f32x4 gv[8];
#pragma unroll
    for (int j = 0; j < 8; ++j) gv[j] = ((const GAS f32x4*)gain)[lane + 64 * j];
    for (int m = gw; m < T; m += NGW) {
        const GAS u32x2* xr = (const GAS u32x2*)(xh + (size_t)m * DM) + lane; GAS f32x4* orow = (GAS f32x4*)(out + (size_t)m * DM) + lane;
        const GAS f32x4* sp = (const GAS f32x4*)(ss + (size_t)m * 8); const f32x4 a = sp[0], b = sp[1];
        const float rstd = __builtin_amdgcn_rsqf(((a.x + a.y) + (a.z + a.w) + (b.x + b.y) + (b.z + b.w)) * (1.f / DM) + EPS);
        u32x2 v[8];
#pragma unroll
        for (int j = 0; j < 8; ++j) v[j] = xr[64 * j];
#pragma unroll
        for (int j = 0; j < 8; ++j) orow[64 * j] = (f32x4){h_lo(v[j].x), h_hi(v[j].x), h_lo(v[j].y), h_hi(v[j].y)} * rstd * gv[j];
    }
}
typedef short s16x4 __attribute__((ext_vector_type(4)));
__device__ __forceinline__ s16x4 tr_read(const LAS unsigned char* p) { return __builtin_bit_cast(s16x4, __builtin_amdgcn_ds_read_tr16_b64_v4i16((LAS s16x4*)p)); }
template <int HD, bool SWA>
__device__ __forceinline__ void attn_wave32(const LAS unsigned char* Ks, int kstr, const LAS unsigned char* Vt, int vstr, const bf16x8 (&qf)[2][HD / 32], f32x4 (&o)[2][HD / 16],
                                            float m0, float l0, float c2, int kt_lo, int kt_hi, int t0, bool first_blk, int lane) {
    const int fr = lane & 15, g = lane >> 4;
    float mrow[2] = {m0, m0}, lrow[2] = {l0, l0};
#pragma unroll
    for (int mt = 0; mt < 2; ++mt)
#pragma unroll
        for (int dt = 0; dt < HD / 16; ++dt) o[mt][dt] = (f32x4){0.f, 0.f, 0.f, 0.f};
    for (int kt = kt_lo; kt <= kt_hi; ++kt) {
        f32x4 s[2][4];
#pragma unroll
        for (int mt = 0; mt < 2; ++mt)
#pragma unroll
            for (int nt = 0; nt < 4; ++nt) s[mt][nt] = (f32x4){0.f, 0.f, 0.f, 0.f};
#pragma unroll
        for (int nt = 0; nt < 4; ++nt)
#pragma unroll
            for (int kk = 0; kk < HD / 32; ++kk) {
                const bf16x8 kf = *(const LAS bf16x8*)(Ks + (kt * 64 + nt * 16 + fr) * kstr + (kk * 32 + g * 8) * 2);
#pragma unroll
                for (int mt = 0; mt < 2; ++mt) s[mt][nt] = __builtin_amdgcn_mfma_f32_16x16x32_bf16(kf, qf[mt][kk], s[mt][nt], 0, 0, 0);
            }
#pragma unroll
        for (int mt = 0; mt < 2; ++mt) {
            float rm = -INFINITY;
#pragma unroll
            for (int nt = 0; nt < 4; ++nt)
#pragma unroll
                for (int e = 0; e < 4; ++e) {
                    float v = s[mt][nt][e] * c2;
                    if (SWA) { const int sidx = kt * 64 + nt * 16 + g * 4 + e, t = t0 + mt * 16 + fr;
                        const bool valid = (sidx > t) && (sidx <= t + 128) && (!first_blk || sidx >= 128); v = valid ? v : -INFINITY; }
                    s[mt][nt][e] = v; rm = fmaxf(rm, v);
                }
            rm = fmaxf(rm, __shfl_xor(rm, 16)); rm = fmaxf(rm, __shfl_xor(rm, 32));
            const float mn = fmaxf(mrow[mt], rm);
            const float alpha = __builtin_amdgcn_exp2f(mrow[mt] - mn);
            float rs = 0.f;
#pragma unroll
            for (int nt = 0; nt < 4; ++nt)
#pragma unroll
                for (int e = 0; e < 4; ++e) { const float p = __builtin_amdgcn_exp2f(s[mt][nt][e] - mn); s[mt][nt][e] = p; rs += p; }
            rs += __shfl_xor(rs, 16); rs += __shfl_xor(rs, 32);
            lrow[mt] = lrow[mt] * alpha + rs; mrow[mt] = mn;
#pragma unroll
            for (int dt = 0; dt < HD / 16; ++dt) o[mt][dt] *= alpha;
        }
        bf16x8 pf[2][2];
#pragma unroll
        for (int mt = 0; mt < 2; ++mt)
#pragma unroll
            for (int k2 = 0; k2 < 2; ++k2) {
                u32x4 w; w.x = cvt_pk_bf16(s[mt][2 * k2][0], s[mt][2 * k2][1]); w.y = cvt_pk_bf16(s[mt][2 * k2][2], s[mt][2 * k2][3]);
                w.z = cvt_pk_bf16(s[mt][2 * k2 + 1][0], s[mt][2 * k2 + 1][1]); w.w = cvt_pk_bf16(s[mt][2 * k2 + 1][2], s[mt][2 * k2 + 1][3]);
                pf[mt][k2] = __builtin_bit_cast(bf16x8, w);
            }
#pragma unroll
        for (int dt = 0; dt < HD / 16; ++dt)
#pragma unroll
            for (int k2 = 0; k2 < 2; ++k2) {
                const LAS unsigned char* vblk = Vt + (kt * 64 + k2 * 32 + g * 4 + (fr >> 2)) * vstr + (dt * 16 + (fr & 3) * 4) * 2;
                const s16x4 lo = tr_read(vblk), hi = tr_read(vblk + 16 * vstr);
                const bf16x8 vf = __builtin_shufflevector(lo, hi, 0, 1, 2, 3, 4, 5, 6, 7);
#pragma unroll
                for (int mt = 0; mt < 2; ++mt) o[mt][dt] = __builtin_amdgcn_mfma_f32_16x16x32_bf16(vf, pf[mt][k2], o[mt][dt], 0, 0, 0);
            }
    }
#pragma unroll
    for (int mt = 0; mt < 2; ++mt) { const float inv = 1.0f / lrow[mt];
#pragma unroll
        for (int dt = 0; dt < HD / 16; ++dt) o[mt][dt] *= inv; }
}

__device__ __forceinline__ void vt_scatter(LAS unsigned char* Vt, int vstr, int d0, int key, u32x4 v) {
    LAS unsigned char* p = Vt + d0 * vstr + key * 2;
    *(LAS bf16*)(p + 0 * vstr) = (bf16)(v.x & 0xffffu); *(LAS bf16*)(p + 1 * vstr) = (bf16)(v.x >> 16);
    *(LAS bf16*)(p + 2 * vstr) = (bf16)(v.y & 0xffffu); *(LAS bf16*)(p + 3 * vstr) = (bf16)(v.y >> 16);
    *(LAS bf16*)(p + 4 * vstr) = (bf16)(v.z & 0xffffu); *(LAS bf16*)(p + 5 * vstr) = (bf16)(v.z >> 16);
    *(LAS bf16*)(p + 6 * vstr) = (bf16)(v.w & 0xffffu); *(LAS bf16*)(p + 7 * vstr) = (bf16)(v.w >> 16);
}

__device__ __forceinline__ void swa_unit(int unit, const GAS bf16* proj, const GAS float* sinks_l, GAS bf16* Y, LAS unsigned char* lds, int tid) {
    const int b = unit >> 6, kvh = (unit >> 4) & 3, blk = unit & 15;
    const int lane = tid & 63, w = __builtin_amdgcn_readfirstlane(tid >> 6), fr = lane & 15, g = lane >> 4;
    constexpr int KSTR = 144, VSTR = 160;
    LAS unsigned char* Ks = lds; LAS unsigned char* Vt = lds + 256 * KSTR;
    __syncthreads();
#pragma unroll
    for (int i = 0; i < 4; ++i) { const int c = tid + NTHR * i, key = c >> 3, part = c & 7;
        const int tok = (blk == 0) ? (key & 127) : (blk - 1) * 128 + key;
        const GAS bf16* src = proj + (size_t)(b * SEQ + tok) * QKVW + kvh * 64 + part * 8;
        const u32x4 kv = *(const GAS u32x4*)(src + C_KA); const u32x4 vv = *(const GAS u32x4*)(src + C_VA);
        *(LAS u32x4*)(Ks + key * KSTR + part * 16) = kv; *(LAS u32x4*)(Vt + key * VSTR + part * 16) = vv; }
    __syncthreads();
    const int head = kvh * 4 + (w >> 1), half = w & 1;
    const float sink2 = sinks_l[head] * LOG2E;
    for (int pass = 0; pass < 2; ++pass) {
        const int t0 = half * 64 + pass * 32;
        bf16x8 qf[2][2];
#pragma unroll
        for (int mt = 0; mt < 2; ++mt)
#pragma unroll
            for (int kk = 0; kk < 2; ++kk) qf[mt][kk] = *(const GAS bf16x8*)(proj + (size_t)(b * SEQ + blk * 128 + t0 + mt * 16 + fr) * QKVW + C_QA + head * 64 + kk * 32 + g * 8);
        int kt_lo = (t0 + 1) >> 6; const int kt_hi = (t0 + 159) >> 6; if (blk == 0 && kt_lo < 2) kt_lo = 2;
        f32x4 o[2][4];
        attn_wave32<64, true>(Ks, KSTR, Vt, VSTR, qf, o, sink2, 1.0f, 0.125f * LOG2E, kt_lo, kt_hi, t0, blk == 0, lane);
#pragma unroll
        for (int mt = 0; mt < 2; ++mt)
#pragma unroll
            for (int dt = 0; dt < 4; ++dt) { u32x2 wv; wv.x = cvt_pk_bf16(o[mt][dt][0], o[mt][dt][1]); wv.y = cvt_pk_bf16(o[mt][dt][2], o[mt][dt][3]);
                *(GAS u32x2*)(Y + (size_t)(b * SEQ + blk * 128 + t0 + mt * 16 + fr) * YW + head * 64 + dt * 16 + g * 4) = wv; }
    }
}

__device__ __forceinline__ void xattn_unit(int unit, int l, const GAS bf16* KV, const GAS bf16* XQ, GAS bf16* XO, LAS unsigned char* lds, int tid) {
    const int b = unit >> 5, head = (unit >> 3) & 3, qb = unit & 7;
    const int lane = tid & 63, w = __builtin_amdgcn_readfirstlane(tid >> 6), fr = lane & 15, g = lane >> 4;
    constexpr int KSTR = 272, VSTR = 288;
    LAS unsigned char* Ks = lds; LAS unsigned char* Vt = lds + 256 * KSTR;
    __syncthreads();
#pragma unroll
    for (int i = 0; i < 8; ++i) { const int c = tid + NTHR * i, key = c >> 4, part = c & 15;
        const GAS bf16* src = KV + (size_t)(b * MEML + key) * 4096 + l * 1024 + head * 128 + part * 8;
        const u32x4 kv = *(const GAS u32x4*)src; const u32x4 vv = *(const GAS u32x4*)(src + 512);
        *(LAS u32x4*)(Ks + key * KSTR + part * 16) = kv; *(LAS u32x4*)(Vt + key * VSTR + part * 16) = vv; }
    __syncthreads();
    const size_t row0 = (size_t)b * SEQ + qb * 256 + w * 32;
    bf16x8 qf[2][4];
#pragma unroll
    for (int mt = 0; mt < 2; ++mt)
#pragma unroll
        for (int kk = 0; kk < 4; ++kk) qf[mt][kk] = *(const GAS bf16x8*)(XQ + (row0 + mt * 16 + fr) * XD + head * 128 + kk * 32 + g * 8);
    f32x4 o[2][8];
    attn_wave32<128, false>(Ks, KSTR, Vt, VSTR, qf, o, -INFINITY, 0.0f, 0.08838834764831845f * LOG2E, 0, 3, 0, false, lane);
#pragma unroll
    for (int mt = 0; mt < 2; ++mt)
#pragma unroll
        for (int dt = 0; dt < 8; ++dt) { u32x2 wv; wv.x = cvt_pk_bf16(o[mt][dt][0], o[mt][dt][1]); wv.y = cvt_pk_bf16(o[mt][dt][2], o[mt][dt][3]);
            *(GAS u32x2*)(XO + (row0 + mt * 16 + fr) * XD + head * 128 + dt * 16 + g * 4) = wv; }
}

__device__ __forceinline__ void sgu_unit(int unit, const GAS bf16* ubuf, const GAS bf16* vbuf, const GAS float* ln_g, const GAS float* ln_b, const GAS float* sw, const GAS float* sb, GAS bf16* Y, LAS unsigned char* lds, int tid) {
    const int b = unit >> 4, c = unit & 15;
    const int lane = tid & 63, w = __builtin_amdgcn_readfirstlane(tid >> 6), fr = lane & 15, g = lane >> 4;
    constexpr int VSTR = 288, WSTR = 272;
    LAS unsigned char* VN = lds; LAS unsigned char* Ws = lds + 128 * VSTR; LAS float* stat = (LAS float*)(lds + 128 * VSTR + 128 * WSTR);
    const size_t tok0 = (size_t)b * SEQ + c * 128;
    u32x4 va[4]; f32x4 wv[8]; u32x2 uu[8];
#define SGU_LOAD(gg) do { _Pragma("unroll") for (int i = 0; i < 4; ++i) { const int cc = tid + NTHR * i, s = cc >> 4, part = cc & 15; va[i] = *(const GAS u32x4*)(vbuf + (tok0 + s) * 1024 + (gg) * 128 + part * 8); } \
        _Pragma("unroll") for (int i = 0; i < 8; ++i) { const int idx = tid + NTHR * i; wv[i] = *(const GAS f32x4*)(sw + (size_t)(gg) * 16384 + idx * 4); } \
        _Pragma("unroll") for (int et = 0; et < 8; ++et) uu[et] = *(const GAS u32x2*)(ubuf + (tok0 + w * 16 + fr) * 1024 + (gg) * 128 + et * 16 + g * 4); } while (0)
    SGU_LOAD(0);
    __syncthreads();
    for (int bt = 0; bt < 2; ++bt) {
        u32x4 a0[8], a1[8];
#pragma unroll
        for (int i = 0; i < 8; ++i) { const GAS bf16* src = vbuf + (tok0 + w * 16 + bt * 8 + i) * 1024 + lane * 16; a0[i] = *(const GAS u32x4*)src; a1[i] = *(const GAS u32x4*)(src + 8); }
        float s1[8], s2[8];
#pragma unroll
        for (int i = 0; i < 8; ++i) { float x[16];
            x[0] = geluf_(bf_lo(a0[i].x)); x[1] = geluf_(bf_hi(a0[i].x)); x[2] = geluf_(bf_lo(a0[i].y)); x[3] = geluf_(bf_hi(a0[i].y));
            x[4] = geluf_(bf_lo(a0[i].z)); x[5] = geluf_(bf_hi(a0[i].z)); x[6] = geluf_(bf_lo(a0[i].w)); x[7] = geluf_(bf_hi(a0[i].w));
            x[8] = geluf_(bf_lo(a1[i].x)); x[9] = geluf_(bf_hi(a1[i].x)); x[10] = geluf_(bf_lo(a1[i].y)); x[11] = geluf_(bf_hi(a1[i].y));
            x[12] = geluf_(bf_lo(a1[i].z)); x[13] = geluf_(bf_hi(a1[i].z)); x[14] = geluf_(bf_lo(a1[i].w)); x[15] = geluf_(bf_hi(a1[i].w));
            float p1 = 0.f, p2 = 0.f;
#pragma unroll
            for (int e = 0; e < 16; ++e) { p1 += x[e]; p2 += x[e] * x[e]; }
            s1[i] = p1; s2[i] = p2; }
#pragma unroll
        for (int o = 1; o < 64; o <<= 1)
#pragma unroll
            for (int i = 0; i < 8; ++i) { s1[i] += __shfl_xor(s1[i], o); s2[i] += __shfl_xor(s2[i], o); }
        if (lane < 8) { float m1 = s1[0], m2 = s2[0];
#pragma unroll
            for (int i = 1; i < 8; ++i) { m1 = (lane == i) ? s1[i] : m1; m2 = (lane == i) ? s2[i] : m2; }
            const float mean = m1 * (1.f / 1024.f); const float var = fmaxf(m2 * (1.f / 1024.f) - mean * mean, 0.f);
            const int s = w * 16 + bt * 8 + lane; stat[2 * s] = mean; stat[2 * s + 1] = __builtin_amdgcn_rsqf(var + EPS); }
    }
    __syncthreads();
    for (int grp = 0; grp < 8; ++grp) {
#pragma unroll
        for (int i = 0; i < 4; ++i) { const int cc = tid + NTHR * i, s = cc >> 4, part = cc & 15; const int ch = grp * 128 + part * 8;
            const f32x4 g0 = *(const GAS f32x4*)(ln_g + ch), g1 = *(const GAS f32x4*)(ln_g + ch + 4), b0 = *(const GAS f32x4*)(ln_b + ch), b1 = *(const GAS f32x4*)(ln_b + ch + 4);
            const float mean = stat[2 * s], rstd = stat[2 * s + 1]; const u32x4 a0 = va[i];
            float y[8];
            y[0] = (geluf_(bf_lo(a0.x)) - mean) * rstd * g0.x + b0.x; y[1] = (geluf_(bf_hi(a0.x)) - mean) * rstd * g0.y + b0.y;
            y[2] = (geluf_(bf_lo(a0.y)) - mean) * rstd * g0.z + b0.z; y[3] = (geluf_(bf_hi(a0.y)) - mean) * rstd * g0.w + b0.w;
            y[4] = (geluf_(bf_lo(a0.z)) - mean) * rstd * g1.x + b1.x; y[5] = (geluf_(bf_hi(a0.z)) - mean) * rstd * g1.y + b1.y;
            y[6] = (geluf_(bf_lo(a0.w)) - mean) * rstd * g1.z + b1.z; y[7] = (geluf_(bf_hi(a0.w)) - mean) * rstd * g1.w + b1.w;
            u32x4 pk; pk.x = cvt_pk_bf16(y[0], y[1]); pk.y = cvt_pk_bf16(y[2], y[3]); pk.z = cvt_pk_bf16(y[4], y[5]); pk.w = cvt_pk_bf16(y[6], y[7]);
            *(LAS u32x4*)(VN + s * VSTR + part * 16) = pk; }
#pragma unroll
        for (int i = 0; i < 8; ++i) { const int idx = tid + NTHR * i, t = idx >> 5, s4 = (idx & 31) * 4; f32x4 x = wv[i];
            x.x = (s4 + 0 <= t) ? x.x : 0.f; x.y = (s4 + 1 <= t) ? x.y : 0.f; x.z = (s4 + 2 <= t) ? x.z : 0.f; x.w = (s4 + 3 <= t) ? x.w : 0.f;
            u32x2 pk; pk.x = cvt_pk_bf16(x.x, x.y); pk.y = cvt_pk_bf16(x.z, x.w);
            *(LAS u32x2*)(Ws + t * WSTR + s4 * 2) = pk; }
        u32x2 uc[8];
#pragma unroll
        for (int et = 0; et < 8; ++et) uc[et] = uu[et];
        __syncthreads();
        if (grp + 1 < 8) SGU_LOAD(grp + 1);
        f32x4 acc[8];
#pragma unroll
        for (int et = 0; et < 8; ++et) acc[et] = (f32x4){0.f, 0.f, 0.f, 0.f};
        const int nkk = ((w * 16 + 15) >> 5) + 1;
        for (int kk = 0; kk < nkk; ++kk) {
            const LAS unsigned char* wrow = Ws + (w * 16 + fr) * WSTR + (kk * 32 + g * 4) * 2;
            const u32x2 ylo = *(const LAS u32x2*)wrow, yhi = *(const LAS u32x2*)(wrow + 32);
            u32x4 yw; yw.x = ylo.x; yw.y = ylo.y; yw.z = yhi.x; yw.w = yhi.y; const bf16x8 yf = __builtin_bit_cast(bf16x8, yw);
#pragma unroll
            for (int et = 0; et < 8; ++et) { const LAS unsigned char* vblk = VN + (kk * 32 + g * 4 + (fr >> 2)) * VSTR + (et * 16 + (fr & 3) * 4) * 2;
                const s16x4 lo = tr_read(vblk), hi = tr_read(vblk + 16 * VSTR);
                acc[et] = __builtin_amdgcn_mfma_f32_16x16x32_bf16(__builtin_shufflevector(lo, hi, 0, 1, 2, 3, 4, 5, 6, 7), yf, acc[et], 0, 0, 0); }
        }
        const int t = w * 16 + fr; const float bias = sb[grp * 128 + t];
#pragma unroll
        for (int et = 0; et < 8; ++et) { const int ch = grp * 128 + et * 16 + g * 4; const u32x2 u2 = uc[et];
            const float o0 = geluf_(bf_lo(u2.x)) * (acc[et][0] + bias), o1 = geluf_(bf_hi(u2.x)) * (acc[et][1] + bias), o2 = geluf_(bf_lo(u2.y)) * (acc[et][2] + bias), o3 = geluf_(bf_hi(u2.y)) * (acc[et][3] + bias);
            u32x2 wo; wo.x = cvt_pk_bf16(o0, o1); wo.y = cvt_pk_bf16(o2, o3);
            *(GAS u32x2*)(Y + (tok0 + t) * YW + 1024 + ch) = wo; }
        __syncthreads();
    }
#undef SGU_LOAD
}

__device__ __forceinline__ void hgrn_unit(int unit, int l, const GAS bf16* hb, const GAS float* hgrn_lb, const GAS float* norm_g, GAS bf16* Y, LAS unsigned char* lds, int tid) {
    const int b = unit >> 3, h = unit & 7;
    const int lane = tid & 63, w = __builtin_amdgcn_readfirstlane(tid >> 6), fr = lane & 15, g = lane >> 4;
    const int d = tid & 127, J = tid >> 7, Ju = w >> 1;
    constexpr int RS = 272, TS = 144;
    LAS unsigned char* U = lds; LAS unsigned char* Wm = lds + 17408; LAS unsigned char* Qe = lds + 60928; LAS unsigned char* KeT = lds + 78336; LAS unsigned char* VT = lds + 96768;
    LAS unsigned char* Am = lds + 115200; LAS float* Gs = (LAS float*)(lds + 124416); LAS float* DEC = (LAS float*)(lds + 126464); LAS float* SS = (LAS float*)(lds + 126976);
    const int ch = h * 128 + d;
    float lb;
    { const float v0 = hgrn_lb[ch], v1 = hgrn_lb[1024 + ch], v2 = hgrn_lb[2048 + ch], v3 = hgrn_lb[3072 + ch];
      const float mx = fmaxf(fmaxf(v0, v1), fmaxf(v2, v3));
      const float e0 = __expf(v0 - mx), e1 = __expf(v1 - mx), e2 = __expf(v2 - mx), e3 = __expf(v3 - mx); const float inv = 1.0f / (e0 + e1 + e2 + e3);
      lb = (l >= 1 ? e1 * inv : 0.f) + (l >= 2 ? e2 * inv : 0.f) + (l >= 3 ? e3 * inv : 0.f); }
    __syncthreads();
    for (int i = tid; i < 9216 / 4; i += NTHR) ((LAS unsigned*)Am)[i] = 0u;
    f32x4 st[8];
#pragma unroll
    for (int dt = 0; dt < 8; ++dt) st[dt] = (f32x4){0.f, 0.f, 0.f, 0.f};
    const int wbase[4] = {0, 16, 48, 96};
    const int base_J = (J == 0) ? 0 : (J == 1) ? 16 : (J == 2) ? 48 : 96;
    (void)wbase;
    constexpr size_t HBS = (size_t)32 << 20;
    const GAS bf16* pb = hb + (size_t)((b * 8 + h) * SEQ) * 128;
    const f32x4 ngv = *(const GAS f32x4*)(norm_g + w * 16 + g * 4);
    unsigned fraw[16], qraw[16], iraw[16];
#define HG_LOAD(cc) do { const GAS bf16* cb_ = pb + (size_t)((cc) * 64 + 16 * Ju) * 128 + (w & 1) * 64 + lane; \
        _Pragma("unroll") for (int tt = 0; tt < 16; ++tt) { fraw[tt] = cb_[tt * 128]; iraw[tt] = cb_[HBS + tt * 128]; qraw[tt] = cb_[2 * HBS + tt * 128]; } } while (0)
    HG_LOAD(0);
    for (int c = 0; c < 32; ++c) {
        const int tok0 = c * 64;
        float f[16], qs[16]; unsigned vraw[8];
        {
            float gp = 1.f;
#pragma unroll
            for (int tt = 0; tt < 16; ++tt) {
                const float fl = __builtin_bit_cast(float, fraw[tt] << 16), qv = __builtin_bit_cast(float, qraw[tt] << 16); const unsigned iv = iraw[tt];
                f[tt] = lb + (1.f - lb) * sigmoidf_(fl); qs[tt] = siluf_(qv) * 0.08838834764831845f; gp *= f[tt];
                if (tt & 1) vraw[tt >> 1] |= iv << 16; else vraw[tt >> 1] = iv; }
            Gs[J * 128 + d] = gp;
        }
        __syncthreads();
        {
            const float G0 = Gs[d], G1 = Gs[128 + d], G2 = Gs[256 + d], G3 = Gs[384 + d];
            const float EJ = (J == 0) ? 1.f : (J == 1) ? G0 : (J == 2) ? G0 * G1 : G0 * G1 * G2;
            const float TJ = (J == 0) ? G1 * G2 * G3 : (J == 1) ? G2 * G3 : (J == 2) ? G3 : 1.f;
            if (J == 0) DEC[d] = G0 * G1 * G2 * G3;
            *(LAS u32x4*)(VT + d * TS + J * 32) = (u32x4){vraw[0], vraw[1], vraw[2], vraw[3]};
            *(LAS u32x4*)(VT + d * TS + J * 32 + 16) = (u32x4){vraw[4], vraw[5], vraw[6], vraw[7]};
            float p = 1.f;
#pragma unroll
            for (int tt = 0; tt < 16; ++tt) { p *= f[tt]; const float u = qs[tt] * p; const int t = 16 * J + tt;
                *(LAS bf16*)(U + t * RS + d * 2) = (bf16)(cvt_pk_bf16(u, 0.f) & 0xffffu);
                *(LAS bf16*)(Qe + t * RS + d * 2) = (bf16)(cvt_pk_bf16(u * EJ, 0.f) & 0xffffu);
                const float kd = (1.f - f[tt]) / fmaxf(p, 1e-30f);
                *(LAS bf16*)(Wm + (base_J + t) * RS + d * 2) = (bf16)(cvt_pk_bf16(kd, 0.f) & 0xffffu); }
            float sfx = 1.f; unsigned kep[8];
#pragma unroll
            for (int tt = 15; tt >= 0; --tt) { const float ks = (1.f - f[tt]) * sfx; sfx *= f[tt]; const int t = 16 * J + tt;
                if (J == 0) { *(LAS bf16*)(Wm + (16 + t) * RS + d * 2) = (bf16)(cvt_pk_bf16(ks, 0.f) & 0xffffu);
                              *(LAS bf16*)(Wm + (48 + t) * RS + d * 2) = (bf16)(cvt_pk_bf16(ks * G1, 0.f) & 0xffffu);
                              *(LAS bf16*)(Wm + (96 + t) * RS + d * 2) = (bf16)(cvt_pk_bf16(ks * G1 * G2, 0.f) & 0xffffu); }
                else if (J == 1) { *(LAS bf16*)(Wm + (48 + t) * RS + d * 2) = (bf16)(cvt_pk_bf16(ks, 0.f) & 0xffffu);
                                   *(LAS bf16*)(Wm + (96 + t) * RS + d * 2) = (bf16)(cvt_pk_bf16(ks * G2, 0.f) & 0xffffu); }
                else if (J == 2) { *(LAS bf16*)(Wm + (96 + t) * RS + d * 2) = (bf16)(cvt_pk_bf16(ks, 0.f) & 0xffffu); }
                const unsigned kb = cvt_pk_bf16(ks * TJ, 0.f) & 0xffffu;
                if (tt & 1) kep[tt >> 1] = kb << 16; else kep[tt >> 1] |= kb; }
            *(LAS u32x4*)(KeT + d * TS + J * 32) = (u32x4){kep[0], kep[1], kep[2], kep[3]};
            *(LAS u32x4*)(KeT + d * TS + J * 32 + 16) = (u32x4){kep[4], kep[5], kep[6], kep[7]};
        }
        __syncthreads();
        if (c + 1 < 32) HG_LOAD(c + 1);
        __builtin_amdgcn_sched_barrier(0);
        for (int ti = w; ti < 10; ti += 8) {
            const int I = (ti == 0) ? 0 : (ti < 3) ? 1 : (ti < 6) ? 2 : 3; const int Jt = ti - ((I * (I + 1)) >> 1);
            const int bI = (I == 0) ? 0 : (I == 1) ? 16 : (I == 2) ? 48 : 96;
            f32x4 a = (f32x4){0.f, 0.f, 0.f, 0.f};
#pragma unroll
            for (int kk = 0; kk < 4; ++kk) { const bf16x8 xf = *(const LAS bf16x8*)(Wm + (bI + 16 * Jt + fr) * RS + (kk * 32 + g * 8) * 2);
                const bf16x8 yf = *(const LAS bf16x8*)(U + (16 * I + fr) * RS + (kk * 32 + g * 8) * 2);
                a = __builtin_amdgcn_mfma_f32_16x16x32_bf16(xf, yf, a, 0, 0, 0); }
            if (Jt == I) {
#pragma unroll
                for (int e = 0; e < 4; ++e) a[e] = (4 * g + e > fr) ? 0.f : a[e]; }
            u32x2 pk; pk.x = cvt_pk_bf16(a[0], a[1]); pk.y = cvt_pk_bf16(a[2], a[3]);
            *(LAS u32x2*)(Am + (16 * I + fr) * TS + (16 * Jt + 4 * g) * 2) = pk;
        }
        f32x4 o[4];
#pragma unroll
        for (int tt = 0; tt < 4; ++tt) o[tt] = (f32x4){0.f, 0.f, 0.f, 0.f};
#pragma unroll
        for (int kk = 0; kk < 4; ++kk) {
            u32x4 sw; sw.x = cvt_pk_bf16(st[2 * kk][0], st[2 * kk][1]); sw.y = cvt_pk_bf16(st[2 * kk][2], st[2 * kk][3]);
            sw.z = cvt_pk_bf16(st[2 * kk + 1][0], st[2 * kk + 1][1]); sw.w = cvt_pk_bf16(st[2 * kk + 1][2], st[2 * kk + 1][3]);
            const bf16x8 sx = __builtin_bit_cast(bf16x8, sw);
#pragma unroll
            for (int tt = 0; tt < 4; ++tt) { const LAS unsigned char* qrow = Qe + (16 * tt + fr) * RS + (kk * 32 + g * 4) * 2;
                const u32x2 lo = *(const LAS u32x2*)qrow, hi = *(const LAS u32x2*)(qrow + 32);
                u32x4 qw; qw.x = lo.x; qw.y = lo.y; qw.z = hi.x; qw.w = hi.y;
                o[tt] = __builtin_amdgcn_mfma_f32_16x16x32_bf16(sx, __builtin_bit_cast(bf16x8, qw), o[tt], 0, 0, 0); }
        }
        __syncthreads();
        u32x2 ggv[4];
#pragma unroll
        for (int tt = 0; tt < 4; ++tt) ggv[tt] = *(const GAS u32x2*)(pb + 3 * HBS + (size_t)(tok0 + 16 * tt + fr) * 128 + w * 16 + g * 4);
        bf16x8 vfr[2];
#pragma unroll
        for (int kk = 0; kk < 2; ++kk) vfr[kk] = *(const LAS bf16x8*)(VT + (16 * w + fr) * TS + (kk * 32 + g * 8) * 2);
#pragma unroll
        for (int tt = 0; tt < 4; ++tt)
#pragma unroll
            for (int kk = 0; kk < 2; ++kk) if (kk <= (tt >> 1)) {
                const bf16x8 yf = *(const LAS bf16x8*)(Am + (16 * tt + fr) * TS + (kk * 32 + g * 8) * 2);
                o[tt] = __builtin_amdgcn_mfma_f32_16x16x32_bf16(vfr[kk], yf, o[tt], 0, 0, 0); }
#pragma unroll
        for (int dt = 0; dt < 8; ++dt) { const f32x4 dec = *(const LAS f32x4*)(DEC + 16 * dt + 4 * g); st[dt] *= dec;
#pragma unroll
            for (int kk = 0; kk < 2; ++kk) { const bf16x8 xf = *(const LAS bf16x8*)(KeT + (16 * dt + fr) * TS + (kk * 32 + g * 8) * 2);
                st[dt] = __builtin_amdgcn_mfma_f32_16x16x32_bf16(xf, vfr[kk], st[dt], 0, 0, 0); } }
#pragma unroll
        for (int tt = 0; tt < 4; ++tt) { float q2 = o[tt][0] * o[tt][0] + o[tt][1] * o[tt][1] + o[tt][2] * o[tt][2] + o[tt][3] * o[tt][3];
            q2 += __shfl_xor(q2, 16); q2 += __shfl_xor(q2, 32);
            if (g == 0) SS[w * 64 + 16 * tt + fr] = q2; }
        __syncthreads();
#pragma unroll
        for (int tt = 0; tt < 4; ++tt) { const int t = 16 * tt + fr; float tot = 0.f;
#pragma unroll
            for (int ww = 0; ww < 8; ++ww) tot += SS[ww * 64 + t];
            const float rstd = __builtin_amdgcn_rsqf(tot * (1.f / 128.f) + EPS);
            const size_t tok = (size_t)b * SEQ + tok0 + t; const int e0 = h * 128 + w * 16 + g * 4;
            const u32x2 gg = ggv[tt];
            const float y0 = o[tt][0] * rstd * ngv.x * siluf_(bf_lo(gg.x)), y1 = o[tt][1] * rstd * ngv.y * siluf_(bf_hi(gg.x));
            const float y2 = o[tt][2] * rstd * ngv.z * siluf_(bf_lo(gg.y)), y3 = o[tt][3] * rstd * ngv.w * siluf_(bf_hi(gg.y));
            u32x2 wv; wv.x = cvt_pk_bf16(y0, y1); wv.y = cvt_pk_bf16(y2, y3);
            *(GAS u32x2*)(Y + tok * YW + 2048 + e0) = wv; }
    }
#undef HG_LOAD
}
#ifndef MK_MULTI
#define MK_MULTI 0
#endif
#ifndef PH_MASK
#define PH_MASK 0xFFFFF
#endif
#define HASP(p) (((PH_MASK) >> (p)) & 1)
#ifndef DUP_MASK
#define DUP_MASK 0
#endif
#define DUPP(p) (((DUP_MASK) >> (p)) & 1)
constexpr int NPH_LAYER = 12, NPH = NL * NPH_LAYER + 1;
struct Args { const float* in[25]; float* out; unsigned char* ws; int ph_lo, ph_hi; };
enum { I_X = 0, I_MEM, I_NORM_MIX, I_W_IN, I_W_GATE, I_SINKS, I_SGU_LN_G, I_SGU_LN_B, I_SGU_W, I_SGU_B, I_HGRN_LB, I_HGRN_NORM, I_W_BR_A, I_W_BR_B, I_W_BR_C, I_W_OUT, I_NORM_X, I_MEM_NORM,
       I_W_XQ, I_W_XKV, I_W_XO, I_NORM_FFN, I_W_FFN_IN, I_W_FFN_OUT, I_FINAL_NORM };

#define CIN(i) ((const GAS float*)(((uintptr_t)(unsigned)__builtin_amdgcn_readfirstlane((int)lctl[17 + 2 * (i)]) << 32) | (uintptr_t)(unsigned)__builtin_amdgcn_readfirstlane((int)lctl[16 + 2 * (i)])))
__device__ __forceinline__ void conv_phase(volatile LAS unsigned* lctl, int l, GAS unsigned char* ws, LAS float* scr, int gw, int NGW, int lane) {
    constexpr int I_IN = 32 * 240, I_GT = 32 * 192, I_BR = 16 * 64, I_OUT = 32 * 64, I_XQ = 32 * 16, I_XO = 8 * 64, I_F1 = 32 * 352, I_F2 = 88 * 64;
    constexpr int NITEMS = I_IN + I_GT + 3 * I_BR + I_OUT + I_XQ + I_XO + I_F1 + I_F2;
    GAS bf16* cWcat = (GAS bf16*)(ws + WS_WCAT); GAS bf16* cWbr = (GAS bf16*)(ws + WS_WBR); GAS bf16* cWout = (GAS bf16*)(ws + WS_WOUT); GAS bf16* cWxq = (GAS bf16*)(ws + WS_WXQ); GAS bf16* cWxo = (GAS bf16*)(ws + WS_WXO);
    GAS bf16* cWf1 = (GAS bf16*)(ws + WS_WF1); GAS bf16* cWf2 = (GAS bf16*)(ws + WS_WF2);
    for (int it = gw; it < NITEMS; it += NGW) {
        int r = it;
        if (r < I_IN) { const int kb = r / 240, nb = r % 240; tr_item(CIN(I_W_IN) + (size_t)l * DM * INW, INW, cWcat, DM, 64 * kb, 32 * nb, 32 * nb, scr, lane, CIN(I_NORM_MIX) + l * DM); continue; } r -= I_IN;
        if (r < I_GT) { const int kb = r / 192, nb = r % 192; tr_item(CIN(I_W_GATE) + (size_t)l * DM * GW, GW, cWcat, DM, 64 * kb, 32 * nb, INW + 32 * nb, scr, lane, CIN(I_NORM_MIX) + l * DM); continue; } r -= I_GT;
        if (r < 3 * I_BR) { const int j = r / I_BR, q = r % I_BR, kb = q / 64, nb = q % 64;
            tr_item(CIN(I_W_BR_A + j) + (size_t)l * 1024 * DM, DM, cWbr + (size_t)j * DM * 1024, 1024, 64 * kb, 32 * nb, 32 * nb, scr, lane); continue; } r -= 3 * I_BR;
        if (r < I_OUT) { const int kb = r / 64, nb = r % 64; tr_item(CIN(I_W_OUT) + (size_t)l * DM * DM, DM, cWout, DM, 64 * kb, 32 * nb, 32 * nb, scr, lane); continue; } r -= I_OUT;
        if (r < I_XQ) { const int kb = r / 16, nb = r % 16; tr_item(CIN(I_W_XQ) + (size_t)l * DM * XD, XD, cWxq, DM, 64 * kb, 32 * nb, 32 * nb, scr, lane, CIN(I_NORM_X) + l * DM); continue; } r -= I_XQ;
        if (r < I_XO) { const int kb = r / 64, nb = r % 64; tr_item(CIN(I_W_XO) + (size_t)l * XD * DM, DM, cWxo, XD, 64 * kb, 32 * nb, 32 * nb, scr, lane); continue; } r -= I_XO;
        if (r < I_F1) { const int kb = r / 352, nb = r % 352; const int n0 = 32 * nb; const int cc = (n0 < DFF) ? n0 : n0 - DFF; const int drow = 256 * (cc >> 7) + (cc & 127) + ((n0 < DFF) ? 0 : 128);
            tr_item(CIN(I_W_FFN_IN) + (size_t)l * DM * 2 * DFF, 2 * DFF, cWf1, DM, 64 * kb, n0, drow, scr, lane, CIN(I_NORM_FFN) + l * DM); continue; } r -= I_F1;
        { const int kb = r / 64, nb = r % 64; tr_item(CIN(I_W_FFN_OUT) + (size_t)l * DFF * DM, DM, cWf2, DFF, 64 * kb, 32 * nb, 32 * nb, scr, lane); }
    }
    if (l == 0) {
        GAS bf16* cWxkv = (GAS bf16*)(ws + WS_WXKV);
        for (int it = gw; it < 4 * 1024; it += NGW) { const int ll = it >> 10, q = it & 1023, kb = q >> 5, nb = q & 31;
            tr_item(CIN(I_W_XKV) + (size_t)ll * DM * 1024, 1024, cWxkv, DM, 64 * kb, 32 * nb, ll * 1024 + 32 * nb, scr, lane); }
        norm_phase(CIN(I_MEM), CIN(I_MEM_NORM), (GAS bf16*)(ws + WS_MEMN), MT, gw, NGW, lane);
    }
}

__global__ void __launch_bounds__(NTHR, 2) fwd_kernel(Args a) {
    extern __shared__ __attribute__((aligned(16))) unsigned char lds_raw[];
    LAS unsigned char* lds = (LAS unsigned char*)lds_raw;
    volatile LAS unsigned* lctl = (volatile LAS unsigned*)(lds + LDSCTL_OFF);
    const int tid0 = threadIdx.x;
    const int G = gridDim.x, bx = blockIdx.x;
    unsigned* ctl0 = (unsigned*)(a.ws + WS_CTL);
    for (int u = tid0; u < (LDS_BYTES - LDSCTL_OFF) / 4; u += NTHR) lctl[u] = 0u;
    __syncthreads();
    if (tid0 < 25) { lctl[16 + 2 * tid0] = (unsigned)(uintptr_t)a.in[tid0]; lctl[17 + 2 * tid0] = (unsigned)((uintptr_t)a.in[tid0] >> 32); }
    if (tid0 == 0) { lctl[8] = (unsigned)(uintptr_t)a.ws; lctl[9] = (unsigned)((uintptr_t)a.ws >> 32); lctl[10] = (unsigned)(uintptr_t)a.out; lctl[11] = (unsigned)((uintptr_t)a.out >> 32); }
    __syncthreads();
    const int lo = a.ph_lo, hi = a.ph_hi;
    XcdBarrier bar; bar.bar = ctl0 + CW_BAR; bar.x = 0; bar.st = nullptr;
    if (hi - lo > 1) bar = xcd_barrier_post(ctl0 + CW_BAR, lctl);
#define IN(k) (lo <= (k) && (k) < hi)
#define SEAM(k) do { if (IN(k) && IN((k) + 1)) xcd_barrier(bar); } while (0)

#define OPQ_PTR(TY, w) ((TY)(((uintptr_t)(unsigned)__builtin_amdgcn_readfirstlane((int)lctl[(w) + 1]) << 32) | (uintptr_t)(unsigned)__builtin_amdgcn_readfirstlane((int)lctl[(w)])))
#define PH_BEGIN int tid = threadIdx.x; asm volatile("" : "+v"(tid)); \
        GAS unsigned char* ws = OPQ_PTR(GAS unsigned char*, 8); GAS float* out = OPQ_PTR(GAS float*, 10); const int lane = tid & 63, wave = __builtin_amdgcn_readfirstlane(tid >> 6); const int gw = bx * NWAVES + wave, NGW = G * NWAVES; \
        (void)ws; (void)out; (void)lane; (void)gw; (void)NGW;
#define WSP(off) ((GAS bf16*)(ws + (off)))
#define GIN(i) OPQ_PTR(const GAS float*, 16 + 2 * (i))
    for (int l = 0; l < NL; ++l) {
        const int pb = l * NPH_LAYER;
        if (HASP(0) && IN(pb + 0)) for (int rep = 0; rep <= DUPP(0); ++rep) { if (rep) xcd_barrier(bar); PH_BEGIN
            conv_phase(lctl, l, ws, (LAS float*)(lds + wave * 16384), gw, NGW, lane);
            if (l == 0) xb_phase(GIN(I_X), WSP(WS_H), (GAS float*)(ws + WS_SS), gw, NGW, lane);
        }
        SEAM(pb + 0);
        if (HASP(1) && IN(pb + 1)) for (int rep = 0; rep <= DUPP(1); ++rep) { if (rep) xcd_barrier(bar); PH_BEGIN
            { pg8::PlainOrder S; S.init(T, NCAT, G, bx, WSP(WS_H), DM, WSP(WS_WCAT), DM); EpiCat E{ws + WS_PROJ, WSP(WS_GATE), RowScale{(const GAS float*)(ws + WS_SS), (LAS float*)(lds + LDS_RSTD)}};
              pg8::gemm_phase(lds, pg8::GemmK{DM, DM, DM}, S, E); }
            if (l == 0) { pg8::PlainOrder S; S.init(MT, 4096, G, bx, WSP(WS_MEMN), DM, WSP(WS_WXKV), DM); EpiPlain<false> E{WSP(WS_KV), 4096, RowScale{nullptr, nullptr}};
              pg8::gemm_phase(lds, pg8::GemmK{DM, DM, DM}, S, E); }
        }
        SEAM(pb + 1);
        if (HASP(2) && IN(pb + 2)) for (int rep = 0; rep <= DUPP(2); ++rep) { if (rep) xcd_barrier(bar);
            for (int r2 = 0; r2 <= DUPP(16); ++r2) { PH_BEGIN unsigned* q = (unsigned*)(a.ws + WS_CTL) + CW_Q + 256 * l + 16 * rep + 8 * r2;
              for (;;) { __syncthreads(); if (tid == 0) lctl[4] = xb_add(q, 1u); __syncthreads(); const int idx = (int)lctl[4]; if (idx >= NB * 8) break;
                hgrn_unit(idx, l, WSP(WS_PROJ + PJ_HB), GIN(I_HGRN_LB), GIN(I_HGRN_NORM) + l * 128, WSP(WS_Y), lds, tid); } }
            for (int r2 = 0; r2 <= DUPP(17); ++r2) { PH_BEGIN unsigned* q = (unsigned*)(a.ws + WS_CTL) + CW_Q + 256 * l + 16 * rep + 8 * r2;
              for (;;) { __syncthreads(); if (tid == 0) lctl[4] = xb_add(q + 64, 1u); __syncthreads(); const int idx = (int)lctl[4]; if (idx >= NB * 64) break;
                swa_unit(idx, WSP(WS_PROJ), GIN(I_SINKS) + l * 16, WSP(WS_Y), lds, tid); } }
            for (int r2 = 0; r2 <= DUPP(18); ++r2) { PH_BEGIN unsigned* q = (unsigned*)(a.ws + WS_CTL) + CW_Q + 256 * l + 16 * rep + 8 * r2;
              for (;;) { __syncthreads(); if (tid == 0) lctl[4] = xb_add(q + 128, 1u); __syncthreads(); const int idx = (int)lctl[4]; if (idx >= NB * 16) break;
                sgu_unit(idx, WSP(WS_PROJ + PJ_UB), WSP(WS_PROJ + PJ_VB), GIN(I_SGU_LN_G) + l * 1024, GIN(I_SGU_LN_B) + l * 1024, GIN(I_SGU_W) + (size_t)l * 8 * 16384, GIN(I_SGU_B) + l * 1024, WSP(WS_Y), lds, tid); } }
            __syncthreads();
        }
        SEAM(pb + 2);
        if (HASP(3) && IN(pb + 3)) for (int rep = 0; rep <= DUPP(3); ++rep) { if (rep) xcd_barrier(bar); PH_BEGIN
            pg8::PlainOrder S; S.init(T, DM, G, bx, WSP(WS_Y), YW, WSP(WS_WBR), 1024, 3, (size_t)1024 * 2, (size_t)DM * 1024 * 2);
            EpiBranch E{WSP(WS_GATE), WSP(WS_PROJ)};
            pg8::gemm_phase(lds, pg8::GemmK{1024, YW, 1024}, S, E);
        }
        SEAM(pb + 3);
        if (HASP(4) && IN(pb + 4)) for (int rep = 0; rep <= DUPP(4); ++rep) { if (rep) xcd_barrier(bar); PH_BEGIN
            pg8::PlainOrder S; S.init(T, DM, G, bx, WSP(WS_PROJ), DM, WSP(WS_WOUT), DM); EpiResid E{WSP(WS_H), rep ? WSP(WS_GATE) : WSP(WS_H), rep ? (GAS float*)nullptr : (GAS float*)(ws + WS_SS), (LAS float*)(lds + LDS_RED)};
            pg8::gemm_phase(lds, pg8::GemmK{DM, DM, DM}, S, E);
        }
        SEAM(pb + 4);
        if (HASP(6) && IN(pb + 6)) for (int rep = 0; rep <= DUPP(6); ++rep) { if (rep) xcd_barrier(bar); PH_BEGIN
            pg8::PlainOrder S; S.init(T, XD, G, bx, WSP(WS_H), DM, WSP(WS_WXQ), DM); EpiPlain<true> E{WSP(WS_Y), XD, RowScale{(const GAS float*)(ws + WS_SS), (LAS float*)(lds + LDS_RSTD)}};
            pg8::gemm_phase(lds, pg8::GemmK{DM, DM, DM}, S, E);
        }
        SEAM(pb + 6);
        if (HASP(7) && IN(pb + 7)) for (int rep = 0; rep <= DUPP(7); ++rep) { if (rep) xcd_barrier(bar); PH_BEGIN for (int u = bx; u < NB * 32; u += G) xattn_unit(u, l, WSP(WS_KV), WSP(WS_Y), WSP(WS_Y + 32 * MiB), lds, tid); __syncthreads(); }
        SEAM(pb + 7);
        if (HASP(8) && IN(pb + 8)) for (int rep = 0; rep <= DUPP(8); ++rep) { if (rep) xcd_barrier(bar); PH_BEGIN
            pg8::PlainOrder S; S.init(T, DM, G, bx, WSP(WS_Y + 32 * MiB), XD, WSP(WS_WXO), XD); EpiResid E{WSP(WS_H), rep ? WSP(WS_GATE) : WSP(WS_H), rep ? (GAS float*)nullptr : (GAS float*)(ws + WS_SS), (LAS float*)(lds + LDS_RED)};
            pg8::gemm_phase(lds, pg8::GemmK{XD, XD, XD}, S, E);
        }
        SEAM(pb + 8);
        if (HASP(10) && IN(pb + 10)) for (int rep = 0; rep <= DUPP(10); ++rep) { if (rep) xcd_barrier(bar); PH_BEGIN
            pg8::PlainOrder S; S.init(T, 2 * DFF, G, bx, WSP(WS_H), DM, WSP(WS_WF1), DM); EpiSwiglu E{WSP(WS_PROJ), RowScale{(const GAS float*)(ws + WS_SS), (LAS float*)(lds + LDS_RSTD)}};
            pg8::gemm_phase(lds, pg8::GemmK{DM, DM, DM}, S, E);
        }
        SEAM(pb + 10);
        if (HASP(11) && IN(pb + 11)) for (int rep = 0; rep <= DUPP(11); ++rep) { if (rep) xcd_barrier(bar); PH_BEGIN
            pg8::PlainOrder S; S.init(T, DM, G, bx, WSP(WS_PROJ), DFF, WSP(WS_WF2), DFF); EpiResid E{WSP(WS_H), rep ? WSP(WS_GATE) : WSP(WS_H), rep ? (GAS float*)nullptr : (GAS float*)(ws + WS_SS), (LAS float*)(lds + LDS_RED)};
            pg8::gemm_phase(lds, pg8::GemmK{DFF, DFF, DFF}, S, E);
        }
        SEAM(pb + 11);
    }
    if (HASP(12) && IN(NPH - 1)) { const int lane = tid0 & 63, wave = __builtin_amdgcn_readfirstlane(tid0 >> 6); final_norm_phase((const GAS unsigned short*)(a.ws + WS_H), (GAS float*)a.out, GIN(I_FINAL_NORM), (const GAS float*)(a.ws + WS_SS), bx * NWAVES + wave, G * NWAVES, lane); }
#undef IN
#undef SEAM
#undef PH_BEGIN
#undef OPQ_PTR
#undef WSP
#undef GIN
}

extern "C" void kernel_launch(void* const* d_in, const int* in_sizes, int n_in, void* d_out, int out_size, void* d_ws, size_t ws_size, hipStream_t stream) {
    static int grid = 0;
    if (grid == 0) {
        if (n_in != 25 || out_size != T * DM || ws_size < WS_END) { fprintf(stderr, "kernel_launch: unexpected shapes (n_in %d, out %d, ws %zu, need %zu)\n", n_in, out_size, ws_size, (size_t)WS_END); grid = -1; return; }
        int dev = 0, cus = 0, per_cu = 0;
        if (hipGetDevice(&dev) != hipSuccess || hipDeviceGetAttribute(&cus, hipDeviceAttributeMultiprocessorCount, dev) != hipSuccess) { grid = -1; return; }
        if (hipFuncSetAttribute((const void*)fwd_kernel, hipFuncAttributeMaxDynamicSharedMemorySize, LDS_BYTES) != hipSuccess) { fprintf(stderr, "kernel_launch: hipFuncSetAttribute failed\n"); grid = -1; return; }
        if (hipOccupancyMaxActiveBlocksPerMultiprocessor(&per_cu, (const void*)fwd_kernel, NTHR, LDS_BYTES) != hipSuccess || per_cu < 1)
            fprintf(stderr, "kernel_launch: occupancy query reports %d workgroups per CU\n", per_cu);
        (void)hipGetLastError();
        grid = cus;
    }
    if (grid < 0) return;
    if (hipMemsetAsync((char*)d_ws + WS_CTL, 0, CTL_ZERO_BYTES, stream) != hipSuccess) return;
    Args a{};
    for (int i = 0; i < 25; ++i) a.in[i] = (const float*)d_in[i];
    a.out = (float*)d_out; a.ws = (unsigned char*)d_ws;
#if MK_MULTI
    for (int p = 0; p < NPH; ++p) { a.ph_lo = p; a.ph_hi = p + 1; hipLaunchKernelGGL(fwd_kernel, dim3(grid), dim3(NTHR), LDS_BYTES, stream, a); }
#else
    a.ph_lo = 0; a.ph_hi = NPH;
    hipLaunchKernelGGL(fwd_kernel, dim3(grid), dim3(NTHR), LDS_BYTES, stream, a);
#endif
}
```

```cpp
#include <hip/hip_runtime.h>
#include <cstdio>
#include <cstdint>

#define LAS __attribute__((address_space(3)))
#define GAS __attribute__((address_space(1)))
typedef unsigned short bf16;
typedef short bf16x8 __attribute__((ext_vector_type(8)));
typedef float f32x4 __attribute__((ext_vector_type(4)));
typedef float f32x2 __attribute__((ext_vector_type(2)));
typedef unsigned u32x4 __attribute__((ext_vector_type(4)));
typedef unsigned u32x2 __attribute__((ext_vector_type(2)));
typedef GAS unsigned gu32;

__device__ __forceinline__ unsigned cvt_pk_bf16(float lo, float hi) { unsigned r; asm volatile("v_cvt_pk_bf16_f32 %0, %1, %2" : "=v"(r) : "v"(lo), "v"(hi)); return r; }
__device__ __forceinline__ float bf_lo(unsigned w) { return __builtin_bit_cast(float, w << 16); }
__device__ __forceinline__ float bf_hi(unsigned w) { return __builtin_bit_cast(float, w & 0xffff0000u); }
__device__ __forceinline__ float bf1(bf16 h) { return __builtin_bit_cast(float, (unsigned)h << 16); }
__device__ __forceinline__ float fast_exp(float x) { return __builtin_amdgcn_exp2f(x * 1.4426950408889634f); }
__device__ __forceinline__ float sigmoidf_(float x) { return __builtin_amdgcn_rcpf(1.0f + fast_exp(-x)); }
__device__ __forceinline__ float siluf_(float x) { return x * sigmoidf_(x); }
__device__ __forceinline__ float geluf_(float x) { return x * sigmoidf_(1.5957691216057308f * (x + 0.044715f * x * x * x)); }
__device__ __forceinline__ float wave_sum(float v) {
#pragma unroll
    for (int o = 1; o < 64; o <<= 1) v += __shfl_xor(v, o);
    return v;
}

typedef _Float16 f16x8 __attribute__((ext_vector_type(8)));
typedef _Float16 f16x4 __attribute__((ext_vector_type(4)));
typedef _Float16 f16x2 __attribute__((ext_vector_type(2)));
template <bool F16> __device__ __forceinline__ f32x4 mma16(bf16x8 a, bf16x8 b, f32x4 c) {
    if constexpr (F16) return __builtin_amdgcn_mfma_f32_16x16x32_f16(__builtin_bit_cast(f16x8, a), __builtin_bit_cast(f16x8, b), c, 0, 0, 0);
    else return __builtin_amdgcn_mfma_f32_16x16x32_bf16(a, b, c, 0, 0, 0);
}
#ifndef RES_F16
#define RES_F16 0
#endif
__device__ __forceinline__ unsigned cvt_pk_f16(float lo, float hi) { f16x2 h; h.x = (_Float16)lo; h.y = (_Float16)hi; return __builtin_bit_cast(unsigned, h); }
__device__ __forceinline__ float h_lo(unsigned w) { return (float)__builtin_bit_cast(f16x2, w).x; }
__device__ __forceinline__ float h_hi(unsigned w) { return (float)__builtin_bit_cast(f16x2, w).y; }
__device__ __forceinline__ unsigned cvt_pk_res(float lo, float hi) { return RES_F16 ? cvt_pk_f16(lo, hi) : cvt_pk_bf16(lo, hi); }
__device__ __forceinline__ float res_lo(unsigned w) { return RES_F16 ? h_lo(w) : bf_lo(w); }
__device__ __forceinline__ float res_hi(unsigned w) { return RES_F16 ? h_hi(w) : bf_hi(w); }
namespace pg8 {
constexpr int BM = 256, BK = 64, HALF = 128, HTB = HALF * BK * 2, STAGE_BYTES = 8 * HTB, NXCD = 8, WGM = 8;
__host__ __device__ __forceinline__ int lds_byte(int r, int c) { const int st = (r >> 4) * 2 + (c >> 5), rr = r & 15, cc = c & 31, ob = rr * 64 + cc * 2; return st * 1024 + (ob ^ (((ob >> 9) & 1) << 5)); }
__host__ __device__ __forceinline__ void stage_rc(int b, int& R, int& C) { const int st = b / 1024, sb = b % 1024, swz = sb ^ (((sb >> 9) & 1) << 5); R = (st >> 1) * 16 + swz / 64; C = (st & 1) * 32 + (swz % 64) / 2; }
__host__ __device__ __forceinline__ int perm32(int rho) { const int n = rho >> 4, i = rho & 15; return 8 * (i >> 2) + 4 * n + (i & 3); }

struct Unit { int pm, pn, aux; const GAS char* a; const GAS char* b; };
struct GemmK { int K, lda, ldb; };

__device__ __forceinline__ void tile_of(int L, int nM, int nN, int wgm, int& pm, int& pn) {
    const int nwg = nM * nN; int wgid = L;
    { const int q = nwg / NXCD, r = nwg % NXCD, xcd = wgid % NXCD, off = wgid / NXCD; wgid = (xcd < r ? xcd * (q + 1) : r * (q + 1) + (xcd - r) * q) + off; }
    const int nig = wgm * nN, gid = wgid / nig, fm = gid * wgm, gsz = (nM - fm) < wgm ? (nM - fm) : wgm;
    pm = fm + ((wgid % nig) % gsz); pn = (wgid % nig) / gsz;
}
struct PlainOrder {
    int nM, nN, nwg, G, c, sub, wgm; const GAS char* A; const GAS char* B; size_t tA, tB, asub, bsub;
    __device__ __forceinline__ void init(int M, int N, int G_, int c_, const GAS void* A_, int lda, const GAS void* B_, int ldb, int sub_ = 1, size_t asub_ = 0, size_t bsub_ = 0, int wgm_ = WGM) {
        nM = M / BM; nN = N / BM; nwg = nM * nN; G = G_; c = c_; A = (const GAS char*)A_; B = (const GAS char*)B_; tA = (size_t)BM * lda * 2; tB = (size_t)BM * ldb * 2; sub = sub_; asub = asub_; bsub = bsub_; wgm = wgm_; }
    __device__ __forceinline__ bool next(int i, Unit& u) const {
        const int ti = i / sub, j = i - ti * sub;
        const long L = (long)ti * G + c; if (L >= nwg) return false;
        tile_of((int)L, nM, nN, wgm, u.pm, u.pn); u.aux = j;
        u.a = A + (size_t)u.pm * tA + (size_t)j * asub; u.b = B + (size_t)u.pn * tB + (size_t)j * bsub; return true;
    }
};

template <class Epi, class Sched>
__device__ __forceinline__ void gemm_phase(LAS unsigned char* lds, const GemmK g, const Sched& S, const Epi& E) {
    int tid = threadIdx.x; asm volatile("" : "+v"(tid));
    const int wid = __builtin_amdgcn_readfirstlane(tid >> 6), lane = tid & 63, wr = wid >> 2, wc = wid & 3, fr = lane & 15, fq = lane >> 4;
    const int K = g.K, nt = K / BK;
    unsigned voffA[2], voffB[2];
#pragma unroll
    for (int i = 0; i < 2; ++i) { int R, C; stage_rc(tid * 16 + i * 8192, R, C); const int Rb = Epi::PERM ? ((R & ~31) + perm32(R & 31)) : R;
        voffA[i] = (unsigned)(R * g.lda + C) * 2u; voffB[i] = (unsigned)(Rb * g.ldb + C) * 2u; }
    const size_t kstep = (size_t)(BK * 2);
    const size_t hstepA = (size_t)HALF * g.lda * 2, hstepB = (size_t)HALF * g.ldb * 2;
    const unsigned ldsw = (unsigned)wid * 1024u;
    const int aoff = lds_byte(wr * 64 + fr, fq * 8), boff = lds_byte(wc * 32 + fr, fq * 8);
#define PG8_SA(b, h) (((b) * 2 + (h)) * HTB)
#define PG8_SB(b, h) ((4 + (b) * 2 + (h)) * HTB)
#define PG8_STAGE(bufoff, gbase, voff) do { _Pragma("unroll") for (int _i = 0; _i < 2; ++_i) \
        __builtin_amdgcn_global_load_lds((const GAS unsigned*)((gbase) + (voff)[_i]), (LAS unsigned*)(lds + (bufoff) + ldsw + _i * 8192), 16, 0, 0); } while (0)
#define PG8_LDA(dst, b, h) do { _Pragma("unroll") for (int m = 0; m < 4; ++m) _Pragma("unroll") for (int k = 0; k < 2; ++k) dst[m][k] = *(const LAS bf16x8*)(lds + PG8_SA(b, h) + aoff + m * 2048 + k * 1024); } while (0)
#define PG8_LDB(dst, b, h) do { _Pragma("unroll") for (int n = 0; n < 2; ++n) _Pragma("unroll") for (int k = 0; k < 2; ++k) dst[n][k] = *(const LAS bf16x8*)(lds + PG8_SB(b, h) + boff + n * 2048 + k * 1024); } while (0)
#define PG8_MMA(ai, bj, At, Bt) do { __builtin_amdgcn_s_setprio(1); _Pragma("unroll") for (int m = 0; m < 4; ++m) _Pragma("unroll") for (int n = 0; n < 2; ++n) _Pragma("unroll") for (int k = 0; k < 2; ++k) \
        acc[ai][bj][m][n] = mma16<Epi::F16>(Bt[n][k], At[m][k], acc[ai][bj][m][n]); __builtin_amdgcn_s_setprio(0); } while (0)
#define PG8_WAIT_V(n) asm volatile("s_waitcnt vmcnt(" #n ")" ::: "memory")
#define PG8_WAIT_L(n) asm volatile("s_waitcnt lgkmcnt(" #n ")" ::: "memory")
#define PG8_BAR __builtin_amdgcn_s_barrier()
#define PG8_SCHED __builtin_amdgcn_sched_barrier(0)
    Unit cur, nxt; int ui = 0;
    if (!S.next(0, cur)) return;
    E.prep(cur, 0, tid);
    f32x4 acc[2][2][4][2];
#pragma unroll
    for (int a = 0; a < 2; ++a)
#pragma unroll
        for (int b = 0; b < 2; ++b)
#pragma unroll
            for (int m = 0; m < 4; ++m)
#pragma unroll
                for (int n = 0; n < 2; ++n) acc[a][b][m][n] = (f32x4){0.f, 0.f, 0.f, 0.f};
    bf16x8 At[4][2], B0[2][2], B1[2][2];
    const GAS char* cA = cur.a; const GAS char* cB = cur.b;
    PG8_STAGE(PG8_SB(0, 0), cB, voffB); PG8_STAGE(PG8_SB(0, 1), cB + hstepB, voffB); PG8_STAGE(PG8_SA(0, 0), cA, voffA); PG8_STAGE(PG8_SA(0, 1), cA + hstepA, voffA);
    if (wr == 1) PG8_BAR;
    PG8_WAIT_V(2); PG8_BAR;
    PG8_STAGE(PG8_SB(1, 0), cB + kstep, voffB); PG8_STAGE(PG8_SA(1, 0), cA + kstep, voffA); PG8_STAGE(PG8_SB(1, 1), cB + hstepB + kstep, voffB);
    PG8_WAIT_V(6); PG8_BAR;
    for (;;) {
        const bool has_next = S.next(ui + 1, nxt);
        const GAS char* nA = has_next ? nxt.a : cA; const GAS char* nB = has_next ? nxt.b : cB;
        for (int t = 0; t < nt; t += 2) {
            const bool last = (t == nt - 2);
            const GAS char* a1 = cA + (size_t)(t + 1) * kstep;
            const GAS char* a2 = last ? nA : cA + (size_t)(t + 2) * kstep; const GAS char* b2 = last ? nB : cB + (size_t)(t + 2) * kstep;
            const GAS char* a3 = a2 + kstep; const GAS char* b3 = b2 + kstep;
            PG8_LDB(B0, 0, 0); PG8_LDB(B1, 0, 1); PG8_SCHED; PG8_LDA(At, 0, 0); PG8_STAGE(PG8_SA(1, 1), a1 + hstepA, voffA);
            PG8_WAIT_V(8); PG8_WAIT_L(0); PG8_BAR; PG8_MMA(0, 0, At, B0); PG8_MMA(0, 1, At, B1); PG8_BAR; PG8_SCHED;
            PG8_LDA(At, 0, 1); PG8_STAGE(PG8_SB(0, 0), b2, voffB); PG8_STAGE(PG8_SB(0, 1), b2 + hstepB, voffB); PG8_STAGE(PG8_SA(0, 0), a2, voffA);
            PG8_WAIT_V(8); PG8_WAIT_L(0); PG8_BAR; PG8_MMA(1, 0, At, B0); PG8_MMA(1, 1, At, B1); PG8_BAR; PG8_SCHED;
            PG8_LDB(B0, 1, 0); PG8_LDB(B1, 1, 1); PG8_SCHED; PG8_LDA(At, 1, 0); PG8_STAGE(PG8_SA(0, 1), a2 + hstepA, voffA);
            PG8_WAIT_V(8); PG8_WAIT_L(0); PG8_BAR; PG8_MMA(0, 0, At, B0); PG8_MMA(0, 1, At, B1); PG8_BAR; PG8_SCHED;
            PG8_LDA(At, 1, 1); PG8_STAGE(PG8_SB(1, 0), b3, voffB); PG8_STAGE(PG8_SB(1, 1), b3 + hstepB, voffB); PG8_STAGE(PG8_SA(1, 0), a3, voffA);
            PG8_WAIT_V(8); PG8_WAIT_L(0); PG8_BAR; PG8_MMA(1, 0, At, B0); PG8_MMA(1, 1, At, B1); PG8_BAR; PG8_SCHED;
        }
        if (wr == 0) PG8_BAR;
        E(acc, cur, wr, wc, fr, fq, ui & 1);
        if (has_next) E.prep(nxt, (ui + 1) & 1, tid);
        if (!has_next) break;
        if (!Epi::keep(cur)) {
#pragma unroll
        for (int a = 0; a < 2; ++a)
#pragma unroll
            for (int b = 0; b < 2; ++b)
#pragma unroll
                for (int m = 0; m < 4; ++m)
#pragma unroll
                    for (int n = 0; n < 2; ++n) acc[a][b][m][n] = (f32x4){0.f, 0.f, 0.f, 0.f};
        }
        cur = nxt; cA = nA; cB = nB; ++ui;
        if (wr == 1) PG8_BAR;
    }
    PG8_WAIT_V(0);
    PG8_BAR;
#undef PG8_SA
#undef PG8_SB
#undef PG8_STAGE
#undef PG8_LDA
#undef PG8_LDB
#undef PG8_MMA
#undef PG8_WAIT_V
#undef PG8_WAIT_L
#undef PG8_BAR
#undef PG8_SCHED
}
}
constexpr int NB = 16, SEQ = 2048, DM = 2048, T = NB * SEQ, NL = 4, MEML = 256, MT = NB * MEML;
constexpr int INW = 7680, GW = 6144, NCAT = INW + GW, XD = 512, DFF = 5632, YW = 3072;
constexpr int C_QA = 0, C_KA = 1024, C_VA = 1280, C_UB = 1536, C_VB = 2560, C_FC = 3584, C_IC = 4608, C_QC = 5632, C_GC = 6656;
constexpr float EPS = 1e-6f;
constexpr float LOG2E = 1.4426950408889634f;
constexpr int NWAVES = 8, NTHR = NWAVES * 64;

constexpr size_t MiB = 1u << 20;
constexpr size_t WS_CTL = 0, CTL_ZERO_BYTES = 1 * MiB;
constexpr size_t WS_WCAT = 1 * MiB;
constexpr size_t WS_WBR = WS_WCAT + 54 * MiB;
constexpr size_t WS_WOUT = WS_WBR + 12 * MiB;
constexpr size_t WS_WXQ = WS_WOUT + 8 * MiB;
constexpr size_t WS_WXO = WS_WXQ + 2 * MiB;
constexpr size_t WS_WF1 = WS_WXO + 2 * MiB;
constexpr size_t WS_WF2 = WS_WF1 + 44 * MiB;
constexpr size_t WS_WXKV = WS_WF2 + 22 * MiB;
constexpr size_t WS_MEMN = WS_WXKV + 16 * MiB;
constexpr size_t WS_KV = WS_MEMN + 16 * MiB;
constexpr size_t WS_H = WS_KV + 32 * MiB;
constexpr size_t WS_PROJ = WS_H + 128 * MiB;
constexpr size_t PJ_QKV = 0, PJ_UB = 96 * MiB, PJ_VB = 160 * MiB, PJ_HB = 224 * MiB  , PJ_STAT = 480 * MiB;
constexpr int QKVW = 1536;
constexpr size_t WS_GATE = WS_PROJ + 484 * MiB;
constexpr size_t WS_Y = WS_GATE + 384 * MiB;
constexpr size_t WS_SS = WS_Y + 192 * MiB;
constexpr size_t WS_END = WS_SS + 1 * MiB;
constexpr int CW_TMO = 0, CW_BAR = 4096, CW_Q = 8192;

constexpr int RING_BYTES = 143360;
constexpr int LDSCTL_OFF = RING_BYTES, LDS_RED = LDSCTL_OFF + 1024, LDS_RSTD = LDS_RED + 4096, LDS_BYTES = 155648;

#define RLX_AGENT __ATOMIC_RELAXED, __HIP_MEMORY_SCOPE_AGENT
#define LDS_WAIT() asm volatile("s_waitcnt lgkmcnt(0)" ::: "memory")
#define VM_WAIT() asm volatile("s_waitcnt vmcnt(0)" ::: "memory")

#define XB_TMO      128
#define XB_XCNT(j)  (256  + 64 * (j))
#define XB_XSUB(j)  (1280 + 64 * (j))
#define XB_XGEN(j)  (2304 + 64 * (j))
#define XB_TOP      3328
#define XB_TOPGEN   3392
#define XCD_BAR_WORDS 3456
#define XB_SPIN_CAP (1u << 18)
__device__ __forceinline__ unsigned xb_ld(unsigned* p)              { return __hip_atomic_load(p, __ATOMIC_RELAXED, __HIP_MEMORY_SCOPE_AGENT); }
__device__ __forceinline__ unsigned xb_add(unsigned* p, unsigned v) { return __hip_atomic_fetch_add(p, v, __ATOMIC_RELAXED, __HIP_MEMORY_SCOPE_AGENT); }
__device__ __forceinline__ unsigned xb_xcc_id() { return (unsigned)__builtin_amdgcn_s_getreg((3 << 11) | 20) & 0xFu; }
#define XB_SPIN(cond, bar) do { unsigned _sp = 0; while (cond) { __builtin_amdgcn_s_sleep(1); \
    if ((++_sp & 255u) == 0u) { if (xb_ld(&(bar)[XB_TMO])) break; if (_sp > XB_SPIN_CAP) { atomicAdd(&(bar)[XB_TMO], 1u); break; } } } } while (0)
struct XcdBarrier { unsigned* bar; unsigned x; volatile LAS unsigned* st; };
__device__ __forceinline__ XcdBarrier xcd_barrier_post(unsigned* bar, volatile LAS unsigned* st) {
    XcdBarrier b; b.bar = bar; b.x = xb_xcc_id(); b.st = st;
    if (threadIdx.x == 0) (void)xb_add(&bar[XB_XCNT(b.x)], 1u);
    return b;
}
__device__ __forceinline__ void xcd_barrier_complete(unsigned* bar, unsigned x, unsigned& nloc, unsigned& nx) {
    const unsigned G = gridDim.x * gridDim.y * gridDim.z;
    unsigned sum, cnt, mine, sp = 0u;
    for (;;) {
        sum = 0u; cnt = 0u; mine = 0u;
#pragma unroll
        for (unsigned j = 0; j < 16; ++j) { const unsigned c = xb_ld(&bar[XB_XCNT(j)]); sum += c; cnt += (c > 0u) ? 1u : 0u; mine = (j == x) ? c : mine; }
        if (sum == G) break;
        __builtin_amdgcn_s_sleep(1);
        if ((++sp & 255u) == 0u) { if (xb_ld(&bar[XB_TMO])) break; if (sp > XB_SPIN_CAP) { atomicAdd(&bar[XB_TMO], 1u); break; } }
    }
    nloc = mine > 0u ? mine : 1u; nx = cnt > 0u ? cnt : 1u;
}
__device__ __forceinline__ void xcd_barrier(const XcdBarrier& b) {
    asm volatile("s_waitcnt vmcnt(0)" ::: "memory");
    __syncthreads();
    if (threadIdx.x == 0) {
        unsigned* bar = b.bar;
        __builtin_amdgcn_s_waitcnt(0);
        unsigned nloc = b.st[0], nx = b.st[1];
        if (nloc == 0u) { xcd_barrier_complete(bar, b.x, nloc, nx); b.st[0] = nloc; b.st[1] = nx; }
        const unsigned old = xb_add(&bar[XB_XSUB(b.x)], 1u);
        const unsigned gen = old / nloc;
        if (old + 1u == (gen + 1u) * nloc) {
            __builtin_amdgcn_fence(__ATOMIC_RELEASE, "agent");
            asm volatile("s_waitcnt vmcnt(0)" ::: "memory");
            const unsigned og = xb_add(&bar[XB_TOP], 1u);
            const unsigned tg = og / nx;
            if (og + 1u == (tg + 1u) * nx) xb_add(&bar[XB_TOPGEN], 1u);
            else XB_SPIN(xb_ld(&bar[XB_TOPGEN]) == tg, bar);
            __builtin_amdgcn_fence(__ATOMIC_ACQUIRE, "agent");
            xb_add(&bar[XB_XGEN(b.x)], 1u);
            asm volatile("s_waitcnt vmcnt(0)" ::: "memory");
        } else {
            XB_SPIN(xb_ld(&bar[XB_XGEN(b.x)]) == gen, bar);
            __builtin_amdgcn_fence(__ATOMIC_ACQUIRE, "agent");
            asm volatile("s_waitcnt vmcnt(0)" ::: "memory");
        }
    }
    __syncthreads();
}

struct RowScale {
    const GAS float* ss; LAS float* tab;
    __device__ __forceinline__ void prep(const pg8::Unit& u, int buf, int tid) const {
        if (tid < 256) { const GAS f32x4* p = (const GAS f32x4*)(ss + ((size_t)u.pm * 256 + tid) * 8); const f32x4 a = p[0], b = p[1];
            tab[buf * 256 + tid] = __builtin_amdgcn_rsqf(((a.x + a.y) + (a.z + a.w) + (b.x + b.y) + (b.z + b.w)) * (1.f / DM) + EPS); }
    }
    __device__ __forceinline__ float get(int buf, int row) const { return tab[buf * 256 + row]; }
};
struct EpiCat {
    static constexpr bool PERM = true, F16 = (RES_F16 != 0); static __device__ __forceinline__ bool keep(const pg8::Unit&) { return false; }
    GAS unsigned char* pj; GAS bf16* gate; RowScale rs;
    __device__ __forceinline__ void prep(const pg8::Unit& u, int buf, int tid) const { rs.prep(u, buf, tid); }
    __device__ __forceinline__ void operator()(f32x4 (&acc)[2][2][4][2], const pg8::Unit& u, int wr, int wc, int fr, int fq, int buf) const {
        const int pn = u.pn; GAS char* base; int ldc, colt; size_t bjs = 256, rowbase = (size_t)u.pm * 256; int kind;
        float c1 = 1.f, c3 = 0.f, sc = 1.f, flo = -INFINITY; bool usex = true;
        if (pn < 6) { base = (GAS char*)pj + PJ_QKV; ldc = QKVW; colt = pn * 256; kind = 0; }
        else if (pn < 14) { base = (GAS char*)pj + (pn < 10 ? PJ_UB : PJ_VB); ldc = 1024; colt = ((pn - 6) & 3) * 256; kind = 0; }
        else if (pn < 30) { const int seg = (pn - 14) >> 2, hp = (pn - 14) & 3, b = u.pm >> 3, t0 = (u.pm & 7) * 256;
            base = (GAS char*)pj + PJ_HB + (size_t)seg * (64 * MiB) + ((size_t)((b * 8 + 2 * hp) * SEQ + t0) * 128) * 2; ldc = 128; colt = 0; bjs = (size_t)SEQ * 128 * 2; rowbase = 0;
            kind = 0; }
        else { base = (GAS char*)gate; ldc = GW; colt = (pn - 30) * 256; kind = 1; usex = false; flo = 1e-20f; }
        const unsigned toff = (unsigned)((wr * 64 + fr) * ldc + wc * 32 + 8 * fq) * 2u;
#pragma unroll
        for (int ai = 0; ai < 2; ++ai)
#pragma unroll
            for (int m = 0; m < 4; ++m) { GAS char* ub = base + ((rowbase + ai * 128 + m * 16) * ldc + colt) * 2;
                const float rsd = rs.get(buf, ai * 128 + wr * 64 + m * 16 + fr);
                float s1 = 0.f, s2 = 0.f;
#pragma unroll
                for (int bj = 0; bj < 2; ++bj) { f32x4 v0 = acc[ai][bj][m][0] * rsd, v1 = acc[ai][bj][m][1] * rsd;
                    if (kind) {
#pragma unroll
                        for (int e = 0; e < 4; ++e) {
                            { const float x = v0[e]; const float sg = __builtin_amdgcn_rcpf(1.0f + __builtin_amdgcn_exp2f(-LOG2E * x * (c1 + c3 * x * x))); v0[e] = fmaxf((usex ? x : 1.f) * sg * sc, flo); }
                            { const float x = v1[e]; const float sg = __builtin_amdgcn_rcpf(1.0f + __builtin_amdgcn_exp2f(-LOG2E * x * (c1 + c3 * x * x))); v1[e] = fmaxf((usex ? x : 1.f) * sg * sc, flo); }
                            if (kind == 2) { s1 += v0[e] + v1[e]; s2 += v0[e] * v0[e] + v1[e] * v1[e]; } } }
                    u32x4 w; w.x = cvt_pk_bf16(v0[0], v0[1]); w.y = cvt_pk_bf16(v0[2], v0[3]); w.z = cvt_pk_bf16(v1[0], v1[1]); w.w = cvt_pk_bf16(v1[2], v1[3]);
                    *(GAS u32x4*)(ub + bj * bjs + toff) = w; }
                if (kind == 2) { s1 += __shfl_xor(s1, 16); s1 += __shfl_xor(s1, 32); s2 += __shfl_xor(s2, 16); s2 += __shfl_xor(s2, 32);
                    if (fq == 0) *(GAS f32x2*)((GAS float*)(pj + PJ_STAT) + ((size_t)u.pm * 256 + ai * 128 + wr * 64 + m * 16 + fr) * 32 + (pn - 10) * 8 + wc * 2) = (f32x2){s1, s2}; } }
    }
};
template <bool SCALE> struct EpiPlain {
    static constexpr bool PERM = true, F16 = SCALE && (RES_F16 != 0);     static __device__ __forceinline__ bool keep(const pg8::Unit&) { return false; }
    GAS bf16* O; int ldc; RowScale rs;
    __device__ __forceinline__ void prep(const pg8::Unit& u, int buf, int tid) const { if (SCALE) rs.prep(u, buf, tid); }
    __device__ __forceinline__ void operator()(f32x4 (&acc)[2][2][4][2], const pg8::Unit& u, int wr, int wc, int fr, int fq, int buf) const {
        const unsigned toff = (unsigned)((wr * 64 + fr) * ldc + wc * 32 + 8 * fq) * 2u;
#pragma unroll
        for (int ai = 0; ai < 2; ++ai)
#pragma unroll
            for (int m = 0; m < 4; ++m) { GAS char* ub = (GAS char*)O + ((size_t)(u.pm * 256 + ai * 128 + m * 16) * ldc + u.pn * 256) * 2;
                const float rsd = SCALE ? rs.get(buf, ai * 128 + wr * 64 + m * 16 + fr) : 1.f;
#pragma unroll
                for (int bj = 0; bj < 2; ++bj) { const f32x4 v0 = acc[ai][bj][m][0] * rsd, v1 = acc[ai][bj][m][1] * rsd;
                    u32x4 w; w.x = cvt_pk_bf16(v0[0], v0[1]); w.y = cvt_pk_bf16(v0[2], v0[3]); w.z = cvt_pk_bf16(v1[0], v1[1]); w.w = cvt_pk_bf16(v1[2], v1[3]);
                    *(GAS u32x4*)(ub + bj * 256 + toff) = w; } }
    }
};
struct EpiResid {
    static constexpr bool PERM = true, F16 = false; static __device__ __forceinline__ bool keep(const pg8::Unit&) { return false; }
    const GAS unsigned short* src; GAS unsigned short* dst; GAS float* ss; LAS float* red; GAS unsigned short* xm;
    __device__ __forceinline__ void prep(const pg8::Unit&, int, int) const {}
    __device__ __forceinline__ void operator()(f32x4 (&acc)[2][2][4][2], const pg8::Unit& u, int wr, int wc, int fr, int fq, int) const {
        const unsigned toff_ = (unsigned)((wr * 64 + fr) * DM + wc * 32 + 8 * fq) * 2u;
#pragma unroll
        for (int ai = 0; ai < 2; ++ai) {
            unsigned toff = toff_; asm volatile("" : "+v"(toff));
            u32x4 sv[4][2];
#pragma unroll
            for (int m = 0; m < 4; ++m) { const GAS char* us = (const GAS char*)(xm ? (const GAS unsigned short*)xm : src) + ((size_t)(u.pm * 256 + ai * 128 + m * 16) * DM + u.pn * 256) * 2;
#pragma unroll
                for (int bj = 0; bj < 2; ++bj) sv[m][bj] = *(const GAS u32x4*)(us + bj * 256 + toff); }
#pragma unroll
            for (int m = 0; m < 4; ++m) { const size_t uo = ((size_t)(u.pm * 256 + ai * 128 + m * 16) * DM + u.pn * 256) * 2; GAS char* ud = (GAS char*)dst + uo; GAS char* um = (GAS char*)xm + uo;
                float q = 0.f;
#pragma unroll
                for (int bj = 0; bj < 2; ++bj) { const u32x4 x = sv[m][bj]; const f32x4 a0 = acc[ai][bj][m][0], a1 = acc[ai][bj][m][1];
                    float v0, v1, v2, v3, v4, v5, v6, v7;
                    if (xm) { v0 = h_lo(x.x) + a0[0]; v1 = h_hi(x.x) + a0[1]; v2 = h_lo(x.y) + a0[2]; v3 = h_hi(x.y) + a0[3]; v4 = h_lo(x.z) + a1[0]; v5 = h_hi(x.z) + a1[1]; v6 = h_lo(x.w) + a1[2]; v7 = h_hi(x.w) + a1[3];
                        u32x4 wm; wm.x = cvt_pk_f16(v0, v1); wm.y = cvt_pk_f16(v2, v3); wm.z = cvt_pk_f16(v4, v5); wm.w = cvt_pk_f16(v6, v7); *(GAS u32x4*)(um + bj * 256 + toff) = wm; }
                    else { v0 = res_lo(x.x) + a0[0]; v1 = res_hi(x.x) + a0[1]; v2 = res_lo(x.y) + a0[2]; v3 = res_hi(x.y) + a0[3]; v4 = res_lo(x.z) + a1[0]; v5 = res_hi(x.z) + a1[1]; v6 = res_lo(x.w) + a1[2]; v7 = res_hi(x.w) + a1[3]; }
                    u32x4 w; w.x = cvt_pk_res(v0, v1); w.y = cvt_pk_res(v2, v3); w.z = cvt_pk_res(v4, v5); w.w = cvt_pk_res(v6, v7);
                    *(GAS u32x4*)(ud + bj * 256 + toff) = w;
                    q += ((v0 * v0 + v1 * v1) + (v2 * v2 + v3 * v3)) + ((v4 * v4 + v5 * v5) + (v6 * v6 + v7 * v7)); }
                if (ss) { q += __shfl_xor(q, 16); q += __shfl_xor(q, 32); if (fq == 0) red[wc * 256 + ai * 128 + wr * 64 + m * 16 + fr] = q; } }
            asm volatile("" ::: "memory"); }
        if (ss) { asm volatile("s_waitcnt lgkmcnt(0)" ::: "memory"); __builtin_amdgcn_s_barrier();
            const int t = threadIdx.x; if (t < 256) ss[((size_t)u.pm * 256 + t) * 8 + u.pn] = (red[t] + red[256 + t]) + (red[512 + t] + red[768 + t]); }
    }
};
struct EpiSwiglu {
    static constexpr bool PERM = true, F16 = (RES_F16 != 0); static __device__ __forceinline__ bool keep(const pg8::Unit&) { return false; }
    GAS bf16* O; RowScale rs;
    __device__ __forceinline__ void prep(const pg8::Unit& u, int buf, int tid) const { rs.prep(u, buf, tid); }
    __device__ __forceinline__ void operator()(f32x4 (&acc)[2][2][4][2], const pg8::Unit& u, int wr, int wc, int fr, int fq, int buf) const {
        const unsigned toff = (unsigned)((wr * 64 + fr) * DFF + wc * 32 + 8 * fq) * 2u;
#pragma unroll
        for (int ai = 0; ai < 2; ++ai)
#pragma unroll
            for (int m = 0; m < 4; ++m) { GAS char* ub = (GAS char*)O + ((size_t)(u.pm * 256 + ai * 128 + m * 16) * DFF + u.pn * 128) * 2;
                f32x4 v0, v1; const float rsd = rs.get(buf, ai * 128 + wr * 64 + m * 16 + fr);
#pragma unroll
                for (int e = 0; e < 4; ++e) { v0[e] = siluf_(acc[ai][0][m][0][e] * rsd) * (acc[ai][1][m][0][e] * rsd); v1[e] = siluf_(acc[ai][0][m][1][e] * rsd) * (acc[ai][1][m][1][e] * rsd); }
                u32x4 w; w.x = cvt_pk_bf16(v0[0], v0[1]); w.y = cvt_pk_bf16(v0[2], v0[3]); w.z = cvt_pk_bf16(v1[0], v1[1]); w.w = cvt_pk_bf16(v1[2], v1[3]);
                *(GAS u32x4*)(ub + toff) = w; }
    }
};
struct EpiBranch {
    static constexpr bool PERM = true, F16 = false; static __device__ __forceinline__ bool keep(const pg8::Unit& u) { return u.aux < 2; }
    const GAS bf16* gate; GAS bf16* merged;
    __device__ __forceinline__ void prep(const pg8::Unit&, int, int) const {}
    __device__ __forceinline__ void operator()(f32x4 (&acc)[2][2][4][2], const pg8::Unit& u, int wr, int wc, int fr, int fq, int) const {
        const int j = u.aux;
        const unsigned toffg_ = (unsigned)((wr * 64 + fr) * GW + wc * 32 + 8 * fq) * 2u, toffm_ = (unsigned)((wr * 64 + fr) * DM + wc * 32 + 8 * fq) * 2u;
#pragma unroll
        for (int ai = 0; ai < 2; ++ai) {
            unsigned toffg = toffg_, toffm = toffm_; asm volatile("" : "+v"(toffg), "+v"(toffm));
            u32x4 gw[4][2], gn[4][2];
#pragma unroll
            for (int m = 0; m < 4; ++m) { const GAS char* ug = (const GAS char*)gate + ((size_t)(u.pm * 256 + ai * 128 + m * 16) * GW + j * DM + u.pn * 256) * 2;
#pragma unroll
                for (int bj = 0; bj < 2; ++bj) { gw[m][bj] = *(const GAS u32x4*)(ug + bj * 256 + toffg); if (j < 2) gn[m][bj] = *(const GAS u32x4*)(ug + DM * 2 + bj * 256 + toffg); } }
#pragma unroll
            for (int m = 0; m < 4; ++m) { GAS char* um = (GAS char*)merged + ((size_t)(u.pm * 256 + ai * 128 + m * 16) * DM + u.pn * 256) * 2;
#pragma unroll
                for (int bj = 0; bj < 2; ++bj) { const u32x4 g0 = gw[m][bj];
                    float s[8] = {bf_lo(g0.x), bf_hi(g0.x), bf_lo(g0.y), bf_hi(g0.y), bf_lo(g0.z), bf_hi(g0.z), bf_lo(g0.w), bf_hi(g0.w)};
                    if (j < 2) { const u32x4 g1 = gn[m][bj];
                        const float d[8] = {bf_lo(g1.x), bf_hi(g1.x), bf_lo(g1.y), bf_hi(g1.y), bf_lo(g1.z), bf_hi(g1.z), bf_lo(g1.w), bf_hi(g1.w)};
#pragma unroll
                        for (int e = 0; e < 8; ++e) s[e] = s[e] * __builtin_amdgcn_rcpf(d[e]); }
                    f32x4 v0 = acc[ai][bj][m][0], v1 = acc[ai][bj][m][1];
                    v0[0] *= s[0]; v0[1] *= s[1]; v0[2] *= s[2]; v0[3] *= s[3]; v1[0] *= s[4]; v1[1] *= s[5]; v1[2] *= s[6]; v1[3] *= s[7];
                    if (j < 2) { acc[ai][bj][m][0] = v0; acc[ai][bj][m][1] = v1; }
                    else { u32x4 w; w.x = cvt_pk_bf16(v0[0], v0[1]); w.y = cvt_pk_bf16(v0[2], v0[3]); w.z = cvt_pk_bf16(v1[0], v1[1]); w.w = cvt_pk_bf16(v1[2], v1[3]);
                        *(GAS u32x4*)(um + bj * 256 + toffm) = w; } } }
            asm volatile("" ::: "memory"); }
    }
};

__device__ __forceinline__ void tr_item(const GAS float* W, int N, GAS bf16* WT, int ldd, int k0, int n0, int drow0, LAS float* scr, int lane, const GAS float* gain = nullptr) {
    const float gv = gain ? gain[k0 + lane] : 1.f;
#pragma unroll 8
    for (int i = 0; i < 32; ++i) { const int kk = 2 * i + (lane >> 5); scr[kk * 33 + (lane & 31)] = W[(size_t)(k0 + kk) * N + n0 + (lane & 31)] * __shfl(gv, kk); }
    LDS_WAIT(); asm volatile("" ::: "memory");
    const int c = lane & 7;
#pragma unroll
    for (int j = 0; j < 4; ++j) { const int n = (lane >> 3) + 8 * j; const LAS float* s = scr + (8 * c) * 33 + n;
        u32x4 o;
        if (gain && RES_F16) { o.x = cvt_pk_f16(s[0 * 33], s[1 * 33]); o.y = cvt_pk_f16(s[2 * 33], s[3 * 33]); o.z = cvt_pk_f16(s[4 * 33], s[5 * 33]); o.w = cvt_pk_f16(s[6 * 33], s[7 * 33]); }
        else { o.x = cvt_pk_bf16(s[0 * 33], s[1 * 33]); o.y = cvt_pk_bf16(s[2 * 33], s[3 * 33]); o.z = cvt_pk_bf16(s[4 * 33], s[5 * 33]); o.w = cvt_pk_bf16(s[6 * 33], s[7 * 33]); }
        *(GAS u32x4*)(WT + (size_t)(drow0 + n) * ldd + k0 + 8 * c) = o; }
    LDS_WAIT(); asm volatile("" ::: "memory");
}
__device__ __forceinline__ void rms_row_bf16(const GAS float* xrow, const f32x4 (&gv)[8], GAS bf16* orow, int lane) {
    const GAS f32x4* xr = (const GAS f32x4*)xrow + lane;
    f32x4 v[8]; float s = 0.f;
#pragma unroll
    for (int j = 0; j < 8; ++j) { v[j] = xr[64 * j]; s += (v[j].x * v[j].x + v[j].y * v[j].y) + (v[j].z * v[j].z + v[j].w * v[j].w); }
    const float rstd = __builtin_amdgcn_rsqf(wave_sum(s) * (1.f / DM) + EPS);
    GAS u32x2* o8 = (GAS u32x2*)orow + lane;
#pragma unroll
    for (int j = 0; j < 8; ++j) { const f32x4 y = v[j] * rstd * gv[j]; u32x2 w; w.x = cvt_pk_bf16(y.x, y.y); w.y = cvt_pk_bf16(y.z, y.w); o8[64 * j] = w; }
}
__device__ __forceinline__ void norm_phase(const GAS float* src, const GAS float* gain, GAS bf16* dst, int nrows, int gw, int NGW, int lane) {
    f32x4 gv[8];
#pragma unroll
    for (int j = 0; j < 8; ++j) gv[j] = ((const GAS f32x4*)gain)[lane + 64 * j];
    for (int m = gw; m < nrows; m += NGW) rms_row_bf16(src + (size_t)m * DM, gv, dst + (size_t)m * DM, lane);
}
__device__ __forceinline__ void xb_phase(const GAS float* src, GAS bf16* xb, GAS unsigned short* xm, GAS float* ss, int gw, int NGW, int lane) {
    for (int m = gw; m < T; m += NGW) {
        const GAS f32x4* xr = (const GAS f32x4*)(src + (size_t)m * DM) + lane; GAS u32x2* o8 = (GAS u32x2*)(xb + (size_t)m * DM) + lane; GAS u32x2* m8 = (GAS u32x2*)(xm + (size_t)m * DM) + lane;
        f32x4 v[8]; float q[8];
#pragma unroll
        for (int j = 0; j < 8; ++j) { v[j] = xr[64 * j]; q[j] = (v[j].x * v[j].x + v[j].y * v[j].y) + (v[j].z * v[j].z + v[j].w * v[j].w); }
#pragma unroll
        for (int j = 0; j < 8; ++j) { u32x2 w; w.x = cvt_pk_res(v[j].x, v[j].y); w.y = cvt_pk_res(v[j].z, v[j].w); o8[64 * j] = w;
            if (xm) { u32x2 wm; wm.x = cvt_pk_f16(v[j].x, v[j].y); wm.y = cvt_pk_f16(v[j].z, v[j].w); m8[64 * j] = wm; } }
#pragma unroll
        for (int o = 1; o < 64; o <<= 1)
#pragma unroll
            for (int j = 0; j < 8; ++j) q[j] += __shfl_xor(q[j], o);
        if (lane == 0) { GAS f32x4* sp = (GAS f32x4*)(ss + (size_t)m * 8); sp[0] = (f32x4){q[0], q[1], q[2], q[3]}; sp[1] = (f32x4){q[4], q[5], q[6], q[7]}; }
    }
}
__device__ __forceinline__ void final_norm_phase(const GAS unsigned short* xh, GAS float* out, const GAS float* gain, const GAS float* ss, int gw, int NGW, int lane) {
    f32x4 gv[8];
#pragma unroll
    for (int j = 0; j < 8; ++j) gv[j] = ((const GAS f32x4*)gain)[lane + 64 * j];
    for (int m = gw; m < T; m += NGW) {
        const GAS u32x2* xr = (const GAS u32x2*)(xh + (size_t)m * DM) + lane; GAS f32x4* orow = (GAS f32x4*)(out + (size_t)m * DM) + lane;
        const GAS f32x4* sp = (const GAS f32x4*)(ss + (size_t)m * 8); const f32x4 a = sp[0], b = sp[1];
        const float rstd = __builtin_amdgcn_rsqf(((a.x + a.y) + (a.z + a.w) + (b.x + b.y) + (b.z + b.w)) * (1.f / DM) + EPS);
        u32x2 v[8];
#pragma unroll
        for (int j = 0; j < 8; ++j) v[j] = xr[64 * j];
#pragma unroll
        for (int j = 0; j < 8; ++j) orow[64 * j] = (f32x4){res_lo(v[j].x), res_hi(v[j].x), res_lo(v[j].y), res_hi(v[j].y)} * rstd * gv[j];
    }
}
typedef short s16x4 __attribute__((ext_vector_type(4)));
__device__ __forceinline__ s16x4 tr_read(const LAS unsigned char* p) { return __builtin_bit_cast(s16x4, __builtin_amdgcn_ds_read_tr16_b64_v4i16((LAS s16x4*)p)); }
template <int HD, bool SWA>
__device__ __forceinline__ void attn_wave32(const LAS unsigned char* Ks, int kstr, const LAS unsigned char* Vt, int vstr, const bf16x8 (&qf)[2][HD / 32], f32x4 (&o)[2][HD / 16],
                                            float m0, float l0, float c2, int kt_lo, int kt_hi, int t0, bool first_blk, int lane) {
    const int fr = lane & 15, g = lane >> 4;
    float mrow[2] = {m0, m0}, lrow[2] = {l0, l0};
#pragma unroll
    for (int mt = 0; mt < 2; ++mt)
#pragma unroll
        for (int dt = 0; dt < HD / 16; ++dt) o[mt][dt] = (f32x4){0.f, 0.f, 0.f, 0.f};
    for (int kt = kt_lo; kt <= kt_hi; ++kt) {
        f32x4 s[2][4];
#pragma unroll
        for (int mt = 0; mt < 2; ++mt)
#pragma unroll
            for (int nt = 0; nt < 4; ++nt) s[mt][nt] = (f32x4){0.f, 0.f, 0.f, 0.f};
#pragma unroll
        for (int nt = 0; nt < 4; ++nt)
#pragma unroll
            for (int kk = 0; kk < HD / 32; ++kk) {
                const bf16x8 kf = *(const LAS bf16x8*)(Ks + (kt * 64 + nt * 16 + fr) * kstr + (kk * 32 + g * 8) * 2);
#pragma unroll
                for (int mt = 0; mt < 2; ++mt) s[mt][nt] = __builtin_amdgcn_mfma_f32_16x16x32_bf16(kf, qf[mt][kk], s[mt][nt], 0, 0, 0);
            }
#pragma unroll
        for (int mt = 0; mt < 2; ++mt) {
            float rm = -INFINITY;
#pragma unroll
            for (int nt = 0; nt < 4; ++nt)
#pragma unroll
                for (int e = 0; e < 4; ++e) {
                    float v = s[mt][nt][e] * c2;
                    if (SWA) { const int sidx = kt * 64 + nt * 16 + g * 4 + e, t = t0 + mt * 16 + fr;
                        const bool valid = (sidx > t) && (sidx <= t + 128) && (!first_blk || sidx >= 128); v = valid ? v : -INFINITY; }
                    s[mt][nt][e] = v; rm = fmaxf(rm, v);
                }
            rm = fmaxf(rm, __shfl_xor(rm, 16)); rm = fmaxf(rm, __shfl_xor(rm, 32));
            const float mn = fmaxf(mrow[mt], rm);
            const float alpha = __builtin_amdgcn_exp2f(mrow[mt] - mn);
            float rs = 0.f;
#pragma unroll
            for (int nt = 0; nt < 4; ++nt)
#pragma unroll
                for (int e = 0; e < 4; ++e) { const float p = __builtin_amdgcn_exp2f(s[mt][nt][e] - mn); s[mt][nt][e] = p; rs += p; }
            rs += __shfl_xor(rs, 16); rs += __shfl_xor(rs, 32);
            lrow[mt] = lrow[mt] * alpha + rs; mrow[mt] = mn;
#pragma unroll
            for (int dt = 0; dt < HD / 16; ++dt) o[mt][dt] *= alpha;
        }
        bf16x8 pf[2][2];
#pragma unroll
        for (int mt = 0; mt < 2; ++mt)
#pragma unroll
            for (int k2 = 0; k2 < 2; ++k2) {
                u32x4 w; w.x = cvt_pk_bf16(s[mt][2 * k2][0], s[mt][2 * k2][1]); w.y = cvt_pk_bf16(s[mt][2 * k2][2], s[mt][2 * k2][3]);
                w.z = cvt_pk_bf16(s[mt][2 * k2 + 1][0], s[mt][2 * k2 + 1][1]); w.w = cvt_pk_bf16(s[mt][2 * k2 + 1][2], s[mt][2 * k2 + 1][3]);
                pf[mt][k2] = __builtin_bit_cast(bf16x8, w);
            }
#pragma unroll
        for (int dt = 0; dt < HD / 16; ++dt)
#pragma unroll
            for (int k2 = 0; k2 < 2; ++k2) {
                const LAS unsigned char* vblk = Vt + (kt * 64 + k2 * 32 + g * 4 + (fr >> 2)) * vstr + (dt * 16 + (fr & 3) * 4) * 2;
                const s16x4 lo = tr_read(vblk), hi = tr_read(vblk + 16 * vstr);
                const bf16x8 vf = __builtin_shufflevector(lo, hi, 0, 1, 2, 3, 4, 5, 6, 7);
#pragma unroll
                for (int mt = 0; mt < 2; ++mt) o[mt][dt] = __builtin_amdgcn_mfma_f32_16x16x32_bf16(vf, pf[mt][k2], o[mt][dt], 0, 0, 0);
            }
    }
#pragma unroll
    for (int mt = 0; mt < 2; ++mt) { const float inv = 1.0f / lrow[mt];
#pragma unroll
        for (int dt = 0; dt < HD / 16; ++dt) o[mt][dt] *= inv; }
}

__device__ __forceinline__ void vt_scatter(LAS unsigned char* Vt, int vstr, int d0, int key, u32x4 v) {
    LAS unsigned char* p = Vt + d0 * vstr + key * 2;
    *(LAS bf16*)(p + 0 * vstr) = (bf16)(v.x & 0xffffu); *(LAS bf16*)(p + 1 * vstr) = (bf16)(v.x >> 16);
    *(LAS bf16*)(p + 2 * vstr) = (bf16)(v.y & 0xffffu); *(LAS bf16*)(p + 3 * vstr) = (bf16)(v.y >> 16);
    *(LAS bf16*)(p + 4 * vstr) = (bf16)(v.z & 0xffffu); *(LAS bf16*)(p + 5 * vstr) = (bf16)(v.z >> 16);
    *(LAS bf16*)(p + 6 * vstr) = (bf16)(v.w & 0xffffu); *(LAS bf16*)(p + 7 * vstr) = (bf16)(v.w >> 16);
}

__device__ __forceinline__ void swa_unit(int unit, const GAS bf16* proj, const GAS float* sinks_l, GAS bf16* Y, LAS unsigned char* lds, int tid) {
    const int b = unit >> 6, kvh = (unit >> 4) & 3, blk = unit & 15;
    const int lane = tid & 63, w = __builtin_amdgcn_readfirstlane(tid >> 6), fr = lane & 15, g = lane >> 4;
    constexpr int KSTR = 144, VSTR = 160;
    LAS unsigned char* Ks = lds; LAS unsigned char* Vt = lds + 256 * KSTR;
    __syncthreads();
#pragma unroll
    for (int i = 0; i < 4; ++i) { const int c = tid + NTHR * i, key = c >> 3, part = c & 7;
        const int tok = (blk == 0) ? (key & 127) : (blk - 1) * 128 + key;
        const GAS bf16* src = proj + (size_t)(b * SEQ + tok) * QKVW + kvh * 64 + part * 8;
        const u32x4 kv = *(const GAS u32x4*)(src + C_KA); const u32x4 vv = *(const GAS u32x4*)(src + C_VA);
        *(LAS u32x4*)(Ks + key * KSTR + part * 16) = kv; *(LAS u32x4*)(Vt + key * VSTR + part * 16) = vv; }
    __syncthreads();
    const int head = kvh * 4 + (w >> 1), half = w & 1;
    const float sink2 = sinks_l[head] * LOG2E;
    for (int pass = 0; pass < 2; ++pass) {
        const int t0 = half * 64 + pass * 32;
        bf16x8 qf[2][2];
#pragma unroll
        for (int mt = 0; mt < 2; ++mt)
#pragma unroll
            for (int kk = 0; kk < 2; ++kk) qf[mt][kk] = *(const GAS bf16x8*)(proj + (size_t)(b * SEQ + blk * 128 + t0 + mt * 16 + fr) * QKVW + C_QA + head * 64 + kk * 32 + g * 8);
        int kt_lo = (t0 + 1) >> 6; const int kt_hi = (t0 + 159) >> 6; if (blk == 0 && kt_lo < 2) kt_lo = 2;
        f32x4 o[2][4];
        attn_wave32<64, true>(Ks, KSTR, Vt, VSTR, qf, o, sink2, 1.0f, 0.125f * LOG2E, kt_lo, kt_hi, t0, blk == 0, lane);
#pragma unroll
        for (int mt = 0; mt < 2; ++mt)
#pragma unroll
            for (int dt = 0; dt < 4; ++dt) { u32x2 wv; wv.x = cvt_pk_bf16(o[mt][dt][0], o[mt][dt][1]); wv.y = cvt_pk_bf16(o[mt][dt][2], o[mt][dt][3]);
                *(GAS u32x2*)(Y + (size_t)(b * SEQ + blk * 128 + t0 + mt * 16 + fr) * YW + head * 64 + dt * 16 + g * 4) = wv; }
    }
}

__device__ __forceinline__ void xattn_unit(int unit, int l, const GAS bf16* KV, const GAS bf16* XQ, GAS bf16* XO, LAS unsigned char* lds, int tid) {
    const int b = unit >> 5, head = (unit >> 3) & 3, qb = unit & 7;
    const int lane = tid & 63, w = __builtin_amdgcn_readfirstlane(tid >> 6), fr = lane & 15, g = lane >> 4;
    constexpr int KSTR = 272, VSTR = 288;
    LAS unsigned char* Ks = lds; LAS unsigned char* Vt = lds + 256 * KSTR;
    __syncthreads();
#pragma unroll
    for (int i = 0; i < 8; ++i) { const int c = tid + NTHR * i, key = c >> 4, part = c & 15;
        const GAS bf16* src = KV + (size_t)(b * MEML + key) * 4096 + l * 1024 + head * 128 + part * 8;
        const u32x4 kv = *(const GAS u32x4*)src; const u32x4 vv = *(const GAS u32x4*)(src + 512);
        *(LAS u32x4*)(Ks + key * KSTR + part * 16) = kv; *(LAS u32x4*)(Vt + key * VSTR + part * 16) = vv; }
    __syncthreads();
    const size_t row0 = (size_t)b * SEQ + qb * 256 + w * 32;
    bf16x8 qf[2][4];
#pragma unroll
    for (int mt = 0; mt < 2; ++mt)
#pragma unroll
        for (int kk = 0; kk < 4; ++kk) qf[mt][kk] = *(const GAS bf16x8*)(XQ + (row0 + mt * 16 + fr) * XD + head * 128 + kk * 32 + g * 8);
    f32x4 o[2][8];
    attn_wave32<128, false>(Ks, KSTR, Vt, VSTR, qf, o, -INFINITY, 0.0f, 0.08838834764831845f * LOG2E, 0, 3, 0, false, lane);
#pragma unroll
    for (int mt = 0; mt < 2; ++mt)
#pragma unroll
        for (int dt = 0; dt < 8; ++dt) { u32x2 wv; wv.x = cvt_pk_bf16(o[mt][dt][0], o[mt][dt][1]); wv.y = cvt_pk_bf16(o[mt][dt][2], o[mt][dt][3]);
            *(GAS u32x2*)(XO + (row0 + mt * 16 + fr) * XD + head * 128 + dt * 16 + g * 4) = wv; }
}

__device__ __forceinline__ void sgu_unit(int unit, const GAS bf16* ubuf, const GAS bf16* vbuf, const GAS float* ln_g, const GAS float* ln_b, const GAS float* sw, const GAS float* sb, GAS bf16* Y, LAS unsigned char* lds, int tid) {
    const int b = unit >> 4, c = unit & 15;
    const int lane = tid & 63, w = __builtin_amdgcn_readfirstlane(tid >> 6), fr = lane & 15, g = lane >> 4;
    constexpr int VSTR = 288, WSTR = 272;
    LAS unsigned char* VN = lds; LAS unsigned char* Ws = lds + 128 * VSTR; LAS float* stat = (LAS float*)(lds + 128 * VSTR + 128 * WSTR);
    const size_t tok0 = (size_t)b * SEQ + c * 128;
    u32x4 va[4]; f32x4 wv[8]; u32x2 uu[8];
#define SGU_LOAD(gg) do { _Pragma("unroll") for (int i = 0; i < 4; ++i) { const int cc = tid + NTHR * i, s = cc >> 4, part = cc & 15; va[i] = *(const GAS u32x4*)(vbuf + (tok0 + s) * 1024 + (gg) * 128 + part * 8); } \
        _Pragma("unroll") for (int i = 0; i < 8; ++i) { const int idx = tid + NTHR * i; wv[i] = *(const GAS f32x4*)(sw + (size_t)(gg) * 16384 + idx * 4); } \
        _Pragma("unroll") for (int et = 0; et < 8; ++et) uu[et] = *(const GAS u32x2*)(ubuf + (tok0 + w * 16 + fr) * 1024 + (gg) * 128 + et * 16 + g * 4); } while (0)
    SGU_LOAD(0);
    __syncthreads();
    for (int bt = 0; bt < 2; ++bt) {
        u32x4 a0[8], a1[8];
#pragma unroll
        for (int i = 0; i < 8; ++i) { const GAS bf16* src = vbuf + (tok0 + w * 16 + bt * 8 + i) * 1024 + lane * 16; a0[i] = *(const GAS u32x4*)src; a1[i] = *(const GAS u32x4*)(src + 8); }
        float s1[8], s2[8];
#pragma unroll
        for (int i = 0; i < 8; ++i) { float x[16];
            x[0] = geluf_(bf_lo(a0[i].x)); x[1] = geluf_(bf_hi(a0[i].x)); x[2] = geluf_(bf_lo(a0[i].y)); x[3] = geluf_(bf_hi(a0[i].y));
            x[4] = geluf_(bf_lo(a0[i].z)); x[5] = geluf_(bf_hi(a0[i].z)); x[6] = geluf_(bf_lo(a0[i].w)); x[7] = geluf_(bf_hi(a0[i].w));
            x[8] = geluf_(bf_lo(a1[i].x)); x[9] = geluf_(bf_hi(a1[i].x)); x[10] = geluf_(bf_lo(a1[i].y)); x[11] = geluf_(bf_hi(a1[i].y));
            x[12] = geluf_(bf_lo(a1[i].z)); x[13] = geluf_(bf_hi(a1[i].z)); x[14] = geluf_(bf_lo(a1[i].w)); x[15] = geluf_(bf_hi(a1[i].w));
            float p1 = 0.f, p2 = 0.f;
#pragma unroll
            for (int e = 0; e < 16; ++e) { p1 += x[e]; p2 += x[e] * x[e]; }
            s1[i] = p1; s2[i] = p2; }
#pragma unroll
        for (int o = 1; o < 64; o <<= 1)
#pragma unroll
            for (int i = 0; i < 8; ++i) { s1[i] += __shfl_xor(s1[i], o); s2[i] += __shfl_xor(s2[i], o); }
        if (lane < 8) { float m1 = s1[0], m2 = s2[0];
#pragma unroll
            for (int i = 1; i < 8; ++i) { m1 = (lane == i) ? s1[i] : m1; m2 = (lane == i) ? s2[i] : m2; }
            const float mean = m1 * (1.f / 1024.f); const float var = fmaxf(m2 * (1.f / 1024.f) - mean * mean, 0.f);
            const int s = w * 16 + bt * 8 + lane; stat[2 * s] = mean; stat[2 * s + 1] = __builtin_amdgcn_rsqf(var + EPS); }
    }
    __syncthreads();
    for (int grp = 0; grp < 8; ++grp) {
#pragma unroll
        for (int i = 0; i < 4; ++i) { const int cc = tid + NTHR * i, s = cc >> 4, part = cc & 15; const int ch = grp * 128 + part * 8;
            const f32x4 g0 = *(const GAS f32x4*)(ln_g + ch), g1 = *(const GAS f32x4*)(ln_g + ch + 4), b0 = *(const GAS f32x4*)(ln_b + ch), b1 = *(const GAS f32x4*)(ln_b + ch + 4);
            const float mean = stat[2 * s], rstd = stat[2 * s + 1]; const u32x4 a0 = va[i];
            float y[8];
            y[0] = (geluf_(bf_lo(a0.x)) - mean) * rstd * g0.x + b0.x; y[1] = (geluf_(bf_hi(a0.x)) - mean) * rstd * g0.y + b0.y;
            y[2] = (geluf_(bf_lo(a0.y)) - mean) * rstd * g0.z + b0.z; y[3] = (geluf_(bf_hi(a0.y)) - mean) * rstd * g0.w + b0.w;
            y[4] = (geluf_(bf_lo(a0.z)) - mean) * rstd * g1.x + b1.x; y[5] = (geluf_(bf_hi(a0.z)) - mean) * rstd * g1.y + b1.y;
            y[6] = (geluf_(bf_lo(a0.w)) - mean) * rstd * g1.z + b1.z; y[7] = (geluf_(bf_hi(a0.w)) - mean) * rstd * g1.w + b1.w;
            u32x4 pk; pk.x = cvt_pk_bf16(y[0], y[1]); pk.y = cvt_pk_bf16(y[2], y[3]); pk.z = cvt_pk_bf16(y[4], y[5]); pk.w = cvt_pk_bf16(y[6], y[7]);
            *(LAS u32x4*)(VN + s * VSTR + part * 16) = pk; }
#pragma unroll
        for (int i = 0; i < 8; ++i) { const int idx = tid + NTHR * i, t = idx >> 5, s4 = (idx & 31) * 4; f32x4 x = wv[i];
            x.x = (s4 + 0 <= t) ? x.x : 0.f; x.y = (s4 + 1 <= t) ? x.y : 0.f; x.z = (s4 + 2 <= t) ? x.z : 0.f; x.w = (s4 + 3 <= t) ? x.w : 0.f;
            u32x2 pk; pk.x = cvt_pk_bf16(x.x, x.y); pk.y = cvt_pk_bf16(x.z, x.w);
            *(LAS u32x2*)(Ws + t * WSTR + s4 * 2) = pk; }
        u32x2 uc[8];
#pragma unroll
        for (int et = 0; et < 8; ++et) uc[et] = uu[et];
        __syncthreads();
        if (grp + 1 < 8) SGU_LOAD(grp + 1);
        f32x4 acc[8];
#pragma unroll
        for (int et = 0; et < 8; ++et) acc[et] = (f32x4){0.f, 0.f, 0.f, 0.f};
        const int nkk = ((w * 16 + 15) >> 5) + 1;
        for (int kk = 0; kk < nkk; ++kk) {
            const LAS unsigned char* wrow = Ws + (w * 16 + fr) * WSTR + (kk * 32 + g * 4) * 2;
            const u32x2 ylo = *(const LAS u32x2*)wrow, yhi = *(const LAS u32x2*)(wrow + 32);
            u32x4 yw; yw.x = ylo.x; yw.y = ylo.y; yw.z = yhi.x; yw.w = yhi.y; const bf16x8 yf = __builtin_bit_cast(bf16x8, yw);
#pragma unroll
            for (int et = 0; et < 8; ++et) { const LAS unsigned char* vblk = VN + (kk * 32 + g * 4 + (fr >> 2)) * VSTR + (et * 16 + (fr & 3) * 4) * 2;
                const s16x4 lo = tr_read(vblk), hi = tr_read(vblk + 16 * VSTR);
                acc[et] = __builtin_amdgcn_mfma_f32_16x16x32_bf16(__builtin_shufflevector(lo, hi, 0, 1, 2, 3, 4, 5, 6, 7), yf, acc[et], 0, 0, 0); }
        }
        const int t = w * 16 + fr; const float bias = sb[grp * 128 + t];
#pragma unroll
        for (int et = 0; et < 8; ++et) { const int ch = grp * 128 + et * 16 + g * 4; const u32x2 u2 = uc[et];
            const float o0 = geluf_(bf_lo(u2.x)) * (acc[et][0] + bias), o1 = geluf_(bf_hi(u2.x)) * (acc[et][1] + bias), o2 = geluf_(bf_lo(u2.y)) * (acc[et][2] + bias), o3 = geluf_(bf_hi(u2.y)) * (acc[et][3] + bias);
            u32x2 wo; wo.x = cvt_pk_bf16(o0, o1); wo.y = cvt_pk_bf16(o2, o3);
            *(GAS u32x2*)(Y + (tok0 + t) * YW + 1024 + ch) = wo; }
        __syncthreads();
    }
#undef SGU_LOAD
}

__device__ __forceinline__ void hgrn_unit(int unit, int l, const GAS bf16* hb, const GAS float* hgrn_lb, const GAS float* norm_g, GAS bf16* Y, LAS unsigned char* lds, int tid) {
    const int b = unit >> 3, h = unit & 7;
    const int lane = tid & 63, w = __builtin_amdgcn_readfirstlane(tid >> 6), fr = lane & 15, g = lane >> 4;
    const int d = tid & 127, J = tid >> 7, Ju = w >> 1;
    constexpr int RS = 272, TS = 144;
    LAS unsigned char* U = lds; LAS unsigned char* Wm = lds + 17408; LAS unsigned char* Qe = lds + 60928; LAS unsigned char* KeT = lds + 78336; LAS unsigned char* VT = lds + 96768;
    LAS unsigned char* Am = lds + 115200; LAS float* Gs = (LAS float*)(lds + 124416); LAS float* DEC = (LAS float*)(lds + 126464); LAS float* SS = (LAS float*)(lds + 126976);
    const int ch = h * 128 + d;
    float lb;
    { const float v0 = hgrn_lb[ch], v1 = hgrn_lb[1024 + ch], v2 = hgrn_lb[2048 + ch], v3 = hgrn_lb[3072 + ch];
      const float mx = fmaxf(fmaxf(v0, v1), fmaxf(v2, v3));
      const float e0 = __expf(v0 - mx), e1 = __expf(v1 - mx), e2 = __expf(v2 - mx), e3 = __expf(v3 - mx); const float inv = 1.0f / (e0 + e1 + e2 + e3);
      lb = (l >= 1 ? e1 * inv : 0.f) + (l >= 2 ? e2 * inv : 0.f) + (l >= 3 ? e3 * inv : 0.f); }
    __syncthreads();
    for (int i = tid; i < 9216 / 4; i += NTHR) ((LAS unsigned*)Am)[i] = 0u;
    f32x4 st[8];
#pragma unroll
    for (int dt = 0; dt < 8; ++dt) st[dt] = (f32x4){0.f, 0.f, 0.f, 0.f};
    const int wbase[4] = {0, 16, 48, 96};
    const int base_J = (J == 0) ? 0 : (J == 1) ? 16 : (J == 2) ? 48 : 96;
    (void)wbase;
    constexpr size_t HBS = (size_t)32 << 20;
    const GAS bf16* pb = hb + (size_t)((b * 8 + h) * SEQ) * 128;
    const f32x4 ngv = *(const GAS f32x4*)(norm_g + w * 16 + g * 4);
    unsigned fraw[16], qraw[16], iraw[16];
#define HG_LOAD(cc) do { const GAS bf16* cb_ = pb + (size_t)((cc) * 64 + 16 * Ju) * 128 + (w & 1) * 64 + lane; \
        _Pragma("unroll") for (int tt = 0; tt < 16; ++tt) { fraw[tt] = cb_[tt * 128]; iraw[tt] = cb_[HBS + tt * 128]; qraw[tt] = cb_[2 * HBS + tt * 128]; } } while (0)
    HG_LOAD(0);
    for (int c = 0; c < 32; ++c) {
        const int tok0 = c * 64;
        float f[16], qs[16]; unsigned vraw[8];
        {
            float gp = 1.f;
#pragma unroll
            for (int tt = 0; tt < 16; ++tt) {
                const float fl = __builtin_bit_cast(float, fraw[tt] << 16), qv = __builtin_bit_cast(float, qraw[tt] << 16); const unsigned iv = iraw[tt];
                f[tt] = lb + (1.f - lb) * sigmoidf_(fl); qs[tt] = siluf_(qv) * 0.08838834764831845f; gp *= f[tt];
                if (tt & 1) vraw[tt >> 1] |= iv << 16; else vraw[tt >> 1] = iv; }
            Gs[J * 128 + d] = gp;
        }
        __syncthreads();
        {
            const float G0 = Gs[d], G1 = Gs[128 + d], G2 = Gs[256 + d], G3 = Gs[384 + d];
            const float EJ = (J == 0) ? 1.f : (J == 1) ? G0 : (J == 2) ? G0 * G1 : G0 * G1 * G2;
            const float TJ = (J == 0) ? G1 * G2 * G3 : (J == 1) ? G2 * G3 : (J == 2) ? G3 : 1.f;
            if (J == 0) DEC[d] = G0 * G1 * G2 * G3;
            *(LAS u32x4*)(VT + d * TS + J * 32) = (u32x4){vraw[0], vraw[1], vraw[2], vraw[3]};
            *(LAS u32x4*)(VT + d * TS + J * 32 + 16) = (u32x4){vraw[4], vraw[5], vraw[6], vraw[7]};
            float p = 1.f;
#pragma unroll
            for (int tt = 0; tt < 16; ++tt) { p *= f[tt]; const float u = qs[tt] * p; const int t = 16 * J + tt;
                *(LAS bf16*)(U + t * RS + d * 2) = (bf16)(cvt_pk_bf16(u, 0.f) & 0xffffu);
                *(LAS bf16*)(Qe + t * RS + d * 2) = (bf16)(cvt_pk_bf16(u * EJ, 0.f) & 0xffffu);
                const float kd = (1.f - f[tt]) / fmaxf(p, 1e-30f);
                *(LAS bf16*)(Wm + (base_J + t) * RS + d * 2) = (bf16)(cvt_pk_bf16(kd, 0.f) & 0xffffu); }
            float sfx = 1.f; unsigned kep[8];
#pragma unroll
            for (int tt = 15; tt >= 0; --tt) { const float ks = (1.f - f[tt]) * sfx; sfx *= f[tt]; const int t = 16 * J + tt;
                if (J == 0) { *(LAS bf16*)(Wm + (16 + t) * RS + d * 2) = (bf16)(cvt_pk_bf16(ks, 0.f) & 0xffffu);
                              *(LAS bf16*)(Wm + (48 + t) * RS + d * 2) = (bf16)(cvt_pk_bf16(ks * G1, 0.f) & 0xffffu);
                              *(LAS bf16*)(Wm + (96 + t) * RS + d * 2) = (bf16)(cvt_pk_bf16(ks * G1 * G2, 0.f) & 0xffffu); }
                else if (J == 1) { *(LAS bf16*)(Wm + (48 + t) * RS + d * 2) = (bf16)(cvt_pk_bf16(ks, 0.f) & 0xffffu);
                                   *(LAS bf16*)(Wm + (96 + t) * RS + d * 2) = (bf16)(cvt_pk_bf16(ks * G2, 0.f) & 0xffffu); }
                else if (J == 2) { *(LAS bf16*)(Wm + (96 + t) * RS + d * 2) = (bf16)(cvt_pk_bf16(ks, 0.f) & 0xffffu); }
                const unsigned kb = cvt_pk_bf16(ks * TJ, 0.f) & 0xffffu;
                if (tt & 1) kep[tt >> 1] = kb << 16; else kep[tt >> 1] |= kb; }
            *(LAS u32x4*)(KeT + d * TS + J * 32) = (u32x4){kep[0], kep[1], kep[2], kep[3]};
            *(LAS u32x4*)(KeT + d * TS + J * 32 + 16) = (u32x4){kep[4], kep[5], kep[6], kep[7]};
        }
        __syncthreads();
        if (c + 1 < 32) HG_LOAD(c + 1);
        __builtin_amdgcn_sched_barrier(0);
        for (int ti = w; ti < 10; ti += 8) {
            const int I = (ti == 0) ? 0 : (ti < 3) ? 1 : (ti < 6) ? 2 : 3; const int Jt = ti - ((I * (I + 1)) >> 1);
            const int bI = (I == 0) ? 0 : (I == 1) ? 16 : (I == 2) ? 48 : 96;
            f32x4 a = (f32x4){0.f, 0.f, 0.f, 0.f};
#pragma unroll
            for (int kk = 0; kk < 4; ++kk) { const bf16x8 xf = *(const LAS bf16x8*)(Wm + (bI + 16 * Jt + fr) * RS + (kk * 32 + g * 8) * 2);
                const bf16x8 yf = *(const LAS bf16x8*)(U + (16 * I + fr) * RS + (kk * 32 + g * 8) * 2);
                a = __builtin_amdgcn_mfma_f32_16x16x32_bf16(xf, yf, a, 0, 0, 0); }
            if (Jt == I) {
#pragma unroll
                for (int e = 0; e < 4; ++e) a[e] = (4 * g + e > fr) ? 0.f : a[e]; }
            u32x2 pk; pk.x = cvt_pk_bf16(a[0], a[1]); pk.y = cvt_pk_bf16(a[2], a[3]);
            *(LAS u32x2*)(Am + (16 * I + fr) * TS + (16 * Jt + 4 * g) * 2) = pk;
        }
        f32x4 o[4];
#pragma unroll
        for (int tt = 0; tt < 4; ++tt) o[tt] = (f32x4){0.f, 0.f, 0.f, 0.f};
#pragma unroll
        for (int kk = 0; kk < 4; ++kk) {
            u32x4 sw; sw.x = cvt_pk_bf16(st[2 * kk][0], st[2 * kk][1]); sw.y = cvt_pk_bf16(st[2 * kk][2], st[2 * kk][3]);
            sw.z = cvt_pk_bf16(st[2 * kk + 1][0], st[2 * kk + 1][1]); sw.w = cvt_pk_bf16(st[2 * kk + 1][2], st[2 * kk + 1][3]);
            const bf16x8 sx = __builtin_bit_cast(bf16x8, sw);
#pragma unroll
            for (int tt = 0; tt < 4; ++tt) { const LAS unsigned char* qrow = Qe + (16 * tt + fr) * RS + (kk * 32 + g * 4) * 2;
                const u32x2 lo = *(const LAS u32x2*)qrow, hi = *(const LAS u32x2*)(qrow + 32);
                u32x4 qw; qw.x = lo.x; qw.y = lo.y; qw.z = hi.x; qw.w = hi.y;
                o[tt] = __builtin_amdgcn_mfma_f32_16x16x32_bf16(sx, __builtin_bit_cast(bf16x8, qw), o[tt], 0, 0, 0); }
        }
        __syncthreads();
        u32x2 ggv[4];
#pragma unroll
        for (int tt = 0; tt < 4; ++tt) ggv[tt] = *(const GAS u32x2*)(pb + 3 * HBS + (size_t)(tok0 + 16 * tt + fr) * 128 + w * 16 + g * 4);
        bf16x8 vfr[2];
#pragma unroll
        for (int kk = 0; kk < 2; ++kk) vfr[kk] = *(const LAS bf16x8*)(VT + (16 * w + fr) * TS + (kk * 32 + g * 8) * 2);
#pragma unroll
        for (int tt = 0; tt < 4; ++tt)
#pragma unroll
            for (int kk = 0; kk < 2; ++kk) if (kk <= (tt >> 1)) {
                const bf16x8 yf = *(const LAS bf16x8*)(Am + (16 * tt + fr) * TS + (kk * 32 + g * 8) * 2);
                o[tt] = __builtin_amdgcn_mfma_f32_16x16x32_bf16(vfr[kk], yf, o[tt], 0, 0, 0); }
#pragma unroll
        for (int dt = 0; dt < 8; ++dt) { const f32x4 dec = *(const LAS f32x4*)(DEC + 16 * dt + 4 * g); st[dt] *= dec;
#pragma unroll
            for (int kk = 0; kk < 2; ++kk) { const bf16x8 xf = *(const LAS bf16x8*)(KeT + (16 * dt + fr) * TS + (kk * 32 + g * 8) * 2);
                st[dt] = __builtin_amdgcn_mfma_f32_16x16x32_bf16(xf, vfr[kk], st[dt], 0, 0, 0); } }
#pragma unroll
        for (int tt = 0; tt < 4; ++tt) { float q2 = o[tt][0] * o[tt][0] + o[tt][1] * o[tt][1] + o[tt][2] * o[tt][2] + o[tt][3] * o[tt][3];
            q2 += __shfl_xor(q2, 16); q2 += __shfl_xor(q2, 32);
            if (g == 0) SS[w * 64 + 16 * tt + fr] = q2; }
        __syncthreads();
#pragma unroll
        for (int tt = 0; tt < 4; ++tt) { const int t = 16 * tt + fr; float tot = 0.f;
#pragma unroll
            for (int ww = 0; ww < 8; ++ww) tot += SS[ww * 64 + t];
            const float rstd = __builtin_amdgcn_rsqf(tot * (1.f / 128.f) + EPS);
            const size_t tok = (size_t)b * SEQ + tok0 + t; const int e0 = h * 128 + w * 16 + g * 4;
            const u32x2 gg = ggv[tt];
            const float y0 = o[tt][0] * rstd * ngv.x * siluf_(bf_lo(gg.x)), y1 = o[tt][1] * rstd * ngv.y * siluf_(bf_hi(gg.x));
            const float y2 = o[tt][2] * rstd * ngv.z * siluf_(bf_lo(gg.y)), y3 = o[tt][3] * rstd * ngv.w * siluf_(bf_hi(gg.y));
            u32x2 wv; wv.x = cvt_pk_bf16(y0, y1); wv.y = cvt_pk_bf16(y2, y3);
            *(GAS u32x2*)(Y + tok * YW + 2048 + e0) = wv; }
    }
#undef HG_LOAD
}
#ifndef MK_MULTI
#define MK_MULTI 0
#endif
#ifndef PH_MASK
#define PH_MASK 0xFFFFF
#endif
#define HASP(p) (((PH_MASK) >> (p)) & 1)
#ifndef RES_MASTER_HALF
#define RES_MASTER_HALF 0
#endif
#ifndef DUP_MASK
#define DUP_MASK 0
#endif
#define DUPP(p) (((DUP_MASK) >> (p)) & 1)
constexpr int NPH_LAYER = 12, NPH = NL * NPH_LAYER + 1;
struct Args { const float* in[25]; float* out; unsigned char* ws; int ph_lo, ph_hi; };
enum { I_X = 0, I_MEM, I_NORM_MIX, I_W_IN, I_W_GATE, I_SINKS, I_SGU_LN_G, I_SGU_LN_B, I_SGU_W, I_SGU_B, I_HGRN_LB, I_HGRN_NORM, I_W_BR_A, I_W_BR_B, I_W_BR_C, I_W_OUT, I_NORM_X, I_MEM_NORM,
       I_W_XQ, I_W_XKV, I_W_XO, I_NORM_FFN, I_W_FFN_IN, I_W_FFN_OUT, I_FINAL_NORM };

#define CIN(i) ((const GAS float*)(((uintptr_t)(unsigned)__builtin_amdgcn_readfirstlane((int)lctl[17 + 2 * (i)]) << 32) | (uintptr_t)(unsigned)__builtin_amdgcn_readfirstlane((int)lctl[16 + 2 * (i)])))
__device__ __forceinline__ void conv_phase(volatile LAS unsigned* lctl, int l, GAS unsigned char* ws, LAS float* scr, int gw, int NGW, int lane) {
    constexpr int I_IN = 32 * 240, I_GT = 32 * 192, I_BR = 16 * 64, I_OUT = 32 * 64, I_XQ = 32 * 16, I_XO = 8 * 64, I_F1 = 32 * 352, I_F2 = 88 * 64;
    constexpr int NITEMS = I_IN + I_GT + 3 * I_BR + I_OUT + I_XQ + I_XO + I_F1 + I_F2;
    GAS bf16* cWcat = (GAS bf16*)(ws + WS_WCAT); GAS bf16* cWbr = (GAS bf16*)(ws + WS_WBR); GAS bf16* cWout = (GAS bf16*)(ws + WS_WOUT); GAS bf16* cWxq = (GAS bf16*)(ws + WS_WXQ); GAS bf16* cWxo = (GAS bf16*)(ws + WS_WXO);
    GAS bf16* cWf1 = (GAS bf16*)(ws + WS_WF1); GAS bf16* cWf2 = (GAS bf16*)(ws + WS_WF2);
    for (int it = gw; it < NITEMS; it += NGW) {
        int r = it;
        if (r < I_IN) { const int kb = r / 240, nb = r % 240; tr_item(CIN(I_W_IN) + (size_t)l * DM * INW, INW, cWcat, DM, 64 * kb, 32 * nb, 32 * nb, scr, lane, CIN(I_NORM_MIX) + l * DM); continue; } r -= I_IN;
        if (r < I_GT) { const int kb = r / 192, nb = r % 192; tr_item(CIN(I_W_GATE) + (size_t)l * DM * GW, GW, cWcat, DM, 64 * kb, 32 * nb, INW + 32 * nb, scr, lane, CIN(I_NORM_MIX) + l * DM); continue; } r -= I_GT;
        if (r < 3 * I_BR) { const int j = r / I_BR, q = r % I_BR, kb = q / 64, nb = q % 64;
            tr_item(CIN(I_W_BR_A + j) + (size_t)l * 1024 * DM, DM, cWbr + (size_t)j * DM * 1024, 1024, 64 * kb, 32 * nb, 32 * nb, scr, lane); continue; } r -= 3 * I_BR;
        if (r < I_OUT) { const int kb = r / 64, nb = r % 64; tr_item(CIN(I_W_OUT) + (size_t)l * DM * DM, DM, cWout, DM, 64 * kb, 32 * nb, 32 * nb, scr, lane); continue; } r -= I_OUT;
        if (r < I_XQ) { const int kb = r / 16, nb = r % 16; tr_item(CIN(I_W_XQ) + (size_t)l * DM * XD, XD, cWxq, DM, 64 * kb, 32 * nb, 32 * nb, scr, lane, CIN(I_NORM_X) + l * DM); continue; } r -= I_XQ;
        if (r < I_XO) { const int kb = r / 64, nb = r % 64; tr_item(CIN(I_W_XO) + (size_t)l * XD * DM, DM, cWxo, XD, 64 * kb, 32 * nb, 32 * nb, scr, lane); continue; } r -= I_XO;
        if (r < I_F1) { const int kb = r / 352, nb = r % 352; const int n0 = 32 * nb; const int cc = (n0 < DFF) ? n0 : n0 - DFF; const int drow = 256 * (cc >> 7) + (cc & 127) + ((n0 < DFF) ? 0 : 128);
            tr_item(CIN(I_W_FFN_IN) + (size_t)l * DM * 2 * DFF, 2 * DFF, cWf1, DM, 64 * kb, n0, drow, scr, lane, CIN(I_NORM_FFN) + l * DM); continue; } r -= I_F1;
        { const int kb = r / 64, nb = r % 64; tr_item(CIN(I_W_FFN_OUT) + (size_t)l * DFF * DM, DM, cWf2, DFF, 64 * kb, 32 * nb, 32 * nb, scr, lane); }
    }
    if (l == 0) {
        GAS bf16* cWxkv = (GAS bf16*)(ws + WS_WXKV);
        for (int it = gw; it < 4 * 1024; it += NGW) { const int ll = it >> 10, q = it & 1023, kb = q >> 5, nb = q & 31;
            tr_item(CIN(I_W_XKV) + (size_t)ll * DM * 1024, 1024, cWxkv, DM, 64 * kb, 32 * nb, ll * 1024 + 32 * nb, scr, lane); }
        norm_phase(CIN(I_MEM), CIN(I_MEM_NORM), (GAS bf16*)(ws + WS_MEMN), MT, gw, NGW, lane);
    }
}

__global__ void __launch_bounds__(NTHR, 2) fwd_kernel(Args a) {
    extern __shared__ __attribute__((aligned(16))) unsigned char lds_raw[];
    LAS unsigned char* lds = (LAS unsigned char*)lds_raw;
    volatile LAS unsigned* lctl = (volatile LAS unsigned*)(lds + LDSCTL_OFF);
    const int tid0 = threadIdx.x;
    const int G = gridDim.x, bx = blockIdx.x;
    unsigned* ctl0 = (unsigned*)(a.ws + WS_CTL);
    for (int u = tid0; u < (LDS_BYTES - LDSCTL_OFF) / 4; u += NTHR) lctl[u] = 0u;
    __syncthreads();
    if (tid0 < 25) { lctl[16 + 2 * tid0] = (unsigned)(uintptr_t)a.in[tid0]; lctl[17 + 2 * tid0] = (unsigned)((uintptr_t)a.in[tid0] >> 32); }
    if (tid0 == 0) { lctl[8] = (unsigned)(uintptr_t)a.ws; lctl[9] = (unsigned)((uintptr_t)a.ws >> 32); lctl[10] = (unsigned)(uintptr_t)a.out; lctl[11] = (unsigned)((uintptr_t)a.out >> 32); }
    __syncthreads();
    const int lo = a.ph_lo, hi = a.ph_hi;
    XcdBarrier bar; bar.bar = ctl0 + CW_BAR; bar.x = 0; bar.st = nullptr;
    if (hi - lo > 1) bar = xcd_barrier_post(ctl0 + CW_BAR, lctl);
#define IN(k) (lo <= (k) && (k) < hi)
#define SEAM(k) do { if (IN(k) && IN((k) + 1)) xcd_barrier(bar); } while (0)

#define OPQ_PTR(TY, w) ((TY)(((uintptr_t)(unsigned)__builtin_amdgcn_readfirstlane((int)lctl[(w) + 1]) << 32) | (uintptr_t)(unsigned)__builtin_amdgcn_readfirstlane((int)lctl[(w)])))
#define PH_BEGIN int tid = threadIdx.x; asm volatile("" : "+v"(tid)); \
        GAS unsigned char* ws = OPQ_PTR(GAS unsigned char*, 8); GAS float* out = OPQ_PTR(GAS float*, 10); const int lane = tid & 63, wave = __builtin_amdgcn_readfirstlane(tid >> 6); const int gw = bx * NWAVES + wave, NGW = G * NWAVES; \
        (void)ws; (void)out; (void)lane; (void)gw; (void)NGW;
#define WSP(off) ((GAS bf16*)(ws + (off)))
#define GIN(i) OPQ_PTR(const GAS float*, 16 + 2 * (i))
    for (int l = 0; l < NL; ++l) {
        const int pb = l * NPH_LAYER;
        if (HASP(0) && IN(pb + 0)) for (int rep = 0; rep <= DUPP(0); ++rep) { if (rep) xcd_barrier(bar); PH_BEGIN
            conv_phase(lctl, l, ws, (LAS float*)(lds + wave * 16384), gw, NGW, lane);
            if (l == 0) xb_phase(GIN(I_X), WSP(WS_H), RES_MASTER_HALF ? (GAS unsigned short*)out : (GAS unsigned short*)nullptr, (GAS float*)(ws + WS_SS), gw, NGW, lane);
        }
        SEAM(pb + 0);
        if (HASP(1) && IN(pb + 1)) for (int rep = 0; rep <= DUPP(1); ++rep) { if (rep) xcd_barrier(bar); PH_BEGIN
            { pg8::PlainOrder S; S.init(T, NCAT, G, bx, WSP(WS_H), DM, WSP(WS_WCAT), DM); EpiCat E{ws + WS_PROJ, WSP(WS_GATE), RowScale{(const GAS float*)(ws + WS_SS), (LAS float*)(lds + LDS_RSTD)}};
              pg8::gemm_phase(lds, pg8::GemmK{DM, DM, DM}, S, E); }
            if (l == 0) { pg8::PlainOrder S; S.init(MT, 4096, G, bx, WSP(WS_MEMN), DM, WSP(WS_WXKV), DM); EpiPlain<false> E{WSP(WS_KV), 4096, RowScale{nullptr, nullptr}};
              pg8::gemm_phase(lds, pg8::GemmK{DM, DM, DM}, S, E); }
        }
        SEAM(pb + 1);
        if (HASP(2) && IN(pb + 2)) for (int rep = 0; rep <= DUPP(2); ++rep) { if (rep) xcd_barrier(bar);
            for (int r2 = 0; r2 <= DUPP(16); ++r2) { PH_BEGIN unsigned* q = (unsigned*)(a.ws + WS_CTL) + CW_Q + 256 * l + 16 * rep + 8 * r2;
              for (;;) { __syncthreads(); if (tid == 0) lctl[4] = xb_add(q, 1u); __syncthreads(); const int idx = (int)lctl[4]; if (idx >= NB * 8) break;
                hgrn_unit(idx, l, WSP(WS_PROJ + PJ_HB), GIN(I_HGRN_LB), GIN(I_HGRN_NORM) + l * 128, WSP(WS_Y), lds, tid); } }
            for (int r2 = 0; r2 <= DUPP(17); ++r2) { PH_BEGIN unsigned* q = (unsigned*)(a.ws + WS_CTL) + CW_Q + 256 * l + 16 * rep + 8 * r2;
              for (;;) { __syncthreads(); if (tid == 0) lctl[4] = xb_add(q + 64, 1u); __syncthreads(); const int idx = (int)lctl[4]; if (idx >= NB * 64) break;
                swa_unit(idx, WSP(WS_PROJ), GIN(I_SINKS) + l * 16, WSP(WS_Y), lds, tid); } }
            for (int r2 = 0; r2 <= DUPP(18); ++r2) { PH_BEGIN unsigned* q = (unsigned*)(a.ws + WS_CTL) + CW_Q + 256 * l + 16 * rep + 8 * r2;
              for (;;) { __syncthreads(); if (tid == 0) lctl[4] = xb_add(q + 128, 1u); __syncthreads(); const int idx = (int)lctl[4]; if (idx >= NB * 16) break;
                sgu_unit(idx, WSP(WS_PROJ + PJ_UB), WSP(WS_PROJ + PJ_VB), GIN(I_SGU_LN_G) + l * 1024, GIN(I_SGU_LN_B) + l * 1024, GIN(I_SGU_W) + (size_t)l * 8 * 16384, GIN(I_SGU_B) + l * 1024, WSP(WS_Y), lds, tid); } }
            __syncthreads();
        }
        SEAM(pb + 2);
        if (HASP(3) && IN(pb + 3)) for (int rep = 0; rep <= DUPP(3); ++rep) { if (rep) xcd_barrier(bar); PH_BEGIN
            pg8::PlainOrder S; S.init(T, DM, G, bx, WSP(WS_Y), YW, WSP(WS_WBR), 1024, 3, (size_t)1024 * 2, (size_t)DM * 1024 * 2);
            EpiBranch E{WSP(WS_GATE), WSP(WS_PROJ)};
            pg8::gemm_phase(lds, pg8::GemmK{1024, YW, 1024}, S, E);
        }
        SEAM(pb + 3);
        if (HASP(4) && IN(pb + 4)) for (int rep = 0; rep <= DUPP(4); ++rep) { if (rep) xcd_barrier(bar); PH_BEGIN
            pg8::PlainOrder S; S.init(T, DM, G, bx, WSP(WS_PROJ), DM, WSP(WS_WOUT), DM); EpiResid E{WSP(WS_H), rep ? WSP(WS_GATE) : WSP(WS_H), rep ? (GAS float*)nullptr : (GAS float*)(ws + WS_SS), (LAS float*)(lds + LDS_RED), (RES_MASTER_HALF && !rep) ? (GAS unsigned short*)out : (GAS unsigned short*)nullptr};
            pg8::gemm_phase(lds, pg8::GemmK{DM, DM, DM}, S, E);
        }
        SEAM(pb + 4);
        if (HASP(6) && IN(pb + 6)) for (int rep = 0; rep <= DUPP(6); ++rep) { if (rep) xcd_barrier(bar); PH_BEGIN
            pg8::PlainOrder S; S.init(T, XD, G, bx, WSP(WS_H), DM, WSP(WS_WXQ), DM); EpiPlain<true> E{WSP(WS_Y), XD, RowScale{(const GAS float*)(ws + WS_SS), (LAS float*)(lds + LDS_RSTD)}};
            pg8::gemm_phase(lds, pg8::GemmK{DM, DM, DM}, S, E);
        }
        SEAM(pb + 6);
        if (HASP(7) && IN(pb + 7)) for (int rep = 0; rep <= DUPP(7); ++rep) { if (rep) xcd_barrier(bar); PH_BEGIN for (int u = bx; u < NB * 32; u += G) xattn_unit(u, l, WSP(WS_KV), WSP(WS_Y), WSP(WS_Y + 32 * MiB), lds, tid); __syncthreads(); }
        SEAM(pb + 7);
        if (HASP(8) && IN(pb + 8)) for (int rep = 0; rep <= DUPP(8); ++rep) { if (rep) xcd_barrier(bar); PH_BEGIN
            pg8::PlainOrder S; S.init(T, DM, G, bx, WSP(WS_Y + 32 * MiB), XD, WSP(WS_WXO), XD); EpiResid E{WSP(WS_H), rep ? WSP(WS_GATE) : WSP(WS_H), rep ? (GAS float*)nullptr : (GAS float*)(ws + WS_SS), (LAS float*)(lds + LDS_RED), (RES_MASTER_HALF && !rep) ? (GAS unsigned short*)out : (GAS unsigned short*)nullptr};
            pg8::gemm_phase(lds, pg8::GemmK{XD, XD, XD}, S, E);
        }
        SEAM(pb + 8);
        if (HASP(10) && IN(pb + 10)) for (int rep = 0; rep <= DUPP(10); ++rep) { if (rep) xcd_barrier(bar); PH_BEGIN
            pg8::PlainOrder S; S.init(T, 2 * DFF, G, bx, WSP(WS_H), DM, WSP(WS_WF1), DM); EpiSwiglu E{WSP(WS_PROJ), RowScale{(const GAS float*)(ws + WS_SS), (LAS float*)(lds + LDS_RSTD)}};
            pg8::gemm_phase(lds, pg8::GemmK{DM, DM, DM}, S, E);
        }
        SEAM(pb + 10);
        if (HASP(11) && IN(pb + 11)) for (int rep = 0; rep <= DUPP(11); ++rep) { if (rep) xcd_barrier(bar); PH_BEGIN
            pg8::PlainOrder S; S.init(T, DM, G, bx, WSP(WS_PROJ), DFF, WSP(WS_WF2), DFF); EpiResid E{WSP(WS_H), rep ? WSP(WS_GATE) : WSP(WS_H), rep ? (GAS float*)nullptr : (GAS float*)(ws + WS_SS), (LAS float*)(lds + LDS_RED), (RES_MASTER_HALF && !rep) ? (GAS unsigned short*)out : (GAS unsigned short*)nullptr};
            pg8::gemm_phase(lds, pg8::GemmK{DFF, DFF, DFF}, S, E);
        }
        SEAM(pb + 11);
    }
    if (HASP(12) && IN(NPH - 1)) { const int lane = tid0 & 63, wave = __builtin_amdgcn_readfirstlane(tid0 >> 6); final_norm_phase((const GAS unsigned short*)(a.ws + WS_H), (GAS float*)a.out, GIN(I_FINAL_NORM), (const GAS float*)(a.ws + WS_SS), bx * NWAVES + wave, G * NWAVES, lane); }
#undef IN
#undef SEAM
#undef PH_BEGIN
#undef OPQ_PTR
#undef WSP
#undef GIN
}

extern "C" void kernel_launch(void* const* d_in, const int* in_sizes, int n_in, void* d_out, int out_size, void* d_ws, size_t ws_size, hipStream_t stream) {
    static int grid = 0;
    if (grid == 0) {
        if (n_in != 25 || out_size != T * DM || ws_size < WS_END) { fprintf(stderr, "kernel_launch: unexpected shapes (n_in %d, out %d, ws %zu, need %zu)\n", n_in, out_size, ws_size, (size_t)WS_END); grid = -1; return; }
        int dev = 0, cus = 0, per_cu = 0;
        if (hipGetDevice(&dev) != hipSuccess || hipDeviceGetAttribute(&cus, hipDeviceAttributeMultiprocessorCount, dev) != hipSuccess) { grid = -1; return; }
        if (hipFuncSetAttribute((const void*)fwd_kernel, hipFuncAttributeMaxDynamicSharedMemorySize, LDS_BYTES) != hipSuccess) { fprintf(stderr, "kernel_launch: hipFuncSetAttribute failed\n"); grid = -1; return; }
        if (hipOccupancyMaxActiveBlocksPerMultiprocessor(&per_cu, (const void*)fwd_kernel, NTHR, LDS_BYTES) != hipSuccess || per_cu < 1)
            fprintf(stderr, "kernel_launch: occupancy query reports %d workgroups per CU\n", per_cu);
        (void)hipGetLastError();
        grid = cus;
    }
    if (grid < 0) return;
    if (hipMemsetAsync((char*)d_ws + WS_CTL, 0, CTL_ZERO_BYTES, stream) != hipSuccess) return;
    Args a{};
    for (int i = 0; i < 25; ++i) a.in[i] = (const float*)d_in[i];
    a.out = (float*)d_out; a.ws = (unsigned char*)d_ws;
#if MK_MULTI
    for (int p = 0; p < NPH; ++p) { a.ph_lo = p; a.ph_hi = p + 1; hipLaunchKernelGGL(fwd_kernel, dim3(grid), dim3(NTHR), LDS_BYTES, stream, a); }
#else
    a.ph_lo = 0; a.ph_hi = NPH;
    hipLaunchKernelGGL(fwd_kernel, dim3(grid), dim3(NTHR), LDS_BYTES, stream, a);
#endif
}
```

```cpp
#include <hip/hip_runtime.h>
#include <cstdio>
#include <cstdint>

#define LAS __attribute__((address_space(3)))
#define GAS __attribute__((address_space(1)))
typedef unsigned short bf16;
typedef short bf16x8 __attribute__((ext_vector_type(8)));
typedef float f32x4 __attribute__((ext_vector_type(4)));
typedef float f32x2 __attribute__((ext_vector_type(2)));
typedef unsigned u32x4 __attribute__((ext_vector_type(4)));
typedef unsigned u32x2 __attribute__((ext_vector_type(2)));
typedef GAS unsigned gu32;

__device__ __forceinline__ unsigned cvt_pk_bf16(float lo, float hi) { unsigned r; asm("v_cvt_pk_bf16_f32 %0, %1, %2" : "=v"(r) : "v"(lo), "v"(hi)); return r; }
__device__ __forceinline__ unsigned pk_min_u16(unsigned a, unsigned b) { unsigned r; asm("v_pk_min_u16 %0, %1, %2" : "=v"(r) : "v"(a), "v"(b)); return r; }
__device__ __forceinline__ float bf_lo(unsigned w) { return __builtin_bit_cast(float, w << 16); }
__device__ __forceinline__ float bf_hi(unsigned w) { return __builtin_bit_cast(float, w & 0xffff0000u); }
__device__ __forceinline__ float bf1(bf16 h) { return __builtin_bit_cast(float, (unsigned)h << 16); }
__device__ __forceinline__ float fast_exp(float x) { return __builtin_amdgcn_exp2f(x * 1.4426950408889634f); }
__device__ __forceinline__ float sigmoidf_(float x) { return __builtin_amdgcn_rcpf(1.0f + fast_exp(-x)); }
__device__ __forceinline__ float siluf_(float x) { return x * sigmoidf_(x); }
__device__ __forceinline__ float geluf_(float x) { return x * sigmoidf_(1.5957691216057308f * (x + 0.044715f * x * x * x)); }
__device__ __forceinline__ float wave_sum(float v) {
#pragma unroll
    for (int o = 1; o < 64; o <<= 1) v += __shfl_xor(v, o);
    return v;
}

typedef _Float16 f16x8 __attribute__((ext_vector_type(8)));
typedef _Float16 f16x4 __attribute__((ext_vector_type(4)));
typedef _Float16 f16x2 __attribute__((ext_vector_type(2)));
template <bool F16> __device__ __forceinline__ f32x4 mma16(bf16x8 a, bf16x8 b, f32x4 c) {
    if constexpr (F16) return __builtin_amdgcn_mfma_f32_16x16x32_f16(__builtin_bit_cast(f16x8, a), __builtin_bit_cast(f16x8, b), c, 0, 0, 0);
    else return __builtin_amdgcn_mfma_f32_16x16x32_bf16(a, b, c, 0, 0, 0);
}
#ifndef RES_F16
#define RES_F16 0
#endif
__device__ __forceinline__ unsigned cvt_pk_f16(float lo, float hi) { f16x2 h; h.x = (_Float16)lo; h.y = (_Float16)hi; return __builtin_bit_cast(unsigned, h); }
__device__ __forceinline__ float h_lo(unsigned w) { return (float)__builtin_bit_cast(f16x2, w).x; }
__device__ __forceinline__ float h_hi(unsigned w) { return (float)__builtin_bit_cast(f16x2, w).y; }
__device__ __forceinline__ unsigned cvt_pk_res(float lo, float hi) { return RES_F16 ? cvt_pk_f16(lo, hi) : cvt_pk_bf16(lo, hi); }
__device__ __forceinline__ float res_lo(unsigned w) { return RES_F16 ? h_lo(w) : bf_lo(w); }
__device__ __forceinline__ float res_hi(unsigned w) { return RES_F16 ? h_hi(w) : bf_hi(w); }
namespace pg8 {
constexpr int BM = 256, BK = 64, HALF = 128, HTB = HALF * BK * 2, STAGE_BYTES = 8 * HTB, NXCD = 8, WGM = 4;
__host__ __device__ __forceinline__ int lds_byte(int r, int c) { const int st = (r >> 4) * 2 + (c >> 5), rr = r & 15, cc = c & 31, ob = rr * 64 + cc * 2; return st * 1024 + (ob ^ (((ob >> 9) & 1) << 5)); }
__host__ __device__ __forceinline__ void stage_rc(int b, int& R, int& C) { const int st = b / 1024, sb = b % 1024, swz = sb ^ (((sb >> 9) & 1) << 5); R = (st >> 1) * 16 + swz / 64; C = (st & 1) * 32 + (swz % 64) / 2; }
__host__ __device__ __forceinline__ int perm32(int rho) { const int n = rho >> 4, i = rho & 15; return 8 * (i >> 2) + 4 * n + (i & 3); }

struct Unit { int pm, pn, aux; const GAS char* a; const GAS char* b; };
struct GemmK { int K, lda, ldb, ablk; };
__host__ __device__ __forceinline__ size_t blk16x32(size_t r, int c, int W) { return ((r >> 4) * (size_t)(W >> 5) + (size_t)(c >> 5)) * 1024 + (r & 15) * 64 + (size_t)(c & 31) * 2; }

__device__ __forceinline__ void tile_of(int L, int nM, int nN, int wgm, int& pm, int& pn) {
    const int nwg = nM * nN; int wgid = L;
    { const int q = nwg / NXCD, r = nwg % NXCD, xcd = wgid % NXCD, off = wgid / NXCD; wgid = (xcd < r ? xcd * (q + 1) : r * (q + 1) + (xcd - r) * q) + off; }
    const int nig = wgm * nN, gid = wgid / nig, fm = gid * wgm, gsz = (nM - fm) < wgm ? (nM - fm) : wgm;
    pm = fm + ((wgid % nig) % gsz); pn = (wgid % nig) / gsz;
}
struct PlainOrder {
    int nM, nN, nwg, G, c, sub, wgm; const GAS char* A; const GAS char* B; size_t tA, tB, asub, bsub;
    __device__ __forceinline__ void init(int M, int N, int G_, int c_, const GAS void* A_, int lda, const GAS void* B_, int ldb, int sub_ = 1, size_t asub_ = 0, size_t bsub_ = 0, int wgm_ = WGM) {
        nM = M / BM; nN = N / BM; nwg = nM * nN; G = G_; c = c_; A = (const GAS char*)A_; B = (const GAS char*)B_; tA = (size_t)BM * lda * 2; tB = (size_t)BM * ldb * 2; sub = sub_; asub = asub_; bsub = bsub_; wgm = wgm_; }
    __device__ __forceinline__ bool next(int i, Unit& u) const {
        const int ti = i / sub, j = i - ti * sub;
        const long L = (long)ti * G + c; if (L >= nwg) return false;
        tile_of((int)L, nM, nN, wgm, u.pm, u.pn); u.aux = j;
        u.a = A + (size_t)u.pm * tA + (size_t)j * asub; u.b = B + (size_t)u.pn * tB + (size_t)j * bsub; return true;
    }
};

template <class Epi, class Sched>
__device__ __forceinline__ void gemm_phase(LAS unsigned char* lds, const GemmK g, const Sched& S, const Epi& E) {
    int tid = threadIdx.x; asm volatile("" : "+v"(tid));
    const int wid = __builtin_amdgcn_readfirstlane(tid >> 6), lane = tid & 63, wr = wid >> 2, wc = wid & 3, fr = lane & 15, fq = lane >> 4;
    const int K = g.K, nt = K / BK;
    unsigned voffA[2], voffB[2];
#pragma unroll
    for (int i = 0; i < 2; ++i) { int R, C; stage_rc(tid * 16 + i * 8192, R, C); const int Rb = Epi::PERM ? ((R & ~31) + perm32(R & 31)) : R;
        voffA[i] = g.ablk ? (unsigned)blk16x32((size_t)R, C, g.lda) : (unsigned)(R * g.lda + C) * 2u; voffB[i] = (unsigned)blk16x32((size_t)Rb, C, g.ldb); }
    const size_t kstep = (size_t)2048, kstepA = g.ablk ? (size_t)2048 : (size_t)(BK * 2);
    const size_t hstepA = (size_t)HALF * g.lda * 2, hstepB = (size_t)HALF * g.ldb * 2;
    const unsigned ldsw = (unsigned)wid * 1024u;
    const int aoff = lds_byte(wr * 64 + fr, fq * 8), boff = lds_byte(wc * 32 + fr, fq * 8);
#define PG8_SA(b, h) (((b) * 2 + (h)) * HTB)
#define PG8_SB(b, h) ((4 + (b) * 2 + (h)) * HTB)
#define PG8_STAGE(bufoff, gbase, voff) do { _Pragma("unroll") for (int _i = 0; _i < 2; ++_i) \
        __builtin_amdgcn_global_load_lds((const GAS unsigned*)((gbase) + (voff)[_i]), (LAS unsigned*)(lds + (bufoff) + ldsw + _i * 8192), 16, 0, 0); } while (0)
#define PG8_LDA(dst, b, h) do { _Pragma("unroll") for (int m = 0; m < 4; ++m) _Pragma("unroll") for (int k = 0; k < 2; ++k) dst[m][k] = *(const LAS bf16x8*)(lds + PG8_SA(b, h) + aoff + m * 2048 + k * 1024); } while (0)
#define PG8_LDB(dst, b, h) do { _Pragma("unroll") for (int n = 0; n < 2; ++n) _Pragma("unroll") for (int k = 0; k < 2; ++k) dst[n][k] = *(const LAS bf16x8*)(lds + PG8_SB(b, h) + boff + n * 2048 + k * 1024); } while (0)
#define PG8_MMA(ai, bj, At, Bt) do { __builtin_amdgcn_s_setprio(1); _Pragma("unroll") for (int m = 0; m < 4; ++m) _Pragma("unroll") for (int n = 0; n < 2; ++n) _Pragma("unroll") for (int k = 0; k < 2; ++k) \
        acc[ai][bj][m][n] = mma16<Epi::F16>(Bt[n][k], At[m][k], acc[ai][bj][m][n]); __builtin_amdgcn_s_setprio(0); } while (0)
#define PG8_WAIT_V(n) asm volatile("s_waitcnt vmcnt(" #n ")" ::: "memory")
#define PG8_WAIT_L(n) asm volatile("s_waitcnt lgkmcnt(" #n ")" ::: "memory")
#define PG8_BAR __builtin_amdgcn_s_barrier()
#define PG8_SCHED __builtin_amdgcn_sched_barrier(0)
    Unit cur, nxt; int ui = 0;
    if (!S.next(0, cur)) return;
    int tb = 0;
    E.prep(cur, 0, tid);
    f32x4 acc[2][2][4][2];
#pragma unroll
    for (int a = 0; a < 2; ++a)
#pragma unroll
        for (int b = 0; b < 2; ++b)
#pragma unroll
            for (int m = 0; m < 4; ++m)
#pragma unroll
                for (int n = 0; n < 2; ++n) acc[a][b][m][n] = (f32x4){0.f, 0.f, 0.f, 0.f};
    bf16x8 At[4][2], B0[2][2], B1[2][2];
    const GAS char* cA = cur.a; const GAS char* cB = cur.b;
    PG8_STAGE(PG8_SB(0, 0), cB, voffB); PG8_STAGE(PG8_SB(0, 1), cB + hstepB, voffB); PG8_STAGE(PG8_SA(0, 0), cA, voffA); PG8_STAGE(PG8_SA(0, 1), cA + hstepA, voffA);
    if (wr == 1) PG8_BAR;
    PG8_WAIT_V(2); PG8_BAR;
    PG8_STAGE(PG8_SB(1, 0), cB + kstep, voffB); PG8_STAGE(PG8_SA(1, 0), cA + kstepA, voffA); PG8_STAGE(PG8_SB(1, 1), cB + hstepB + kstep, voffB);
    PG8_WAIT_V(6); PG8_BAR;
#ifdef PROBE_TIMING
    unsigned long long pt_k = 0, pt_e = 0, pt_0 = 0; unsigned pt_n = 0;
#endif
    for (;;) {
#ifdef PROBE_TIMING
        pt_0 = __builtin_amdgcn_s_memrealtime();
#endif
        const bool has_next = S.next(ui + 1, nxt);
        const GAS char* nA = has_next ? nxt.a : cA; const GAS char* nB = has_next ? nxt.b : cB;
        for (int t = 0; t < nt; t += 2) {
            const bool last = (t == nt - 2);
            const GAS char* a1 = cA + (size_t)(t + 1) * kstepA;
            const GAS char* a2 = last ? nA : cA + (size_t)(t + 2) * kstepA; const GAS char* b2 = last ? nB : cB + (size_t)(t + 2) * kstep;
            const GAS char* a3 = a2 + kstepA; const GAS char* b3 = b2 + kstep;
            PG8_LDB(B0, 0, 0); PG8_LDB(B1, 0, 1); PG8_SCHED; PG8_LDA(At, 0, 0); PG8_STAGE(PG8_SA(1, 1), a1 + hstepA, voffA);
            PG8_WAIT_V(8); PG8_WAIT_L(0); PG8_BAR; PG8_MMA(0, 0, At, B0); PG8_MMA(0, 1, At, B1); PG8_BAR; PG8_SCHED;
            PG8_LDA(At, 0, 1); PG8_STAGE(PG8_SB(0, 0), b2, voffB); PG8_STAGE(PG8_SB(0, 1), b2 + hstepB, voffB); PG8_STAGE(PG8_SA(0, 0), a2, voffA);
            PG8_WAIT_V(8); PG8_WAIT_L(0); PG8_BAR; PG8_MMA(1, 0, At, B0); PG8_MMA(1, 1, At, B1); PG8_BAR; PG8_SCHED;
            PG8_LDB(B0, 1, 0); PG8_LDB(B1, 1, 1); PG8_SCHED; PG8_LDA(At, 1, 0); PG8_STAGE(PG8_SA(0, 1), a2 + hstepA, voffA);
            PG8_WAIT_V(8); PG8_WAIT_L(0); PG8_BAR; PG8_MMA(0, 0, At, B0); PG8_MMA(0, 1, At, B1); PG8_BAR; PG8_SCHED;
            PG8_LDA(At, 1, 1); PG8_STAGE(PG8_SB(1, 0), b3, voffB); PG8_STAGE(PG8_SB(1, 1), b3 + hstepB, voffB); PG8_STAGE(PG8_SA(1, 0), a3, voffA);
            PG8_WAIT_V(8); PG8_WAIT_L(0); PG8_BAR; PG8_MMA(1, 0, At, B0); PG8_MMA(1, 1, At, B1); PG8_BAR; PG8_SCHED;
        }
#ifdef PROBE_TIMING
        { const unsigned long long t = __builtin_amdgcn_s_memrealtime(); pt_k += t - pt_0; pt_0 = t; }
#endif
        if (wr == 0) PG8_BAR;
        E(acc, cur, wr, wc, fr, fq, tb);
        if (has_next && nxt.pm != cur.pm) { tb ^= 1; E.prep(nxt, tb, tid); }
#ifdef PROBE_TIMING
        { asm volatile("s_waitcnt vmcnt(0)" ::: "memory"); const unsigned long long t = __builtin_amdgcn_s_memrealtime(); pt_e += t - pt_0; ++pt_n; }
#endif
        if (!has_next) break;
        if (!Epi::keep(cur)) {
#pragma unroll
        for (int a = 0; a < 2; ++a)
#pragma unroll
            for (int b = 0; b < 2; ++b)
#pragma unroll
                for (int m = 0; m < 4; ++m)
#pragma unroll
                    for (int n = 0; n < 2; ++n) { f32x2 lo, hi; asm volatile("v_mov_b64 %0, 0" : "=v"(lo)); asm volatile("v_mov_b64 %0, 0" : "=v"(hi));
                        acc[a][b][m][n] = __builtin_shufflevector(lo, hi, 0, 1, 2, 3); }
        }
        cur = nxt; cA = nA; cB = nB; ++ui;
        if (wr == 1) PG8_BAR;
    }
    PG8_WAIT_V(0);
    PG8_BAR;
#ifdef PROBE_TIMING
    { volatile LAS unsigned* pl = (volatile LAS unsigned*)(lds + PROBE_LCTL_OFF); if (tid == 0 && pl[99]) { pl[100] = (unsigned)pt_k; pl[101] = (unsigned)pt_e; pl[102] = pt_n; } }
#endif
#undef PG8_SA
#undef PG8_SB
#undef PG8_STAGE
#undef PG8_LDA
#undef PG8_LDB
#undef PG8_MMA
#undef PG8_WAIT_V
#undef PG8_WAIT_L
#undef PG8_BAR
#undef PG8_SCHED
}
}
constexpr int NB = 16, SEQ = 2048, DM = 2048, T = NB * SEQ, NL = 4, MEML = 256, MT = NB * MEML;
constexpr int INW = 7680, GW = 6144, NCAT = INW + GW, XD = 512, DFF = 5632, YW = 3072;
constexpr int C_QA = 0, C_KA = 1024, C_VA = 1280, C_UB = 1536, C_VB = 2560, C_FC = 3584, C_IC = 4608, C_QC = 5632, C_GC = 6656;
constexpr float EPS = 1e-6f;
constexpr float LOG2E = 1.4426950408889634f;
constexpr int NWAVES = 8, NTHR = NWAVES * 64;

constexpr size_t MiB = 1u << 20;
constexpr size_t WS_CTL = 0, CTL_ZERO_BYTES = 1 * MiB;
constexpr size_t WS_WCAT = 1 * MiB;
constexpr size_t WS_WBR = WS_WCAT + 54 * MiB;
constexpr size_t WS_WOUT = WS_WBR + 12 * MiB;
constexpr size_t WS_WXQ = WS_WOUT + 8 * MiB;
constexpr size_t WS_WXO = WS_WXQ + 2 * MiB;
constexpr size_t WS_WF1 = WS_WXO + 2 * MiB;
constexpr size_t WS_WF2 = WS_WF1 + 44 * MiB;
constexpr size_t WS_WXKV = WS_WF2 + 22 * MiB;
constexpr size_t WS_MEMN = WS_WXKV + 16 * MiB;
constexpr size_t WS_KV = WS_MEMN + 16 * MiB;
constexpr size_t WS_H = WS_KV + 32 * MiB;
constexpr size_t WS_PROJ = WS_H + 128 * MiB;
constexpr size_t PJ_QKV = 0, PJ_UB = 96 * MiB, PJ_VB = 160 * MiB, PJ_HB = 224 * MiB  , PJ_STAT = 480 * MiB;
constexpr int QKVW = 1536;
constexpr size_t WS_GATE = WS_PROJ + 484 * MiB;
constexpr size_t WS_Y = WS_GATE + 384 * MiB;
constexpr size_t WS_SS = WS_Y + 192 * MiB;
constexpr size_t WS_END = WS_SS + 1 * MiB;
constexpr int CW_TMO = 0, CW_BAR = 4096, CW_Q = 8192;

constexpr int RING_BYTES = 143360;
constexpr int LDSCTL_OFF = RING_BYTES, LDS_RED = LDSCTL_OFF + 1024, LDS_RSTD = LDS_RED + 4096, LDS_BYTES = 155648;

#define RLX_AGENT __ATOMIC_RELAXED, __HIP_MEMORY_SCOPE_AGENT
#define LDS_WAIT() asm volatile("s_waitcnt lgkmcnt(0)" ::: "memory")
#define VM_WAIT() asm volatile("s_waitcnt vmcnt(0)" ::: "memory")

#define XB_TMO      128
#define XB_XCNT(j)  (256  + 64 * (j))
#define XB_XSUB(j)  (1280 + 64 * (j))
#define XB_XGEN(j)  (2304 + 64 * (j))
#define XB_TOP      3328
#define XB_TOPGEN   3392
#define XCD_BAR_WORDS 3456
#define XB_SPIN_CAP (1u << 18)
__device__ __forceinline__ unsigned xb_ld(unsigned* p)              { return __hip_atomic_load(p, __ATOMIC_RELAXED, __HIP_MEMORY_SCOPE_AGENT); }
__device__ __forceinline__ unsigned xb_add(unsigned* p, unsigned v) { return __hip_atomic_fetch_add(p, v, __ATOMIC_RELAXED, __HIP_MEMORY_SCOPE_AGENT); }
__device__ __forceinline__ unsigned xb_xcc_id() { return (unsigned)__builtin_amdgcn_s_getreg((3 << 11) | 20) & 0xFu; }
#define XB_SPIN(cond, bar) do { unsigned _sp = 0; while (cond) { __builtin_amdgcn_s_sleep(1); \
    if ((++_sp & 255u) == 0u) { if (xb_ld(&(bar)[XB_TMO])) break; if (_sp > XB_SPIN_CAP) { atomicAdd(&(bar)[XB_TMO], 1u); break; } } } } while (0)
struct XcdBarrier { unsigned* bar; unsigned x; volatile LAS unsigned* st; };
__device__ __forceinline__ XcdBarrier xcd_barrier_post(unsigned* bar, volatile LAS unsigned* st) {
    XcdBarrier b; b.bar = bar; b.x = xb_xcc_id(); b.st = st;
    if (threadIdx.x == 0) (void)xb_add(&bar[XB_XCNT(b.x)], 1u);
    return b;
}
__device__ __forceinline__ void xcd_barrier_complete(unsigned* bar, unsigned x, unsigned& nloc, unsigned& nx) {
    const unsigned G = gridDim.x * gridDim.y * gridDim.z;
    unsigned sum, cnt, mine, sp = 0u;
    for (;;) {
        sum = 0u; cnt = 0u; mine = 0u;
#pragma unroll
        for (unsigned j = 0; j < 16; ++j) { const unsigned c = xb_ld(&bar[XB_XCNT(j)]); sum += c; cnt += (c > 0u) ? 1u : 0u; mine = (j == x) ? c : mine; }
        if (sum == G) break;
        __builtin_amdgcn_s_sleep(1);
        if ((++sp & 255u) == 0u) { if (xb_ld(&bar[XB_TMO])) break; if (sp > XB_SPIN_CAP) { atomicAdd(&bar[XB_TMO], 1u); break; } }
    }
    nloc = mine > 0u ? mine : 1u; nx = cnt > 0u ? cnt : 1u;
}
__device__ __forceinline__ void xcd_barrier(const XcdBarrier& b) {
    asm volatile("s_waitcnt vmcnt(0)" ::: "memory");
    __syncthreads();
    if (threadIdx.x == 0) {
        unsigned* bar = b.bar;
        __builtin_amdgcn_s_waitcnt(0);
        unsigned nloc = b.st[0], nx = b.st[1];
        if (nloc == 0u) { xcd_barrier_complete(bar, b.x, nloc, nx); b.st[0] = nloc; b.st[1] = nx; }
        const unsigned old = xb_add(&bar[XB_XSUB(b.x)], 1u);
        const unsigned gen = old / nloc;
        if (old + 1u == (gen + 1u) * nloc) {
            __builtin_amdgcn_fence(__ATOMIC_RELEASE, "agent");
            asm volatile("s_waitcnt vmcnt(0)" ::: "memory");
            const unsigned og = xb_add(&bar[XB_TOP], 1u);
            const unsigned tg = og / nx;
            if (og + 1u == (tg + 1u) * nx) xb_add(&bar[XB_TOPGEN], 1u);
            else XB_SPIN(xb_ld(&bar[XB_TOPGEN]) == tg, bar);
            __builtin_amdgcn_fence(__ATOMIC_ACQUIRE, "agent");
            xb_add(&bar[XB_XGEN(b.x)], 1u);
            asm volatile("s_waitcnt vmcnt(0)" ::: "memory");
        } else {
            XB_SPIN(xb_ld(&bar[XB_XGEN(b.x)]) == gen, bar);
            __builtin_amdgcn_fence(__ATOMIC_ACQUIRE, "agent");
            asm volatile("s_waitcnt vmcnt(0)" ::: "memory");
        }
    }
    __syncthreads();
}

struct RowScale {
    const GAS float* ss; LAS float* tab;
    __device__ __forceinline__ void prep(const pg8::Unit& u, int buf, int tid) const {
        if (tid < 256) { const GAS f32x4* p = (const GAS f32x4*)(ss + ((size_t)u.pm * 256 + tid) * 8); const f32x4 a = p[0], b = p[1];
            tab[buf * 256 + tid] = __builtin_amdgcn_rsqf(((a.x + a.y) + (a.z + a.w) + (b.x + b.y) + (b.z + b.w)) * (1.f / DM) + EPS); }
    }
    __device__ __forceinline__ float get(int buf, int row) const { return tab[buf * 256 + row]; }
};
struct EpiCat {
    static constexpr bool PERM = true, F16 = (RES_F16 != 0); static __device__ __forceinline__ bool keep(const pg8::Unit&) { return false; }
    GAS unsigned char* pj; GAS bf16* gate; RowScale rs;
    __device__ __forceinline__ void prep(const pg8::Unit& u, int buf, int tid) const { rs.prep(u, buf, tid); }
    __device__ __forceinline__ void operator()(f32x4 (&acc)[2][2][4][2], const pg8::Unit& u, int wr, int wc, int fr, int fq, int buf) const {
        const int pn = u.pn; GAS char* base; int ldc, colt; size_t bjs = 256, rowbase = (size_t)u.pm * 256; bool isgate = false, blk = false;
        if (pn < 6) { base = (GAS char*)pj + PJ_QKV; ldc = QKVW; colt = pn * 256; blk = true; bjs = 4096; }
        else if (pn < 14) { base = (GAS char*)pj + (pn < 10 ? PJ_UB : PJ_VB); ldc = 1024; colt = ((pn - 6) & 3) * 256; blk = true; bjs = 4096; }
        else if (pn < 30) { const int seg = (pn - 14) >> 2, hp = (pn - 14) & 3, b = u.pm >> 3, t0 = (u.pm & 7) * 256;
            base = (GAS char*)pj + PJ_HB + (size_t)seg * (64 * MiB) + ((size_t)((b * 8 + 2 * hp) * SEQ + t0) * 128) * 2; ldc = 128; colt = 0; bjs = (size_t)SEQ * 128 * 2; rowbase = 0; blk = true; }
        else { base = (GAS char*)gate; ldc = GW; colt = (pn - 30) * 256; isgate = true; }
        const unsigned toff = blk ? (unsigned)((wr * 4 * (ldc >> 5) + wc) * 1024 + fr * 64 + fq * 16) : (unsigned)((wr * 64 + fr) * ldc + wc * 32 + 8 * fq) * 2u, tidoff = (unsigned)threadIdx.x * 16u;
#pragma unroll
        for (int ai = 0; ai < 2; ++ai)
#pragma unroll
            for (int m = 0; m < 4; ++m) { GAS char* ub = blk ? base + ((size_t)((rowbase >> 4) + ai * 8 + m) * (ldc >> 5) + (colt >> 5)) * 1024 : base + ((rowbase + ai * 128 + m * 16) * ldc + colt) * 2;
                float rsd = rs.get(buf, ai * 128 + wr * 64 + m * 16 + fr); if (isgate) rsd *= -LOG2E;
#pragma unroll
                for (int bj = 0; bj < 2; ++bj) { f32x4 v0 = acc[ai][bj][m][0] * rsd, v1 = acc[ai][bj][m][1] * rsd;
                    if (isgate) {
#pragma unroll
                        for (int e = 0; e < 4; ++e) { v0[e] = __builtin_amdgcn_exp2f(v0[e]); v1[e] = __builtin_amdgcn_exp2f(v1[e]); }
                        v0 = v0 + 1.0f; v1 = v1 + 1.0f; }
                    u32x4 w; w.x = cvt_pk_bf16(v0[0], v0[1]); w.y = cvt_pk_bf16(v0[2], v0[3]); w.z = cvt_pk_bf16(v1[0], v1[1]); w.w = cvt_pk_bf16(v1[2], v1[3]);
                    if (isgate) { w.x = pk_min_u16(w.x, 0x60AD60ADu); w.y = pk_min_u16(w.y, 0x60AD60ADu); w.z = pk_min_u16(w.z, 0x60AD60ADu); w.w = pk_min_u16(w.w, 0x60AD60ADu); }
                    if (isgate) __builtin_nontemporal_store(w, (GAS u32x4*)((GAS char*)gate + ((size_t)(u.pm * 24 + pn - 30) * 16 + (ai * 4 + m) * 2 + bj) * (NTHR * 16) + tidoff));
                    else __builtin_nontemporal_store(w, (GAS u32x4*)(ub + bj * bjs + toff)); } }
    }
};
template <bool SCALE> struct EpiPlain {
    static constexpr bool PERM = true, F16 = SCALE && (RES_F16 != 0);     static __device__ __forceinline__ bool keep(const pg8::Unit&) { return false; }
    GAS bf16* O; int ldc; RowScale rs;
    __device__ __forceinline__ void prep(const pg8::Unit& u, int buf, int tid) const { if (SCALE) rs.prep(u, buf, tid); }
    __device__ __forceinline__ void operator()(f32x4 (&acc)[2][2][4][2], const pg8::Unit& u, int wr, int wc, int fr, int fq, int buf) const {
        const unsigned toff = SCALE ? (unsigned)((wr * 4 * (ldc >> 5) + wc) * 1024 + fr * 64 + fq * 16) : (unsigned)((wr * 64 + fr) * ldc + wc * 32 + 8 * fq) * 2u;
#pragma unroll
        for (int ai = 0; ai < 2; ++ai)
#pragma unroll
            for (int m = 0; m < 4; ++m) { GAS char* ub = SCALE ? (GAS char*)O + ((size_t)(u.pm * 16 + ai * 8 + m) * (ldc >> 5) + u.pn * 8) * 1024 : (GAS char*)O + ((size_t)(u.pm * 256 + ai * 128 + m * 16) * ldc + u.pn * 256) * 2;
                const float rsd = SCALE ? rs.get(buf, ai * 128 + wr * 64 + m * 16 + fr) : 1.f;
#pragma unroll
                for (int bj = 0; bj < 2; ++bj) { const f32x4 v0 = acc[ai][bj][m][0] * rsd, v1 = acc[ai][bj][m][1] * rsd;
                    u32x4 w; w.x = cvt_pk_bf16(v0[0], v0[1]); w.y = cvt_pk_bf16(v0[2], v0[3]); w.z = cvt_pk_bf16(v1[0], v1[1]); w.w = cvt_pk_bf16(v1[2], v1[3]);
                    *(GAS u32x4*)(ub + bj * (SCALE ? 4096 : 256) + toff) = w; } }
    }
};
struct EpiResid {
    static constexpr bool PERM = true, F16 = false; static __device__ __forceinline__ bool keep(const pg8::Unit&) { return false; }
    const GAS unsigned short* src; GAS unsigned short* dst; GAS float* ss; LAS float* red; GAS unsigned short* xm;
    __device__ __forceinline__ void prep(const pg8::Unit&, int, int) const {}
    __device__ __forceinline__ void operator()(f32x4 (&acc)[2][2][4][2], const pg8::Unit& u, int wr, int wc, int fr, int fq, int) const {
        const unsigned toff_ = (unsigned)((wr * 4 * (DM / 32) + wc) * 1024 + fr * 64 + fq * 16);
        unsigned toff = toff_; asm volatile("" : "+v"(toff));
        u32x4 sv[2][4][2];
#pragma unroll
        for (int ai = 0; ai < 2; ++ai)
#pragma unroll
            for (int m = 0; m < 4; ++m) { const GAS char* us = (const GAS char*)(xm ? (const GAS unsigned short*)xm : src) + ((size_t)(u.pm * 16 + ai * 8 + m) * (DM / 32) + u.pn * 8 + 2) * 1024;
#pragma unroll
                for (int bj = 0; bj < 2; ++bj) sv[ai][m][bj] = *(const GAS u32x4*)(us + (bj * 4096 - 2048) + toff); }
#pragma unroll
        for (int ai = 0; ai < 2; ++ai) {
#pragma unroll
            for (int m = 0; m < 4; ++m) { const size_t uo = ((size_t)(u.pm * 16 + ai * 8 + m) * (DM / 32) + u.pn * 8 + 2) * 1024; GAS char* ud = (GAS char*)dst + uo; GAS char* um = (GAS char*)xm + uo;
                float q = 0.f;
                if (!xm) {
                    f32x2 qv = (f32x2){0.f, 0.f};
#pragma unroll
                    for (int bj = 0; bj < 2; ++bj) { const u32x4 x = sv[ai][m][bj]; const f32x4 a0 = acc[ai][bj][m][0], a1 = acc[ai][bj][m][1];
                        const f32x2 p0 = (f32x2){res_lo(x.x), res_hi(x.x)} + (f32x2){a0[0], a0[1]}, p1 = (f32x2){res_lo(x.y), res_hi(x.y)} + (f32x2){a0[2], a0[3]};
                        const f32x2 p2 = (f32x2){res_lo(x.z), res_hi(x.z)} + (f32x2){a1[0], a1[1]}, p3 = (f32x2){res_lo(x.w), res_hi(x.w)} + (f32x2){a1[2], a1[3]};
                        u32x4 w; w.x = cvt_pk_res(p0.x, p0.y); w.y = cvt_pk_res(p1.x, p1.y); w.z = cvt_pk_res(p2.x, p2.y); w.w = cvt_pk_res(p3.x, p3.y);
                        *(GAS u32x4*)(ud + (bj * 4096 - 2048) + toff) = w;
                        qv = p0 * p0 + qv; qv = p1 * p1 + qv; qv = p2 * p2 + qv; qv = p3 * p3 + qv; }
                    q = qv.x + qv.y; }
                else
#pragma unroll
                for (int bj = 0; bj < 2; ++bj) { const u32x4 x = sv[ai][m][bj]; const f32x4 a0 = acc[ai][bj][m][0], a1 = acc[ai][bj][m][1];
                    float v0, v1, v2, v3, v4, v5, v6, v7;
                    if (xm) { v0 = h_lo(x.x) + a0[0]; v1 = h_hi(x.x) + a0[1]; v2 = h_lo(x.y) + a0[2]; v3 = h_hi(x.y) + a0[3]; v4 = h_lo(x.z) + a1[0]; v5 = h_hi(x.z) + a1[1]; v6 = h_lo(x.w) + a1[2]; v7 = h_hi(x.w) + a1[3];
                        u32x4 wm; wm.x = cvt_pk_f16(v0, v1); wm.y = cvt_pk_f16(v2, v3); wm.z = cvt_pk_f16(v4, v5); wm.w = cvt_pk_f16(v6, v7); *(GAS u32x4*)(um + (bj * 4096 - 2048) + toff) = wm; }
                    else { v0 = res_lo(x.x) + a0[0]; v1 = res_hi(x.x) + a0[1]; v2 = res_lo(x.y) + a0[2]; v3 = res_hi(x.y) + a0[3]; v4 = res_lo(x.z) + a1[0]; v5 = res_hi(x.z) + a1[1]; v6 = res_lo(x.w) + a1[2]; v7 = res_hi(x.w) + a1[3]; }
                    u32x4 w; w.x = cvt_pk_res(v0, v1); w.y = cvt_pk_res(v2, v3); w.z = cvt_pk_res(v4, v5); w.w = cvt_pk_res(v6, v7);
                    *(GAS u32x4*)(ud + (bj * 4096 - 2048) + toff) = w;
                    q += ((v0 * v0 + v1 * v1) + (v2 * v2 + v3 * v3)) + ((v4 * v4 + v5 * v5) + (v6 * v6 + v7 * v7)); }
                if (ss) { q += __shfl_xor(q, 16); q += __shfl_xor(q, 32); if (fq == 0) red[wc * 256 + ai * 128 + wr * 64 + m * 16 + fr] = q; } }
            }
        if (ss) { asm volatile("s_waitcnt lgkmcnt(0)" ::: "memory"); __builtin_amdgcn_s_barrier();
            const int t = threadIdx.x; if (t < 256) ss[((size_t)u.pm * 256 + t) * 8 + u.pn] = (red[t] + red[256 + t]) + (red[512 + t] + red[768 + t]); }
    }
};
struct EpiSwiglu {
    static constexpr bool PERM = true, F16 = (RES_F16 != 0); static __device__ __forceinline__ bool keep(const pg8::Unit&) { return false; }
    GAS bf16* O; RowScale rs;
    __device__ __forceinline__ void prep(const pg8::Unit& u, int buf, int tid) const { rs.prep(u, buf, tid); }
    __device__ __forceinline__ void operator()(f32x4 (&acc)[2][2][4][2], const pg8::Unit& u, int wr, int wc, int fr, int fq, int buf) const {
        const unsigned toff = (unsigned)((wr * 4 * (DFF / 32) + wc) * 1024 + fr * 64 + fq * 16);
#pragma unroll
        for (int ai = 0; ai < 2; ++ai)
#pragma unroll
            for (int m = 0; m < 4; ++m) { GAS char* ub = (GAS char*)O + ((size_t)(u.pm * 16 + ai * 8 + m) * (DFF / 32) + u.pn * 4) * 1024;
                const float rsd = rs.get(buf, ai * 128 + wr * 64 + m * 16 + fr); const float ca = rsd * -LOG2E, ir2 = __builtin_amdgcn_rcpf(rsd * rsd);
                unsigned wq[4];
#pragma unroll
                for (int q = 0; q < 4; ++q) { const int n = q >> 1, p = (q & 1) * 2;
                    const f32x2 g = (f32x2){acc[ai][0][m][n][p], acc[ai][0][m][n][p + 1]}, uu = (f32x2){acc[ai][1][m][n][p], acc[ai][1][m][n][p + 1]};
                    const f32x2 a = g * ca; const f32x2 d = (f32x2){__builtin_amdgcn_exp2f(a.x), __builtin_amdgcn_exp2f(a.y)} * ir2 + ir2;
                    const f32x2 o = (g * uu) * (f32x2){__builtin_amdgcn_rcpf(d.x), __builtin_amdgcn_rcpf(d.y)};
                    wq[q] = cvt_pk_bf16(o.x, o.y); }
                u32x4 w; w.x = wq[0]; w.y = wq[1]; w.z = wq[2]; w.w = wq[3];
                __builtin_nontemporal_store(w, (GAS u32x4*)(ub + toff)); }
    }
};
struct EpiBranch {
    static constexpr bool PERM = true, F16 = false; static __device__ __forceinline__ bool keep(const pg8::Unit& u) { return u.aux < 2; }
    const GAS bf16* gate; GAS bf16* merged;
    __device__ __forceinline__ void prep(const pg8::Unit&, int, int) const {}
    __device__ __forceinline__ void operator()(f32x4 (&acc)[2][2][4][2], const pg8::Unit& u, int wr, int wc, int fr, int fq, int) const {
        const int j = u.aux;
        const unsigned toffg_ = (unsigned)threadIdx.x * 16u, toffm_ = (unsigned)((wr * 4 * (DM / 32) + wc) * 1024 + fr * 64 + fq * 16);
#pragma unroll
        for (int ai = 0; ai < 2; ++ai) {
            unsigned toffg = toffg_, toffm = toffm_; asm volatile("" : "+v"(toffg), "+v"(toffm));
            u32x4 gw[4][2], gn[4][2];
#pragma unroll
            for (int m = 0; m < 4; ++m) { const GAS char* ug = (const GAS char*)gate + ((size_t)(u.pm * 24 + j * 8 + u.pn) * 16 + (ai * 4 + m) * 2) * (NTHR * 16);
#pragma unroll
                for (int bj = 0; bj < 2; ++bj) { gw[m][bj] = *(const GAS u32x4*)(ug + bj * (NTHR * 16) + toffg); if (j < 2) gn[m][bj] = *(const GAS u32x4*)(ug + (size_t)8 * 16 * (NTHR * 16) + bj * (NTHR * 16) + toffg); } }
#pragma unroll
            for (int m = 0; m < 4; ++m) { GAS char* um = (GAS char*)merged + ((size_t)(u.pm * 16 + ai * 8 + m) * (DM / 32) + u.pn * 8 + 2) * 1024;
#pragma unroll
                for (int bj = 0; bj < 2; ++bj) { const u32x4 g0 = gw[m][bj];
                    float s[8] = {bf_lo(g0.x), bf_hi(g0.x), bf_lo(g0.y), bf_hi(g0.y), bf_lo(g0.z), bf_hi(g0.z), bf_lo(g0.w), bf_hi(g0.w)};
#pragma unroll
                    for (int e = 0; e < 8; ++e) s[e] = __builtin_amdgcn_rcpf(s[e]);
                    if (j < 2) { const u32x4 g1 = gn[m][bj];
                        const float d[8] = {bf_lo(g1.x), bf_hi(g1.x), bf_lo(g1.y), bf_hi(g1.y), bf_lo(g1.z), bf_hi(g1.z), bf_lo(g1.w), bf_hi(g1.w)};
#pragma unroll
                        for (int e = 0; e < 8; ++e) s[e] = s[e] * d[e]; }
                    if (j < 2) { acc[ai][bj][m][0] *= (f32x4){s[0], s[1], s[2], s[3]}; acc[ai][bj][m][1] *= (f32x4){s[4], s[5], s[6], s[7]}; }
                    else { f32x4 v0 = acc[ai][bj][m][0], v1 = acc[ai][bj][m][1];
                        v0[0] *= s[0]; v0[1] *= s[1]; v0[2] *= s[2]; v0[3] *= s[3]; v1[0] *= s[4]; v1[1] *= s[5]; v1[2] *= s[6]; v1[3] *= s[7];
                        u32x4 w; w.x = cvt_pk_bf16(v0[0], v0[1]); w.y = cvt_pk_bf16(v0[2], v0[3]); w.z = cvt_pk_bf16(v1[0], v1[1]); w.w = cvt_pk_bf16(v1[2], v1[3]);
                        *(GAS u32x4*)(um + (bj * 4096 - 2048) + toffm) = w; } } }
            asm volatile("" ::: "memory"); }
    }
};

__device__ __forceinline__ void tr_item(const GAS float* W, int N, GAS bf16* WT, int ldd, int k0, int n0, int drow0, LAS float* scr, int lane, const GAS float* gain = nullptr) {
    const float gv = gain ? gain[k0 + lane] : 1.f;
#pragma unroll 8
    for (int i = 0; i < 32; ++i) { const int kk = 2 * i + (lane >> 5); scr[kk * 33 + (lane & 31)] = W[(size_t)(k0 + kk) * N + n0 + (lane & 31)] * __shfl(gv, kk); }
    LDS_WAIT(); asm volatile("" ::: "memory");
    const int c = lane & 7;
#pragma unroll
    for (int j = 0; j < 4; ++j) { const int n = (lane >> 3) + 8 * j; const LAS float* s = scr + (8 * c) * 33 + n;
        u32x4 o;
        if (gain && RES_F16) { o.x = cvt_pk_f16(s[0 * 33], s[1 * 33]); o.y = cvt_pk_f16(s[2 * 33], s[3 * 33]); o.z = cvt_pk_f16(s[4 * 33], s[5 * 33]); o.w = cvt_pk_f16(s[6 * 33], s[7 * 33]); }
        else { o.x = cvt_pk_bf16(s[0 * 33], s[1 * 33]); o.y = cvt_pk_bf16(s[2 * 33], s[3 * 33]); o.z = cvt_pk_bf16(s[4 * 33], s[5 * 33]); o.w = cvt_pk_bf16(s[6 * 33], s[7 * 33]); }
        *(GAS u32x4*)((GAS char*)WT + pg8::blk16x32((size_t)(drow0 + n), k0 + 8 * c, ldd)) = o; }
    LDS_WAIT(); asm volatile("" ::: "memory");
}
__device__ __forceinline__ void rms_row_bf16(const GAS float* xrow, const f32x4 (&gv)[8], GAS bf16* orow, int lane) {
    const GAS f32x4* xr = (const GAS f32x4*)xrow + lane;
    f32x4 v[8]; float s = 0.f;
#pragma unroll
    for (int j = 0; j < 8; ++j) { v[j] = xr[64 * j]; s += (v[j].x * v[j].x + v[j].y * v[j].y) + (v[j].z * v[j].z + v[j].w * v[j].w); }
    const float rstd = __builtin_amdgcn_rsqf(wave_sum(s) * (1.f / DM) + EPS);
    GAS u32x2* o8 = (GAS u32x2*)orow + lane;
#pragma unroll
    for (int j = 0; j < 8; ++j) { const f32x4 y = v[j] * rstd * gv[j]; u32x2 w; w.x = cvt_pk_bf16(y.x, y.y); w.y = cvt_pk_bf16(y.z, y.w); o8[64 * j] = w; }
}
__device__ __forceinline__ void norm_phase(const GAS float* src, const GAS float* gain, GAS bf16* dst, int nrows, int gw, int NGW, int lane) {
    f32x4 gv[8];
#pragma unroll
    for (int j = 0; j < 8; ++j) gv[j] = ((const GAS f32x4*)gain)[lane + 64 * j];
    for (int m = gw; m < nrows; m += NGW) rms_row_bf16(src + (size_t)m * DM, gv, dst + (size_t)m * DM, lane);
}
__device__ __forceinline__ void xb_phase(const GAS float* src, GAS bf16* xb, GAS unsigned short* xm, GAS float* ss, int gw, int NGW, int lane) {
    for (int m = gw; m < T; m += NGW) {
        const GAS f32x4* xr = (const GAS f32x4*)(src + (size_t)m * DM) + lane; GAS char* o8 = (GAS char*)xb + (size_t)(m >> 4) * (DM / 32) * 1024 + (m & 15) * 64 + (lane >> 3) * 1024 + (lane & 7) * 8;   GAS u32x2* m8 = (GAS u32x2*)(xm + (size_t)m * DM) + lane;
        f32x4 v[8]; float q[8];
#pragma unroll
        for (int j = 0; j < 8; ++j) { v[j] = xr[64 * j]; q[j] = (v[j].x * v[j].x + v[j].y * v[j].y) + (v[j].z * v[j].z + v[j].w * v[j].w); }
#pragma unroll
        for (int j = 0; j < 8; ++j) { u32x2 w; w.x = cvt_pk_res(v[j].x, v[j].y); w.y = cvt_pk_res(v[j].z, v[j].w); *(GAS u32x2*)(o8 + j * 8192) = w;
            if (xm) { u32x2 wm; wm.x = cvt_pk_f16(v[j].x, v[j].y); wm.y = cvt_pk_f16(v[j].z, v[j].w); m8[64 * j] = wm; } }
#pragma unroll
        for (int o = 1; o < 64; o <<= 1)
#pragma unroll
            for (int j = 0; j < 8; ++j) q[j] += __shfl_xor(q[j], o);
        if (lane == 0) { GAS f32x4* sp = (GAS f32x4*)(ss + (size_t)m * 8); sp[0] = (f32x4){q[0], q[1], q[2], q[3]}; sp[1] = (f32x4){q[4], q[5], q[6], q[7]}; }
    }
}
__device__ __forceinline__ void final_norm_phase(const GAS unsigned short* xh, GAS float* out, const GAS float* gain, const GAS float* ss, int gw, int NGW, int lane) {
    f32x4 gv[8];
#pragma unroll
    for (int j = 0; j < 8; ++j) gv[j] = ((const GAS f32x4*)gain)[lane + 64 * j];
    for (int m = gw; m < T; m += NGW) {
        const GAS char* xr = (const GAS char*)xh + (size_t)(m >> 4) * (DM / 32) * 1024 + (m & 15) * 64 + (lane >> 3) * 1024 + (lane & 7) * 8; GAS f32x4* orow = (GAS f32x4*)(out + (size_t)m * DM) + lane;
        const GAS f32x4* sp = (const GAS f32x4*)(ss + (size_t)m * 8); const f32x4 a = sp[0], b = sp[1];
        const float rstd = __builtin_amdgcn_rsqf(((a.x + a.y) + (a.z + a.w) + (b.x + b.y) + (b.z + b.w)) * (1.f / DM) + EPS);
        u32x2 v[8];
#pragma unroll
        for (int j = 0; j < 8; ++j) v[j] = *(const GAS u32x2*)(xr + j * 8192);
#pragma unroll
        for (int j = 0; j < 8; ++j) orow[64 * j] = (f32x4){res_lo(v[j].x), res_hi(v[j].x), res_lo(v[j].y), res_hi(v[j].y)} * rstd * gv[j];
    }
}
typedef short s16x4 __attribute__((ext_vector_type(4)));
__device__ __forceinline__ s16x4 tr_read(const LAS unsigned char* p) { return __builtin_bit_cast(s16x4, __builtin_amdgcn_ds_read_tr16_b64_v4i16((LAS s16x4*)p)); }
template <int HD, bool SWA>
__device__ __forceinline__ void attn_wave32(const LAS unsigned char* Ks, int kstr, const LAS unsigned char* Vt, int vstr, const bf16x8 (&qf)[2][HD / 32], f32x4 (&o)[2][HD / 16],
                                            float m0, float l0, float c2, int kt_lo, int kt_hi, int t0, bool first_blk, int lane) {
    const int fr = lane & 15, g = lane >> 4;
    float mrow[2] = {m0, m0}, lrow[2] = {l0, l0};
#pragma unroll
    for (int mt = 0; mt < 2; ++mt)
#pragma unroll
        for (int dt = 0; dt < HD / 16; ++dt) o[mt][dt] = (f32x4){0.f, 0.f, 0.f, 0.f};
    for (int kt = kt_lo; kt <= kt_hi; ++kt) {
        f32x4 s[2][4];
#pragma unroll
        for (int mt = 0; mt < 2; ++mt)
#pragma unroll
            for (int nt = 0; nt < 4; ++nt) s[mt][nt] = (f32x4){0.f, 0.f, 0.f, 0.f};
#pragma unroll
        for (int nt = 0; nt < 4; ++nt)
#pragma unroll
            for (int kk = 0; kk < HD / 32; ++kk) {
                const bf16x8 kf = *(const LAS bf16x8*)(Ks + (kt * 64 + nt * 16 + fr) * kstr + (kk * 32 + g * 8) * 2);
#pragma unroll
                for (int mt = 0; mt < 2; ++mt) s[mt][nt] = __builtin_amdgcn_mfma_f32_16x16x32_bf16(kf, qf[mt][kk], s[mt][nt], 0, 0, 0);
            }
#pragma unroll
        for (int mt = 0; mt < 2; ++mt) {
            float rm = -INFINITY;
#pragma unroll
            for (int nt = 0; nt < 4; ++nt)
#pragma unroll
                for (int e = 0; e < 4; ++e) {
                    float v = s[mt][nt][e] * c2;
                    if (SWA) { const int sidx = kt * 64 + nt * 16 + g * 4 + e, t = t0 + mt * 16 + fr;
                        const bool valid = (sidx > t) && (sidx <= t + 128) && (!first_blk || sidx >= 128); v = valid ? v : -INFINITY; }
                    s[mt][nt][e] = v; rm = fmaxf(rm, v);
                }
            rm = fmaxf(rm, __shfl_xor(rm, 16)); rm = fmaxf(rm, __shfl_xor(rm, 32));
            const float mn = fmaxf(mrow[mt], rm);
            const float alpha = __builtin_amdgcn_exp2f(mrow[mt] - mn);
            float rs = 0.f;
#pragma unroll
            for (int nt = 0; nt < 4; ++nt)
#pragma unroll
                for (int e = 0; e < 4; ++e) { const float p = __builtin_amdgcn_exp2f(s[mt][nt][e] - mn); s[mt][nt][e] = p; rs += p; }
            rs += __shfl_xor(rs, 16); rs += __shfl_xor(rs, 32);
            lrow[mt] = lrow[mt] * alpha + rs; mrow[mt] = mn;
#pragma unroll
            for (int dt = 0; dt < HD / 16; ++dt) o[mt][dt] *= alpha;
        }
        bf16x8 pf[2][2];
#pragma unroll
        for (int mt = 0; mt < 2; ++mt)
#pragma unroll
            for (int k2 = 0; k2 < 2; ++k2) {
                u32x4 w; w.x = cvt_pk_bf16(s[mt][2 * k2][0], s[mt][2 * k2][1]); w.y = cvt_pk_bf16(s[mt][2 * k2][2], s[mt][2 * k2][3]);
                w.z = cvt_pk_bf16(s[mt][2 * k2 + 1][0], s[mt][2 * k2 + 1][1]); w.w = cvt_pk_bf16(s[mt][2 * k2 + 1][2], s[mt][2 * k2 + 1][3]);
                pf[mt][k2] = __builtin_bit_cast(bf16x8, w);
            }
#pragma unroll
        for (int dt = 0; dt < HD / 16; ++dt)
#pragma unroll
            for (int k2 = 0; k2 < 2; ++k2) {
                const LAS unsigned char* vblk = Vt + (kt * 64 + k2 * 32 + g * 4 + (fr >> 2)) * vstr + (dt * 16 + (fr & 3) * 4) * 2;
                const s16x4 lo = tr_read(vblk), hi = tr_read(vblk + 16 * vstr);
                const bf16x8 vf = __builtin_shufflevector(lo, hi, 0, 1, 2, 3, 4, 5, 6, 7);
#pragma unroll
                for (int mt = 0; mt < 2; ++mt) o[mt][dt] = __builtin_amdgcn_mfma_f32_16x16x32_bf16(vf, pf[mt][k2], o[mt][dt], 0, 0, 0);
            }
    }
#pragma unroll
    for (int mt = 0; mt < 2; ++mt) { const float inv = 1.0f / lrow[mt];
#pragma unroll
        for (int dt = 0; dt < HD / 16; ++dt) o[mt][dt] *= inv; }
}

__device__ __forceinline__ void vt_scatter(LAS unsigned char* Vt, int vstr, int d0, int key, u32x4 v) {
    LAS unsigned char* p = Vt + d0 * vstr + key * 2;
    *(LAS bf16*)(p + 0 * vstr) = (bf16)(v.x & 0xffffu); *(LAS bf16*)(p + 1 * vstr) = (bf16)(v.x >> 16);
    *(LAS bf16*)(p + 2 * vstr) = (bf16)(v.y & 0xffffu); *(LAS bf16*)(p + 3 * vstr) = (bf16)(v.y >> 16);
    *(LAS bf16*)(p + 4 * vstr) = (bf16)(v.z & 0xffffu); *(LAS bf16*)(p + 5 * vstr) = (bf16)(v.z >> 16);
    *(LAS bf16*)(p + 6 * vstr) = (bf16)(v.w & 0xffffu); *(LAS bf16*)(p + 7 * vstr) = (bf16)(v.w >> 16);
}

__device__ __forceinline__ void swa_loop(unsigned* qctr, volatile LAS unsigned* lctl, const GAS bf16* proj, const GAS float* sinks_l, GAS bf16* Y, LAS unsigned char* lds, int tid) {
    const int lane = tid & 63, w = __builtin_amdgcn_readfirstlane(tid >> 6), fr = lane & 15, g = lane >> 4;
    constexpr int KSTR = 144, VSTR = 160, NU = NB * 64;
    LAS unsigned char* Ks = lds; LAS unsigned char* Vt = lds + 256 * KSTR;
    u32x4 kr[4], vr[4];
    unsigned kvoff = (unsigned)((((tid >> 7) * 48 + ((tid & 7) >> 2)) << 10) + ((tid >> 3) & 15) * 64 + (tid & 3) * 16); asm volatile("" : "+v"(kvoff));
#define SWA_LOADKV(unit) do { const int b_ = (unit) >> 6, kvh_ = ((unit) >> 4) & 3, blk_ = (unit) & 15; _Pragma("unroll") for (int i = 0; i < 4; ++i) { \
        const int rb_ = (blk_ == 0) ? b_ * 128 + 4 * (i & 1) : b_ * 128 + (blk_ - 1) * 8 + 4 * i;     \
        const GAS char* src = (const GAS char*)proj + ((size_t)rb_ * 48 + (C_KA >> 5) + kvh_ * 2) * 1024 + kvoff; \
        kr[i] = *(const GAS u32x4*)src; vr[i] = *(const GAS u32x4*)(src + ((C_VA - C_KA) >> 5) * 1024); } } while (0)
    unsigned pend = 0u;
    __syncthreads();
    if (tid == 0) { lctl[4] = xb_add(qctr, 1u); lctl[5] = xb_add(qctr, 1u); pend = xb_add(qctr, 1u); }
    __syncthreads();
    int idx = (int)lctl[4], nidx = (int)lctl[5];
    if (idx < NU) SWA_LOADKV(idx);
    int par = 0;
    while (idx < NU) {
        const int b = idx >> 6, kvh = (idx >> 4) & 3, blk = idx & 15;
        __syncthreads();
#pragma unroll
        for (int i = 0; i < 4; ++i) { const int c = tid + NTHR * i, key = c >> 3, part = c & 7; *(LAS u32x4*)(Ks + key * KSTR + part * 16) = kr[i]; *(LAS u32x4*)(Vt + key * VSTR + part * 16) = vr[i]; }
        if (tid == 0) { lctl[6 + par] = pend; pend = xb_add(qctr, 1u); }
        __syncthreads();
        const int nnidx = (int)lctl[6 + par]; par ^= 1;
        const int head = kvh * 4 + (w >> 1), half = w & 1;
        const float sink2 = sinks_l[head] * LOG2E;
        bf16x8 qf[2][2][2]; unsigned qoff = (unsigned)(fr * 64 + g * 16); asm volatile("" : "+v"(qoff));
#pragma unroll
        for (int pass = 0; pass < 2; ++pass)
#pragma unroll
            for (int mt = 0; mt < 2; ++mt)
#pragma unroll
                for (int kk = 0; kk < 2; ++kk) qf[pass][mt][kk] = *(const GAS bf16x8*)((const GAS char*)proj + ((size_t)(b * 128 + blk * 8 + half * 4 + pass * 2 + mt) * 48 + head * 2 + kk) * 1024 + qoff);
        if (nidx < NU) SWA_LOADKV(nidx);
#pragma unroll
        for (int pass = 0; pass < 2; ++pass) {
            const int t0 = half * 64 + pass * 32;
            int kt_lo = (t0 + 1) >> 6; const int kt_hi = (t0 + 159) >> 6; if (blk == 0 && kt_lo < 2) kt_lo = 2;
            f32x4 o[2][4];
            attn_wave32<64, true>(Ks, KSTR, Vt, VSTR, qf[pass], o, sink2, 1.0f, 0.125f * LOG2E, kt_lo, kt_hi, t0, blk == 0, lane);
#pragma unroll
            for (int mt = 0; mt < 2; ++mt)
#pragma unroll
                for (int dt = 0; dt < 4; ++dt) { u32x2 wv; wv.x = cvt_pk_bf16(o[mt][dt][0], o[mt][dt][1]); wv.y = cvt_pk_bf16(o[mt][dt][2], o[mt][dt][3]);
                    *(GAS u32x2*)((GAS char*)Y + pg8::blk16x32((size_t)(b * SEQ + blk * 128 + t0 + mt * 16 + fr), head * 64 + dt * 16 + g * 4, YW)) = wv; }
        }
        idx = nidx; nidx = nnidx;
    }
    __syncthreads();
#undef SWA_LOADKV
}

__device__ __forceinline__ void xattn_unit(int unit, int l, const GAS bf16* KV, const GAS bf16* XQ, GAS bf16* XO, LAS unsigned char* lds, int tid, bool stage) {
    const int b = unit >> 5, head = (unit >> 3) & 3, qb = unit & 7;
    const int lane = tid & 63, w = __builtin_amdgcn_readfirstlane(tid >> 6), fr = lane & 15, g = lane >> 4;
    constexpr int KSTR = 272, VSTR = 288;
    LAS unsigned char* Ks = lds; LAS unsigned char* Vt = lds + 256 * KSTR;
    const size_t row0 = (size_t)b * SEQ + qb * 256 + w * 32;
    bf16x8 qf[2][4]; unsigned xoff = (unsigned)(fr * 64 + g * 16), yoff = (unsigned)(fr * 64 + g * 8); asm volatile("" : "+v"(xoff), "+v"(yoff));
#pragma unroll
    for (int mt = 0; mt < 2; ++mt)
#pragma unroll
        for (int kk = 0; kk < 4; ++kk) qf[mt][kk] = *(const GAS bf16x8*)((const GAS char*)XQ + (((row0 >> 4) + mt) * 16 + head * 4 + kk) * 1024 + xoff);
    if (stage) {
        __syncthreads();
#pragma unroll
        for (int i = 0; i < 8; ++i) { const int c = tid + NTHR * i, key = c >> 4, part = c & 15;
            const GAS bf16* src = KV + (size_t)(b * MEML + key) * 4096 + l * 1024 + head * 128 + part * 8;
            const u32x4 kv = *(const GAS u32x4*)src; const u32x4 vv = *(const GAS u32x4*)(src + 512);
            *(LAS u32x4*)(Ks + key * KSTR + part * 16) = kv; *(LAS u32x4*)(Vt + key * VSTR + part * 16) = vv; }
        __syncthreads();
    }
    f32x4 o[2][8];
    attn_wave32<128, false>(Ks, KSTR, Vt, VSTR, qf, o, -INFINITY, 0.0f, 0.08838834764831845f * LOG2E, 0, 3, 0, false, lane);
#pragma unroll
    for (int mt = 0; mt < 2; ++mt)
#pragma unroll
        for (int dt = 0; dt < 8; ++dt) { u32x2 wv; wv.x = cvt_pk_bf16(o[mt][dt][0], o[mt][dt][1]); wv.y = cvt_pk_bf16(o[mt][dt][2], o[mt][dt][3]);
            *(GAS u32x2*)((GAS char*)XO + (((row0 >> 4) + mt) * 16 + head * 4 + (dt >> 1)) * 1024 + (dt & 1) * 32 + yoff) = wv; }
}

__device__ __forceinline__ void sgu_unit(int unit, const GAS bf16* ubuf, const GAS bf16* vbuf, const GAS float* ln_g, const GAS float* ln_b, const GAS float* sw, const GAS float* sb, GAS bf16* Y, LAS unsigned char* lds, int tid) {
    const int b = unit >> 4, c = unit & 15;
    const int lane = tid & 63, w = __builtin_amdgcn_readfirstlane(tid >> 6), fr = lane & 15, g = lane >> 4;
    constexpr int VSTR = 288, WSTR = 272;
    LAS unsigned char* VN = lds; LAS unsigned char* Ws = lds + 128 * VSTR; LAS float* stat = (LAS float*)(lds + 128 * VSTR + 128 * WSTR);
    const size_t tok0 = (size_t)b * SEQ + c * 128;
    u32x4 va[4]; f32x4 wv[8]; u32x2 uu[8];
    unsigned vaoff = (unsigned)((((tid >> 8) * 32 + ((tid & 15) >> 2)) << 10) + ((tid >> 4) & 15) * 64 + (tid & 3) * 16), uuoff = (unsigned)(w * 32768 + fr * 64 + g * 8), stoff = (unsigned)(w * 32768 + (lane >> 1) * 1024 + (lane & 1) * 32);
    asm volatile("" : "+v"(vaoff), "+v"(uuoff), "+v"(stoff));
#define SGU_LOAD(gg) do { _Pragma("unroll") for (int i = 0; i < 4; ++i) { const int cc = tid + NTHR * i, s = cc >> 4, part = cc & 15; (void)s; (void)part; va[i] = *(const GAS u32x4*)((const GAS char*)vbuf + (((tok0 >> 4) + 2 * i) * 32 + (gg) * 4) * 1024 + vaoff); }     \
        _Pragma("unroll") for (int i = 0; i < 8; ++i) { const int idx = tid + NTHR * i; wv[i] = *(const GAS f32x4*)(sw + (size_t)(gg) * 16384 + idx * 4); } \
        _Pragma("unroll") for (int et = 0; et < 8; ++et) uu[et] = *(const GAS u32x2*)((const GAS char*)ubuf + ((tok0 >> 4) * 32 + (gg) * 4) * 1024 + uuoff + ((et >> 1) * 1024 + (et & 1) * 32)); } while (0)
    SGU_LOAD(0);
    __syncthreads();
    for (int bt = 0; bt < 2; ++bt) {
        u32x4 a0[8], a1[8];
#pragma unroll
        for (int i = 0; i < 8; ++i) { const GAS char* src = (const GAS char*)vbuf + (tok0 >> 4) * 32768 + stoff + (bt * 8 + i) * 64; a0[i] = *(const GAS u32x4*)src; a1[i] = *(const GAS u32x4*)(src + 16); }
        float s1[8], s2[8];
#pragma unroll
        for (int i = 0; i < 8; ++i) { float x[16];
            x[0] = geluf_(bf_lo(a0[i].x)); x[1] = geluf_(bf_hi(a0[i].x)); x[2] = geluf_(bf_lo(a0[i].y)); x[3] = geluf_(bf_hi(a0[i].y));
            x[4] = geluf_(bf_lo(a0[i].z)); x[5] = geluf_(bf_hi(a0[i].z)); x[6] = geluf_(bf_lo(a0[i].w)); x[7] = geluf_(bf_hi(a0[i].w));
            x[8] = geluf_(bf_lo(a1[i].x)); x[9] = geluf_(bf_hi(a1[i].x)); x[10] = geluf_(bf_lo(a1[i].y)); x[11] = geluf_(bf_hi(a1[i].y));
            x[12] = geluf_(bf_lo(a1[i].z)); x[13] = geluf_(bf_hi(a1[i].z)); x[14] = geluf_(bf_lo(a1[i].w)); x[15] = geluf_(bf_hi(a1[i].w));
            float p1 = 0.f, p2 = 0.f;
#pragma unroll
            for (int e = 0; e < 16; ++e) { p1 += x[e]; p2 += x[e] * x[e]; }
            s1[i] = p1; s2[i] = p2; }
#pragma unroll
        for (int o = 1; o < 64; o <<= 1)
#pragma unroll
            for (int i = 0; i < 8; ++i) { s1[i] += __shfl_xor(s1[i], o); s2[i] += __shfl_xor(s2[i], o); }
        if (lane < 8) { float m1 = s1[0], m2 = s2[0];
#pragma unroll
            for (int i = 1; i < 8; ++i) { m1 = (lane == i) ? s1[i] : m1; m2 = (lane == i) ? s2[i] : m2; }
            const float mean = m1 * (1.f / 1024.f); const float var = fmaxf(m2 * (1.f / 1024.f) - mean * mean, 0.f);
            const int s = w * 16 + bt * 8 + lane; stat[2 * s] = mean; stat[2 * s + 1] = __builtin_amdgcn_rsqf(var + EPS); }
    }
    __syncthreads();
    for (int grp = 0; grp < 8; ++grp) {
#pragma unroll
        for (int i = 0; i < 4; ++i) { const int cc = tid + NTHR * i, s = cc >> 4, part = cc & 15; const int ch = grp * 128 + part * 8;
            const f32x4 g0 = *(const GAS f32x4*)(ln_g + ch), g1 = *(const GAS f32x4*)(ln_g + ch + 4), b0 = *(const GAS f32x4*)(ln_b + ch), b1 = *(const GAS f32x4*)(ln_b + ch + 4);
            const float mean = stat[2 * s], rstd = stat[2 * s + 1]; const u32x4 a0 = va[i];
            float y[8];
            y[0] = (geluf_(bf_lo(a0.x)) - mean) * rstd * g0.x + b0.x; y[1] = (geluf_(bf_hi(a0.x)) - mean) * rstd * g0.y + b0.y;
            y[2] = (geluf_(bf_lo(a0.y)) - mean) * rstd * g0.z + b0.z; y[3] = (geluf_(bf_hi(a0.y)) - mean) * rstd * g0.w + b0.w;
            y[4] = (geluf_(bf_lo(a0.z)) - mean) * rstd * g1.x + b1.x; y[5] = (geluf_(bf_hi(a0.z)) - mean) * rstd * g1.y + b1.y;
            y[6] = (geluf_(bf_lo(a0.w)) - mean) * rstd * g1.z + b1.z; y[7] = (geluf_(bf_hi(a0.w)) - mean) * rstd * g1.w + b1.w;
            u32x4 pk; pk.x = cvt_pk_bf16(y[0], y[1]); pk.y = cvt_pk_bf16(y[2], y[3]); pk.z = cvt_pk_bf16(y[4], y[5]); pk.w = cvt_pk_bf16(y[6], y[7]);
            *(LAS u32x4*)(VN + s * VSTR + part * 16) = pk; }
#pragma unroll
        for (int i = 0; i < 8; ++i) { const int idx = tid + NTHR * i, t = idx >> 5, s4 = (idx & 31) * 4; f32x4 x = wv[i];
            x.x = (s4 + 0 <= t) ? x.x : 0.f; x.y = (s4 + 1 <= t) ? x.y : 0.f; x.z = (s4 + 2 <= t) ? x.z : 0.f; x.w = (s4 + 3 <= t) ? x.w : 0.f;
            u32x2 pk; pk.x = cvt_pk_bf16(x.x, x.y); pk.y = cvt_pk_bf16(x.z, x.w);
            *(LAS u32x2*)(Ws + t * WSTR + s4 * 2) = pk; }
        u32x2 uc[8];
#pragma unroll
        for (int et = 0; et < 8; ++et) uc[et] = uu[et];
        __syncthreads();
        if (grp + 1 < 8) SGU_LOAD(grp + 1);
        f32x4 acc[8];
#pragma unroll
        for (int et = 0; et < 8; ++et) acc[et] = (f32x4){0.f, 0.f, 0.f, 0.f};
        const int nkk = ((w * 16 + 15) >> 5) + 1;
        for (int kk = 0; kk < nkk; ++kk) {
            const LAS unsigned char* wrow = Ws + (w * 16 + fr) * WSTR + (kk * 32 + g * 4) * 2;
            const u32x2 ylo = *(const LAS u32x2*)wrow, yhi = *(const LAS u32x2*)(wrow + 32);
            u32x4 yw; yw.x = ylo.x; yw.y = ylo.y; yw.z = yhi.x; yw.w = yhi.y; const bf16x8 yf = __builtin_bit_cast(bf16x8, yw);
#pragma unroll
            for (int et = 0; et < 8; ++et) { const LAS unsigned char* vblk = VN + (kk * 32 + g * 4 + (fr >> 2)) * VSTR + (et * 16 + (fr & 3) * 4) * 2;
                const s16x4 lo = tr_read(vblk), hi = tr_read(vblk + 16 * VSTR);
                acc[et] = __builtin_amdgcn_mfma_f32_16x16x32_bf16(__builtin_shufflevector(lo, hi, 0, 1, 2, 3, 4, 5, 6, 7), yf, acc[et], 0, 0, 0); }
        }
        const int t = w * 16 + fr; const float bias = sb[grp * 128 + t];
#pragma unroll
        for (int et = 0; et < 8; ++et) { const int ch = grp * 128 + et * 16 + g * 4; const u32x2 u2 = uc[et];
            const float o0 = geluf_(bf_lo(u2.x)) * (acc[et][0] + bias), o1 = geluf_(bf_hi(u2.x)) * (acc[et][1] + bias), o2 = geluf_(bf_lo(u2.y)) * (acc[et][2] + bias), o3 = geluf_(bf_hi(u2.y)) * (acc[et][3] + bias);
            u32x2 wo; wo.x = cvt_pk_bf16(o0, o1); wo.y = cvt_pk_bf16(o2, o3);
            *(GAS u32x2*)((GAS char*)Y + pg8::blk16x32((size_t)(tok0 + t), 1024 + ch, YW)) = wo; }
        __syncthreads();
    }
#undef SGU_LOAD
}

__device__ __forceinline__ void hgrn_unit(int unit, int l, const GAS bf16* hb, const GAS float* hgrn_lb, const GAS float* norm_g, GAS bf16* Y, LAS unsigned char* lds, int tid) {
    const int b = unit >> 3, h = unit & 7;
    const int lane = tid & 63, w = __builtin_amdgcn_readfirstlane(tid >> 6), fr = lane & 15, g = lane >> 4;
    const int d = tid & 127, J = tid >> 7, Ju = w >> 1;
    constexpr int US = 160, WS = 352, TS = 144;
    LAS unsigned char* U = lds; LAS unsigned char* Qe = lds + 20480; LAS unsigned char* Wm = lds + 40960; LAS unsigned char* KeT = lds + 86016; LAS unsigned char* VT = lds + 104448;
    LAS unsigned char* Am = lds + 122880; LAS float* Gs = (LAS float*)(lds + 132096); LAS float* DEC = (LAS float*)(lds + 134144); LAS float* SS = (LAS float*)(lds + 134656);
    const int ch = h * 128 + d;
    float lb;
    { const float v0 = hgrn_lb[ch], v1 = hgrn_lb[1024 + ch], v2 = hgrn_lb[2048 + ch], v3 = hgrn_lb[3072 + ch];
      const float mx = fmaxf(fmaxf(v0, v1), fmaxf(v2, v3));
      const float e0 = __expf(v0 - mx), e1 = __expf(v1 - mx), e2 = __expf(v2 - mx), e3 = __expf(v3 - mx); const float inv = 1.0f / (e0 + e1 + e2 + e3);
      lb = (l >= 1 ? e1 * inv : 0.f) + (l >= 2 ? e2 * inv : 0.f) + (l >= 3 ? e3 * inv : 0.f); }
    __syncthreads();
    for (int i = tid; i < 9216 / 4; i += NTHR) ((LAS unsigned*)Am)[i] = 0u;
    f32x4 st[8];
#pragma unroll
    for (int dt = 0; dt < 8; ++dt) st[dt] = (f32x4){0.f, 0.f, 0.f, 0.f};
    const int base_J = (J == 0) ? 0 : (J == 1) ? 16 : (J == 2) ? 48 : 96;
    constexpr size_t HBS = (size_t)32 << 20;
    const GAS bf16* pb = hb + (size_t)((b * 8 + h) * SEQ) * 128;
    const f32x4 ngv = *(const GAS f32x4*)(norm_g + w * 16 + g * 4);
    unsigned fraw[16], qraw[16], iraw[16];
#define HG_LOAD(cc) do { const GAS bf16* cb_ = pb + (size_t)(((cc) * 4 + Ju) * 4 + (w & 1) * 2) * 512 + hgoff;     \
        _Pragma("unroll") for (int tt = 0; tt < 16; ++tt) { fraw[tt] = cb_[tt * 32]; iraw[tt] = cb_[HBS + tt * 32]; qraw[tt] = cb_[2 * HBS + tt * 32]; } } while (0)
    unsigned hgoff = (unsigned)((lane >> 5) * 512 + (lane & 31)); asm volatile("" : "+v"(hgoff));
    HG_LOAD(0);
    for (int c = 0; c < 32; ++c) {
        const int tok0 = c * 64;
        u32x2 ggv[4];
#pragma unroll
        for (int tt = 0; tt < 4; ++tt) ggv[tt] = *(const GAS u32x2*)(pb + 3 * HBS + (size_t)((c * 4 + tt) * 4 + (w >> 1)) * 512 + (fr * 32 + (w & 1) * 16 + g * 4));
        float f[16], qs[16]; unsigned vraw[8];
        {
            float gp = 1.f;
#pragma unroll
            for (int tt = 0; tt < 16; ++tt) {
                const float fl = __builtin_bit_cast(float, fraw[tt] << 16), qv = __builtin_bit_cast(float, qraw[tt] << 16); const unsigned iv = iraw[tt];
                f[tt] = lb + (1.f - lb) * sigmoidf_(fl); qs[tt] = siluf_(qv) * 0.08838834764831845f; gp *= f[tt];
                if (tt & 1) vraw[tt >> 1] |= iv << 16; else vraw[tt >> 1] = iv; }
            Gs[J * 128 + d] = gp;
        }
        __syncthreads();
        {
            const float G0 = Gs[d], G1 = Gs[128 + d], G2 = Gs[256 + d], G3 = Gs[384 + d];
            const float EJ = (J == 0) ? 1.f : (J == 1) ? G0 : (J == 2) ? G0 * G1 : G0 * G1 * G2;
            const float TJ = (J == 0) ? G1 * G2 * G3 : (J == 1) ? G2 * G3 : (J == 2) ? G3 : 1.f;
            if (J == 0) DEC[d] = G0 * G1 * G2 * G3;
            *(LAS u32x4*)(VT + d * TS + J * 32) = (u32x4){vraw[0], vraw[1], vraw[2], vraw[3]};
            *(LAS u32x4*)(VT + d * TS + J * 32 + 16) = (u32x4){vraw[4], vraw[5], vraw[6], vraw[7]};
            float p = 1.f; unsigned up[8], qp[8], wd[8];
#pragma unroll
            for (int t2 = 0; t2 < 8; ++t2) { float u0, u1, k0, k1;
                p *= f[2 * t2]; u0 = qs[2 * t2] * p; k0 = (1.f - f[2 * t2]) * __builtin_amdgcn_rcpf(fmaxf(p, 1e-30f));
                p *= f[2 * t2 + 1]; u1 = qs[2 * t2 + 1] * p; k1 = (1.f - f[2 * t2 + 1]) * __builtin_amdgcn_rcpf(fmaxf(p, 1e-30f));
                up[t2] = cvt_pk_bf16(u0, u1); qp[t2] = cvt_pk_bf16(u0 * EJ, u1 * EJ); wd[t2] = cvt_pk_bf16(k0, k1); }
            { LAS unsigned char* pu = U + d * US + J * 32; *(LAS u32x4*)pu = (u32x4){up[0], up[1], up[2], up[3]}; *(LAS u32x4*)(pu + 16) = (u32x4){up[4], up[5], up[6], up[7]};
              LAS unsigned char* pq = Qe + d * US + J * 32; *(LAS u32x4*)pq = (u32x4){qp[0], qp[1], qp[2], qp[3]}; *(LAS u32x4*)(pq + 16) = (u32x4){qp[4], qp[5], qp[6], qp[7]};
              LAS unsigned char* pw = Wm + d * WS + (base_J + 16 * J) * 2; *(LAS u32x4*)pw = (u32x4){wd[0], wd[1], wd[2], wd[3]}; *(LAS u32x4*)(pw + 16) = (u32x4){wd[4], wd[5], wd[6], wd[7]}; }
            float sfx = 1.f, ksv[16];
#pragma unroll
            for (int tt = 15; tt >= 0; --tt) { ksv[tt] = (1.f - f[tt]) * sfx; sfx *= f[tt]; }
            unsigned kep[8];
#pragma unroll
            for (int t2 = 0; t2 < 8; ++t2) kep[t2] = cvt_pk_bf16(ksv[2 * t2] * TJ, ksv[2 * t2 + 1] * TJ);
            *(LAS u32x4*)(KeT + d * TS + J * 32) = (u32x4){kep[0], kep[1], kep[2], kep[3]};
            *(LAS u32x4*)(KeT + d * TS + J * 32 + 16) = (u32x4){kep[4], kep[5], kep[6], kep[7]};
            if (J < 3) {
                const float m1 = (J == 0) ? G1 : G2, m2 = G1 * G2;
                unsigned w0[8], w1[8], w2[8];
#pragma unroll
                for (int t2 = 0; t2 < 8; ++t2) { w0[t2] = cvt_pk_bf16(ksv[2 * t2], ksv[2 * t2 + 1]); w1[t2] = cvt_pk_bf16(ksv[2 * t2] * m1, ksv[2 * t2 + 1] * m1); w2[t2] = cvt_pk_bf16(ksv[2 * t2] * m2, ksv[2 * t2 + 1] * m2); }
                const int s1 = (J == 0) ? 16 : (J == 1) ? 48 : 96;
                LAS unsigned char* p1 = Wm + d * WS + (s1 + 16 * J) * 2; *(LAS u32x4*)p1 = (u32x4){w0[0], w0[1], w0[2], w0[3]}; *(LAS u32x4*)(p1 + 16) = (u32x4){w0[4], w0[5], w0[6], w0[7]};
                if (J < 2) { const int s2 = (J == 0) ? 48 : 96; LAS unsigned char* p2 = Wm + d * WS + (s2 + 16 * J) * 2; *(LAS u32x4*)p2 = (u32x4){w1[0], w1[1], w1[2], w1[3]}; *(LAS u32x4*)(p2 + 16) = (u32x4){w1[4], w1[5], w1[6], w1[7]}; }
                if (J == 0) { LAS unsigned char* p3 = Wm + d * WS + 96 * 2; *(LAS u32x4*)p3 = (u32x4){w2[0], w2[1], w2[2], w2[3]}; *(LAS u32x4*)(p3 + 16) = (u32x4){w2[4], w2[5], w2[6], w2[7]}; }
            }
        }
        __syncthreads();
        if (c + 1 < 32) HG_LOAD(c + 1);
        __builtin_amdgcn_sched_barrier(0);
        for (int ti = w; ti < 10; ti += 8) {
            const int I = (ti == 0) ? 0 : (ti < 3) ? 1 : (ti < 6) ? 2 : 3; const int Jt = ti - ((I * (I + 1)) >> 1);
            const int bI = (I == 0) ? 0 : (I == 1) ? 16 : (I == 2) ? 48 : 96;
            f32x4 a = (f32x4){0.f, 0.f, 0.f, 0.f};
#pragma unroll
            for (int kk = 0; kk < 4; ++kk) { const LAS unsigned char* wb = Wm + (kk * 32 + g * 4 + (fr >> 2)) * WS + (bI + 16 * Jt + (fr & 3) * 4) * 2;
                const LAS unsigned char* ub = U + (kk * 32 + g * 4 + (fr >> 2)) * US + (16 * I + (fr & 3) * 4) * 2;
                const s16x4 xl = tr_read(wb), xh = tr_read(wb + 16 * WS), yl = tr_read(ub), yh = tr_read(ub + 16 * US);
                a = __builtin_amdgcn_mfma_f32_16x16x32_bf16(__builtin_shufflevector(xl, xh, 0, 1, 2, 3, 4, 5, 6, 7), __builtin_shufflevector(yl, yh, 0, 1, 2, 3, 4, 5, 6, 7), a, 0, 0, 0); }
            if (Jt == I) {
#pragma unroll
                for (int e = 0; e < 4; ++e) a[e] = (4 * g + e > fr) ? 0.f : a[e]; }
            u32x2 pk; pk.x = cvt_pk_bf16(a[0], a[1]); pk.y = cvt_pk_bf16(a[2], a[3]);
            *(LAS u32x2*)(Am + (16 * I + fr) * TS + (16 * Jt + 4 * g) * 2) = pk;
        }
        f32x4 o[4];
#pragma unroll
        for (int tt = 0; tt < 4; ++tt) o[tt] = (f32x4){0.f, 0.f, 0.f, 0.f};
#pragma unroll
        for (int kk = 0; kk < 4; ++kk) {
            u32x4 sw; sw.x = cvt_pk_bf16(st[2 * kk][0], st[2 * kk][1]); sw.y = cvt_pk_bf16(st[2 * kk][2], st[2 * kk][3]);
            sw.z = cvt_pk_bf16(st[2 * kk + 1][0], st[2 * kk + 1][1]); sw.w = cvt_pk_bf16(st[2 * kk + 1][2], st[2 * kk + 1][3]);
            const bf16x8 sx = __builtin_bit_cast(bf16x8, sw);
#pragma unroll
            for (int tt = 0; tt < 4; ++tt) { const LAS unsigned char* qb = Qe + (kk * 32 + g * 4 + (fr >> 2)) * US + (16 * tt + (fr & 3) * 4) * 2;
                const s16x4 lo = tr_read(qb), hi = tr_read(qb + 16 * US);
                o[tt] = __builtin_amdgcn_mfma_f32_16x16x32_bf16(sx, __builtin_shufflevector(lo, hi, 0, 1, 2, 3, 4, 5, 6, 7), o[tt], 0, 0, 0); }
        }
        __syncthreads();
        bf16x8 vfr[2];
#pragma unroll
        for (int kk = 0; kk < 2; ++kk) vfr[kk] = *(const LAS bf16x8*)(VT + (16 * w + fr) * TS + (kk * 32 + g * 8) * 2);
#pragma unroll
        for (int tt = 0; tt < 4; ++tt)
#pragma unroll
            for (int kk = 0; kk < 2; ++kk) if (kk <= (tt >> 1)) {
                const bf16x8 yf = *(const LAS bf16x8*)(Am + (16 * tt + fr) * TS + (kk * 32 + g * 8) * 2);
                o[tt] = __builtin_amdgcn_mfma_f32_16x16x32_bf16(vfr[kk], yf, o[tt], 0, 0, 0); }
#pragma unroll
        for (int dt = 0; dt < 8; ++dt) { const f32x4 dec = *(const LAS f32x4*)(DEC + 16 * dt + 4 * g); st[dt] *= dec;
#pragma unroll
            for (int kk = 0; kk < 2; ++kk) { const bf16x8 xf = *(const LAS bf16x8*)(KeT + (16 * dt + fr) * TS + (kk * 32 + g * 8) * 2);
                st[dt] = __builtin_amdgcn_mfma_f32_16x16x32_bf16(xf, vfr[kk], st[dt], 0, 0, 0); } }
#pragma unroll
        for (int tt = 0; tt < 4; ++tt) { float q2 = o[tt][0] * o[tt][0] + o[tt][1] * o[tt][1] + o[tt][2] * o[tt][2] + o[tt][3] * o[tt][3];
            q2 += __shfl_xor(q2, 16); q2 += __shfl_xor(q2, 32);
            if (g == 0) SS[w * 64 + 16 * tt + fr] = q2; }
        __syncthreads();
#pragma unroll
        for (int tt = 0; tt < 4; ++tt) { const int t = 16 * tt + fr; float tot = 0.f;
#pragma unroll
            for (int ww = 0; ww < 8; ++ww) tot += SS[ww * 64 + t];
            const float rstd = __builtin_amdgcn_rsqf(tot * (1.f / 128.f) + EPS);
            const size_t tok = (size_t)b * SEQ + tok0 + t; const int e0 = h * 128 + w * 16 + g * 4;
            const u32x2 gg = ggv[tt];
            const float y0 = o[tt][0] * rstd * ngv.x * siluf_(bf_lo(gg.x)), y1 = o[tt][1] * rstd * ngv.y * siluf_(bf_hi(gg.x));
            const float y2 = o[tt][2] * rstd * ngv.z * siluf_(bf_lo(gg.y)), y3 = o[tt][3] * rstd * ngv.w * siluf_(bf_hi(gg.y));
            u32x2 wv; wv.x = cvt_pk_bf16(y0, y1); wv.y = cvt_pk_bf16(y2, y3);
            *(GAS u32x2*)((GAS char*)Y + pg8::blk16x32(tok, 2048 + e0, YW)) = wv; }
    }
#undef HG_LOAD
}
#ifndef MK_MULTI
#define MK_MULTI 0
#endif
#ifndef PH_MASK
#define PH_MASK 0xFFFFF
#endif
#define HASP(p) (((PH_MASK) >> (p)) & 1)
#ifndef RES_MASTER_HALF
#define RES_MASTER_HALF 0
#endif
#ifndef DUP_MASK
#define DUP_MASK 0
#endif
#define DUPP(p) (((DUP_MASK) >> (p)) & 1)
constexpr int NPH_LAYER = 12, NPH = NL * NPH_LAYER + 1;
struct Args { const float* in[25]; float* out; unsigned char* ws; int ph_lo, ph_hi; };
enum { I_X = 0, I_MEM, I_NORM_MIX, I_W_IN, I_W_GATE, I_SINKS, I_SGU_LN_G, I_SGU_LN_B, I_SGU_W, I_SGU_B, I_HGRN_LB, I_HGRN_NORM, I_W_BR_A, I_W_BR_B, I_W_BR_C, I_W_OUT, I_NORM_X, I_MEM_NORM,
       I_W_XQ, I_W_XKV, I_W_XO, I_NORM_FFN, I_W_FFN_IN, I_W_FFN_OUT, I_FINAL_NORM };

#define CIN(i) ((const GAS float*)(((uintptr_t)(unsigned)__builtin_amdgcn_readfirstlane((int)lctl[17 + 2 * (i)]) << 32) | (uintptr_t)(unsigned)__builtin_amdgcn_readfirstlane((int)lctl[16 + 2 * (i)])))
__device__ __forceinline__ void conv_phase(volatile LAS unsigned* lctl, int l, GAS unsigned char* ws, LAS float* scr, int gw, int NGW, int lane) {
    constexpr int I_IN = 32 * 240, I_GT = 32 * 192, I_BR = 16 * 64, I_OUT = 32 * 64, I_XQ = 32 * 16, I_XO = 8 * 64, I_F1 = 32 * 352, I_F2 = 88 * 64;
    constexpr int NITEMS = I_IN + I_GT + 3 * I_BR + I_OUT + I_XQ + I_XO + I_F1 + I_F2;
    GAS bf16* cWcat = (GAS bf16*)(ws + WS_WCAT); GAS bf16* cWbr = (GAS bf16*)(ws + WS_WBR); GAS bf16* cWout = (GAS bf16*)(ws + WS_WOUT); GAS bf16* cWxq = (GAS bf16*)(ws + WS_WXQ); GAS bf16* cWxo = (GAS bf16*)(ws + WS_WXO);
    GAS bf16* cWf1 = (GAS bf16*)(ws + WS_WF1); GAS bf16* cWf2 = (GAS bf16*)(ws + WS_WF2);
    for (int it = gw; it < NITEMS; it += NGW) {
        int r = it;
        if (r < I_IN) { const int kb = r / 240, nb = r % 240; tr_item(CIN(I_W_IN) + (size_t)l * DM * INW, INW, cWcat, DM, 64 * kb, 32 * nb, 32 * nb, scr, lane, CIN(I_NORM_MIX) + l * DM); continue; } r -= I_IN;
        if (r < I_GT) { const int kb = r / 192, nb = r % 192; tr_item(CIN(I_W_GATE) + (size_t)l * DM * GW, GW, cWcat, DM, 64 * kb, 32 * nb, INW + 32 * nb, scr, lane, CIN(I_NORM_MIX) + l * DM); continue; } r -= I_GT;
        if (r < 3 * I_BR) { const int j = r / I_BR, q = r % I_BR, kb = q / 64, nb = q % 64;
            tr_item(CIN(I_W_BR_A + j) + (size_t)l * 1024 * DM, DM, cWbr + (size_t)j * DM * 1024, 1024, 64 * kb, 32 * nb, 32 * nb, scr, lane); continue; } r -= 3 * I_BR;
        if (r < I_OUT) { const int kb = r / 64, nb = r % 64; tr_item(CIN(I_W_OUT) + (size_t)l * DM * DM, DM, cWout, DM, 64 * kb, 32 * nb, 32 * nb, scr, lane); continue; } r -= I_OUT;
        if (r < I_XQ) { const int kb = r / 16, nb = r % 16; tr_item(CIN(I_W_XQ) + (size_t)l * DM * XD, XD, cWxq, DM, 64 * kb, 32 * nb, 32 * nb, scr, lane, CIN(I_NORM_X) + l * DM); continue; } r -= I_XQ;
        if (r < I_XO) { const int kb = r / 64, nb = r % 64; tr_item(CIN(I_W_XO) + (size_t)l * XD * DM, DM, cWxo, XD, 64 * kb, 32 * nb, 32 * nb, scr, lane); continue; } r -= I_XO;
        if (r < I_F1) { const int kb = r / 352, nb = r % 352; const int n0 = 32 * nb; const int cc = (n0 < DFF) ? n0 : n0 - DFF; const int drow = 256 * (cc >> 7) + (cc & 127) + ((n0 < DFF) ? 0 : 128);
            tr_item(CIN(I_W_FFN_IN) + (size_t)l * DM * 2 * DFF, 2 * DFF, cWf1, DM, 64 * kb, n0, drow, scr, lane, CIN(I_NORM_FFN) + l * DM); continue; } r -= I_F1;
        { const int kb = r / 64, nb = r % 64; tr_item(CIN(I_W_FFN_OUT) + (size_t)l * DFF * DM, DM, cWf2, DFF, 64 * kb, 32 * nb, 32 * nb, scr, lane); }
    }
    if (l == 0) {
        GAS bf16* cWxkv = (GAS bf16*)(ws + WS_WXKV);
        for (int it = gw; it < 4 * 1024; it += NGW) { const int ll = it >> 10, q = it & 1023, kb = q >> 5, nb = q & 31;
            tr_item(CIN(I_W_XKV) + (size_t)ll * DM * 1024, 1024, cWxkv, DM, 64 * kb, 32 * nb, ll * 1024 + 32 * nb, scr, lane); }
        norm_phase(CIN(I_MEM), CIN(I_MEM_NORM), (GAS bf16*)(ws + WS_MEMN), MT, gw, NGW, lane);
    }
}

__global__ void __launch_bounds__(NTHR, 2) fwd_kernel(Args a) {
    extern __shared__ __attribute__((aligned(16))) unsigned char lds_raw[];
    LAS unsigned char* lds = (LAS unsigned char*)lds_raw;
    volatile LAS unsigned* lctl = (volatile LAS unsigned*)(lds + LDSCTL_OFF);
    const int tid0 = threadIdx.x;
    const int G = gridDim.x, bx = blockIdx.x;
    unsigned* ctl0 = (unsigned*)(a.ws + WS_CTL);
    for (int u = tid0; u < (LDS_BYTES - LDSCTL_OFF) / 4; u += NTHR) lctl[u] = 0u;
    __syncthreads();
    if (tid0 < 25) { lctl[16 + 2 * tid0] = (unsigned)(uintptr_t)a.in[tid0]; lctl[17 + 2 * tid0] = (unsigned)((uintptr_t)a.in[tid0] >> 32); }
    if (tid0 == 0) { lctl[8] = (unsigned)(uintptr_t)a.ws; lctl[9] = (unsigned)((uintptr_t)a.ws >> 32); lctl[10] = (unsigned)(uintptr_t)a.out; lctl[11] = (unsigned)((uintptr_t)a.out >> 32); }
    __syncthreads();
    const int lo = a.ph_lo, hi = a.ph_hi;
    XcdBarrier bar; bar.bar = ctl0 + CW_BAR; bar.x = 0; bar.st = nullptr;
    if (hi - lo > 1) bar = xcd_barrier_post(ctl0 + CW_BAR, lctl);
#define IN(k) (lo <= (k) && (k) < hi)
#define SEAM(k) do { if (IN(k) && IN((k) + 1)) xcd_barrier(bar); } while (0)

#define OPQ_PTR(TY, w) ((TY)(((uintptr_t)(unsigned)__builtin_amdgcn_readfirstlane((int)lctl[(w) + 1]) << 32) | (uintptr_t)(unsigned)__builtin_amdgcn_readfirstlane((int)lctl[(w)])))
#define PH_BEGIN int tid = threadIdx.x; asm volatile("" : "+v"(tid)); \
        GAS unsigned char* ws = OPQ_PTR(GAS unsigned char*, 8); GAS float* out = OPQ_PTR(GAS float*, 10); const int lane = tid & 63, wave = __builtin_amdgcn_readfirstlane(tid >> 6); const int gw = bx * NWAVES + wave, NGW = G * NWAVES; \
        (void)ws; (void)out; (void)lane; (void)gw; (void)NGW;
#define WSP(off) ((GAS bf16*)(ws + (off)))
#ifdef PROBE_TIMING
#define PROBE_MARK(p) do { if (threadIdx.x == 0) lctl[99] = ((p) == PROBE_PHASE && l == 1) ? 1u : 0u; __syncthreads(); } while (0)
#else
#define PROBE_MARK(p) do {} while (0)
#endif
#define GIN(i) OPQ_PTR(const GAS float*, 16 + 2 * (i))
    for (int l = 0; l < NL; ++l) {
        const int pb = l * NPH_LAYER;
        if (HASP(0) && IN(pb + 0)) for (int rep = 0; rep <= DUPP(0); ++rep) { if (rep) xcd_barrier(bar); PH_BEGIN
            conv_phase(lctl, l, ws, (LAS float*)(lds + wave * 16384), gw, NGW, lane);
            if (l == 0) xb_phase(GIN(I_X), WSP(WS_H), RES_MASTER_HALF ? (GAS unsigned short*)out : (GAS unsigned short*)nullptr, (GAS float*)(ws + WS_SS), gw, NGW, lane);
        }
        SEAM(pb + 0);
        if (HASP(1) && IN(pb + 1)) for (int rep = 0; rep <= DUPP(1); ++rep) { if (rep) xcd_barrier(bar); PH_BEGIN PROBE_MARK(1);
            { pg8::PlainOrder S; S.init(T, NCAT, G, bx, WSP(WS_H), DM, WSP(WS_WCAT), DM); EpiCat E{ws + WS_PROJ, WSP(WS_GATE), RowScale{(const GAS float*)(ws + WS_SS), (LAS float*)(lds + LDS_RSTD)}};
              pg8::gemm_phase(lds, pg8::GemmK{DM, DM, DM, 1}, S, E); }
            if (l == 0) { pg8::PlainOrder S; S.init(MT, 4096, G, bx, WSP(WS_MEMN), DM, WSP(WS_WXKV), DM); EpiPlain<false> E{WSP(WS_KV), 4096, RowScale{nullptr, nullptr}};
              pg8::gemm_phase(lds, pg8::GemmK{DM, DM, DM, 0}, S, E); }
        }
        SEAM(pb + 1);
        if (HASP(2) && IN(pb + 2)) for (int rep = 0; rep <= DUPP(2); ++rep) { if (rep) xcd_barrier(bar);
            for (int r2 = 0; r2 <= DUPP(16); ++r2) { PH_BEGIN unsigned* q = (unsigned*)(a.ws + WS_CTL) + CW_Q + 256 * l + 16 * rep + 8 * r2;
              for (;;) { __syncthreads(); if (tid == 0) lctl[4] = xb_add(q, 1u); __syncthreads(); const int idx = (int)lctl[4]; if (idx >= NB * 8) break;
                hgrn_unit(idx, l, WSP(WS_PROJ + PJ_HB), GIN(I_HGRN_LB), GIN(I_HGRN_NORM) + l * 128, WSP(WS_Y), lds, tid); } }
            for (int r2 = 0; r2 <= DUPP(17); ++r2) { PH_BEGIN unsigned* q = (unsigned*)(a.ws + WS_CTL) + CW_Q + 256 * l + 16 * rep + 8 * r2;
              swa_loop(q + 64, lctl, WSP(WS_PROJ), GIN(I_SINKS) + l * 16, WSP(WS_Y), lds, tid); }
            for (int r2 = 0; r2 <= DUPP(18); ++r2) { PH_BEGIN unsigned* q = (unsigned*)(a.ws + WS_CTL) + CW_Q + 256 * l + 16 * rep + 8 * r2;
              for (;;) { __syncthreads(); if (tid == 0) lctl[4] = xb_add(q + 128, 1u); __syncthreads(); const int idx = (int)lctl[4]; if (idx >= NB * 16) break;
                sgu_unit(idx, WSP(WS_PROJ + PJ_UB), WSP(WS_PROJ + PJ_VB), GIN(I_SGU_LN_G) + l * 1024, GIN(I_SGU_LN_B) + l * 1024, GIN(I_SGU_W) + (size_t)l * 8 * 16384, GIN(I_SGU_B) + l * 1024, WSP(WS_Y), lds, tid); } }
            __syncthreads();
        }
        SEAM(pb + 2);
        if (HASP(3) && IN(pb + 3)) for (int rep = 0; rep <= DUPP(3); ++rep) { if (rep) xcd_barrier(bar); PH_BEGIN PROBE_MARK(3);
            pg8::PlainOrder S; S.init(T, DM, G, bx, WSP(WS_Y), YW, WSP(WS_WBR), 1024, 3, (size_t)32 * 1024, (size_t)DM * 1024 * 2);
            EpiBranch E{WSP(WS_GATE), WSP(WS_PROJ)};
            pg8::gemm_phase(lds, pg8::GemmK{1024, YW, 1024, 1}, S, E);
        }
        SEAM(pb + 3);
        if (HASP(4) && IN(pb + 4)) for (int rep = 0; rep <= DUPP(4); ++rep) { if (rep) xcd_barrier(bar); PH_BEGIN PROBE_MARK(4);
            pg8::PlainOrder S; S.init(T, DM, G, bx, WSP(WS_PROJ), DM, WSP(WS_WOUT), DM); EpiResid E{WSP(WS_H), rep ? WSP(WS_GATE) : WSP(WS_H), rep ? (GAS float*)nullptr : (GAS float*)(ws + WS_SS), (LAS float*)(lds + LDS_RED), (RES_MASTER_HALF && !rep) ? (GAS unsigned short*)out : (GAS unsigned short*)nullptr};
            pg8::gemm_phase(lds, pg8::GemmK{DM, DM, DM, 1}, S, E);
        }
        SEAM(pb + 4);
        if (HASP(6) && IN(pb + 6)) for (int rep = 0; rep <= DUPP(6); ++rep) { if (rep) xcd_barrier(bar); PH_BEGIN PROBE_MARK(6);
            pg8::PlainOrder S; S.init(T, XD, G, bx, WSP(WS_H), DM, WSP(WS_WXQ), DM); EpiPlain<true> E{WSP(WS_Y), XD, RowScale{(const GAS float*)(ws + WS_SS), (LAS float*)(lds + LDS_RSTD)}};
            pg8::gemm_phase(lds, pg8::GemmK{DM, DM, DM, 1}, S, E);
        }
        SEAM(pb + 6);
        if (HASP(7) && IN(pb + 7)) for (int rep = 0; rep <= DUPP(7); ++rep) { if (rep) xcd_barrier(bar); PH_BEGIN for (int u = 2 * bx, up = -1; u < NB * 32; u += (u & 1) ? 2 * G - 1 : 1) { xattn_unit(u, l, WSP(WS_KV), WSP(WS_Y), WSP(WS_Y + 32 * MiB), lds, tid, (u >> 3) != up); up = u >> 3; } __syncthreads(); }
        SEAM(pb + 7);
        if (HASP(8) && IN(pb + 8)) for (int rep = 0; rep <= DUPP(8); ++rep) { if (rep) xcd_barrier(bar); PH_BEGIN PROBE_MARK(8);
            pg8::PlainOrder S; S.init(T, DM, G, bx, WSP(WS_Y + 32 * MiB), XD, WSP(WS_WXO), XD); EpiResid E{WSP(WS_H), rep ? WSP(WS_GATE) : WSP(WS_H), rep ? (GAS float*)nullptr : (GAS float*)(ws + WS_SS), (LAS float*)(lds + LDS_RED), (RES_MASTER_HALF && !rep) ? (GAS unsigned short*)out : (GAS unsigned short*)nullptr};
            pg8::gemm_phase(lds, pg8::GemmK{XD, XD, XD, 1}, S, E);
        }
        SEAM(pb + 8);
        if (HASP(10) && IN(pb + 10)) for (int rep = 0; rep <= DUPP(10); ++rep) { if (rep) xcd_barrier(bar); PH_BEGIN PROBE_MARK(10);
            pg8::PlainOrder S; S.init(T, 2 * DFF, G, bx, WSP(WS_H), DM, WSP(WS_WF1), DM); EpiSwiglu E{WSP(WS_PROJ), RowScale{(const GAS float*)(ws + WS_SS), (LAS float*)(lds + LDS_RSTD)}};
            pg8::gemm_phase(lds, pg8::GemmK{DM, DM, DM, 1}, S, E);
        }
        SEAM(pb + 10);
        if (HASP(11) && IN(pb + 11)) for (int rep = 0; rep <= DUPP(11); ++rep) { if (rep) xcd_barrier(bar); PH_BEGIN PROBE_MARK(11);
            pg8::PlainOrder S; S.init(T, DM, G, bx, WSP(WS_PROJ), DFF, WSP(WS_WF2), DFF); EpiResid E{WSP(WS_H), rep ? WSP(WS_GATE) : WSP(WS_H), rep ? (GAS float*)nullptr : (GAS float*)(ws + WS_SS), (LAS float*)(lds + LDS_RED), (RES_MASTER_HALF && !rep) ? (GAS unsigned short*)out : (GAS unsigned short*)nullptr};
            pg8::gemm_phase(lds, pg8::GemmK{DFF, DFF, DFF, 1}, S, E);
        }
        SEAM(pb + 11);
    }
    if (HASP(12) && IN(NPH - 1)) { int tq = tid0; asm volatile("" : "+v"(tq)); const int lane = tq & 63, wave = __builtin_amdgcn_readfirstlane(tq >> 6); final_norm_phase((const GAS unsigned short*)(a.ws + WS_H), (GAS float*)a.out, GIN(I_FINAL_NORM), (const GAS float*)(a.ws + WS_SS), bx * NWAVES + wave, G * NWAVES, lane); }
#ifdef PROBE_TIMING
    if (bx == 0 && tid0 == 0) { asm volatile("s_waitcnt vmcnt(0)" ::: "memory"); a.out[0] = (float)lctl[100 + PROBE_WHAT]; }
#endif
#undef IN
#undef SEAM
#undef PH_BEGIN
#undef OPQ_PTR
#undef WSP
#undef GIN
}

extern "C" void kernel_launch(void* const* d_in, const int* in_sizes, int n_in, void* d_out, int out_size, void* d_ws, size_t ws_size, hipStream_t stream) {
    static int grid = 0;
    if (grid == 0) {
        if (n_in != 25 || out_size != T * DM || ws_size < WS_END) { fprintf(stderr, "kernel_launch: unexpected shapes (n_in %d, out %d, ws %zu, need %zu)\n", n_in, out_size, ws_size, (size_t)WS_END); grid = -1; return; }
        int dev = 0, cus = 0, per_cu = 0;
        if (hipGetDevice(&dev) != hipSuccess || hipDeviceGetAttribute(&cus, hipDeviceAttributeMultiprocessorCount, dev) != hipSuccess) { grid = -1; return; }
        if (hipFuncSetAttribute((const void*)fwd_kernel, hipFuncAttributeMaxDynamicSharedMemorySize, LDS_BYTES) != hipSuccess) { fprintf(stderr, "kernel_launch: hipFuncSetAttribute failed\n"); grid = -1; return; }
        if (hipOccupancyMaxActiveBlocksPerMultiprocessor(&per_cu, (const void*)fwd_kernel, NTHR, LDS_BYTES) != hipSuccess || per_cu < 1)
            fprintf(stderr, "kernel_launch: occupancy query reports %d workgroups per CU\n", per_cu);
        (void)hipGetLastError();
        grid = cus;
    }
    if (grid < 0) return;
    if (hipMemsetAsync((char*)d_ws + WS_CTL, 0, CTL_ZERO_BYTES, stream) != hipSuccess) return;
    Args a{};
    for (int i = 0; i < 25; ++i) a.in[i] = (const float*)d_in[i];
    a.out = (float*)d_out; a.ws = (unsigned char*)d_ws;
#if MK_MULTI
    for (int p = 0; p < NPH; ++p) { a.ph_lo = p; a.ph_hi = p + 1; hipLaunchKernelGGL(fwd_kernel, dim3(grid), dim3(NTHR), LDS_BYTES, stream, a); }
#else
    a.ph_lo = 0; a.ph_hi = NPH;
    hipLaunchKernelGGL(fwd_kernel, dim3(grid), dim3(NTHR), LDS_BYTES, stream, a);
#endif
}
```

```cpp
#include <hip/hip_runtime.h>
#include <cstdio>
#include <cstdint>

#define LAS __attribute__((address_space(3)))
#define GAS __attribute__((address_space(1)))
typedef unsigned short bf16;
typedef short bf16x8 __attribute__((ext_vector_type(8)));
typedef float f32x4 __attribute__((ext_vector_type(4)));
typedef float f32x2 __attribute__((ext_vector_type(2)));
typedef unsigned u32x4 __attribute__((ext_vector_type(4)));
typedef unsigned u32x2 __attribute__((ext_vector_type(2)));
typedef GAS unsigned gu32;

__device__ __forceinline__ unsigned cvt_pk_bf16(float lo, float hi) { unsigned r; asm("v_cvt_pk_bf16_f32 %0, %1, %2" : "=v"(r) : "v"(lo), "v"(hi)); return r; }
__device__ __forceinline__ unsigned pk_min_u16(unsigned a, unsigned b) { unsigned r; asm("v_pk_min_u16 %0, %1, %2" : "=v"(r) : "v"(a), "v"(b)); return r; }
__device__ __forceinline__ float bf_lo(unsigned w) { return __builtin_bit_cast(float, w << 16); }
__device__ __forceinline__ float bf_hi(unsigned w) { return __builtin_bit_cast(float, w & 0xffff0000u); }
__device__ __forceinline__ float bf1(bf16 h) { return __builtin_bit_cast(float, (unsigned)h << 16); }
__device__ __forceinline__ float fast_exp(float x) { return __builtin_amdgcn_exp2f(x * 1.4426950408889634f); }
__device__ __forceinline__ float sigmoidf_(float x) { return __builtin_amdgcn_rcpf(1.0f + fast_exp(-x)); }
__device__ __forceinline__ float siluf_(float x) { return x * sigmoidf_(x); }
__device__ __forceinline__ float geluf_(float x) { return x * sigmoidf_(1.5957691216057308f * (x + 0.044715f * x * x * x)); }
__device__ __forceinline__ float wave_sum(float v) {
#pragma unroll
    for (int o = 1; o < 64; o <<= 1) v += __shfl_xor(v, o);
    return v;
}

typedef _Float16 f16x8 __attribute__((ext_vector_type(8)));
typedef _Float16 f16x4 __attribute__((ext_vector_type(4)));
typedef _Float16 f16x2 __attribute__((ext_vector_type(2)));
template <bool F16> __device__ __forceinline__ f32x4 mma16(bf16x8 a, bf16x8 b, f32x4 c) {
    if constexpr (F16) return __builtin_amdgcn_mfma_f32_16x16x32_f16(__builtin_bit_cast(f16x8, a), __builtin_bit_cast(f16x8, b), c, 0, 0, 0);
    else return __builtin_amdgcn_mfma_f32_16x16x32_bf16(a, b, c, 0, 0, 0);
}
#ifndef RES_F16
#define RES_F16 0
#endif
__device__ __forceinline__ unsigned cvt_pk_f16(float lo, float hi) { f16x2 h; h.x = (_Float16)lo; h.y = (_Float16)hi; return __builtin_bit_cast(unsigned, h); }
__device__ __forceinline__ float h_lo(unsigned w) { return (float)__builtin_bit_cast(f16x2, w).x; }
__device__ __forceinline__ float h_hi(unsigned w) { return (float)__builtin_bit_cast(f16x2, w).y; }
__device__ __forceinline__ unsigned cvt_pk_res(float lo, float hi) { return RES_F16 ? cvt_pk_f16(lo, hi) : cvt_pk_bf16(lo, hi); }
__device__ __forceinline__ float res_lo(unsigned w) { return RES_F16 ? h_lo(w) : bf_lo(w); }
__device__ __forceinline__ float res_hi(unsigned w) { return RES_F16 ? h_hi(w) : bf_hi(w); }
namespace pg8 {
constexpr int BM = 256, BK = 64, HALF = 128, HTB = HALF * BK * 2, STAGE_BYTES = 8 * HTB, NXCD = 8, WGM = 4;
__host__ __device__ __forceinline__ int lds_byte(int r, int c) { const int st = (r >> 4) * 2 + (c >> 5), rr = r & 15, cc = c & 31, ob = rr * 64 + cc * 2; return st * 1024 + (ob ^ (((ob >> 9) & 1) << 5)); }
__host__ __device__ __forceinline__ void stage_rc(int b, int& R, int& C) { const int st = b / 1024, sb = b % 1024, swz = sb ^ (((sb >> 9) & 1) << 5); R = (st >> 1) * 16 + swz / 64; C = (st & 1) * 32 + (swz % 64) / 2; }
__host__ __device__ __forceinline__ int perm32(int rho) { const int n = rho >> 4, i = rho & 15; return 8 * (i >> 2) + 4 * n + (i & 3); }

struct Unit { int pm, pn, aux; const GAS char* a; const GAS char* b; };
struct GemmK { int K, lda, ldb, ablk; };
__host__ __device__ __forceinline__ size_t blk16x32(size_t r, int c, int W) { return ((r >> 4) * (size_t)(W >> 5) + (size_t)(c >> 5)) * 1024 + (r & 15) * 64 + (size_t)(c & 31) * 2; }

__device__ __forceinline__ void tile_of(int L, int nM, int nN, int wgm, int& pm, int& pn) {
    const int nwg = nM * nN; int wgid = L;
    { const int q = nwg / NXCD, r = nwg % NXCD, xcd = wgid % NXCD, off = wgid / NXCD; wgid = (xcd < r ? xcd * (q + 1) : r * (q + 1) + (xcd - r) * q) + off; }
    const int nig = wgm * nN, gid = wgid / nig, fm = gid * wgm, gsz = (nM - fm) < wgm ? (nM - fm) : wgm;
    pm = fm + ((wgid % nig) % gsz); pn = (wgid % nig) / gsz;
}
struct PlainOrder {
    int nM, nN, nwg, G, c, sub, wgm; const GAS char* A; const GAS char* B; size_t tA, tB, asub, bsub;
    __device__ __forceinline__ void init(int M, int N, int G_, int c_, const GAS void* A_, int lda, const GAS void* B_, int ldb, int sub_ = 1, size_t asub_ = 0, size_t bsub_ = 0, int wgm_ = WGM) {
        nM = M / BM; nN = N / BM; nwg = nM * nN; G = G_; c = c_; A = (const GAS char*)A_; B = (const GAS char*)B_; tA = (size_t)BM * lda * 2; tB = (size_t)BM * ldb * 2; sub = sub_; asub = asub_; bsub = bsub_; wgm = wgm_; }
    __device__ __forceinline__ bool next(int i, Unit& u) const {
        const int ti = i / sub, j = i - ti * sub;
        const long L = (long)ti * G + c; if (L >= nwg) return false;
        tile_of((int)L, nM, nN, wgm, u.pm, u.pn); u.aux = j;
        u.a = A + (size_t)u.pm * tA + (size_t)j * asub; u.b = B + (size_t)u.pn * tB + (size_t)j * bsub; return true;
    }
};

template <class Epi, class Sched>
__device__ __forceinline__ void gemm_phase(LAS unsigned char* lds, const GemmK g, const Sched& S, const Epi& E) {
    int tid = threadIdx.x; asm volatile("" : "+v"(tid));
    const int wid = __builtin_amdgcn_readfirstlane(tid >> 6), lane = tid & 63, wr = wid >> 2, wc = wid & 3, fr = lane & 15, fq = lane >> 4;
    const int K = g.K, nt = K / BK;
    unsigned voffA[2], voffB[2];
#pragma unroll
    for (int i = 0; i < 2; ++i) { int R, C; stage_rc(tid * 16 + i * 8192, R, C); const int Rb = Epi::PERM ? ((R & ~31) + perm32(R & 31)) : R;
        voffA[i] = g.ablk ? (unsigned)blk16x32((size_t)R, C, g.lda) : (unsigned)(R * g.lda + C) * 2u; voffB[i] = (unsigned)blk16x32((size_t)Rb, C, g.ldb); }
    const size_t kstep = (size_t)2048, kstepA = g.ablk ? (size_t)2048 : (size_t)(BK * 2);
    const size_t hstepA = (size_t)HALF * g.lda * 2, hstepB = (size_t)HALF * g.ldb * 2;
    const unsigned ldsw = (unsigned)wid * 1024u;
    const int aoff = lds_byte(wr * 64 + fr, fq * 8), boff = lds_byte(wc * 32 + fr, fq * 8);
#define PG8_SA(b, h) (((b) * 2 + (h)) * HTB)
#define PG8_SB(b, h) ((4 + (b) * 2 + (h)) * HTB)
#define PG8_STAGE(bufoff, gbase, voff) do { _Pragma("unroll") for (int _i = 0; _i < 2; ++_i) \
        __builtin_amdgcn_global_load_lds((const GAS unsigned*)((gbase) + (voff)[_i]), (LAS unsigned*)(lds + (bufoff) + ldsw + _i * 8192), 16, 0, 0); } while (0)
#define PG8_LDA(dst, b, h) do { _Pragma("unroll") for (int m = 0; m < 4; ++m) _Pragma("unroll") for (int k = 0; k < 2; ++k) dst[m][k] = *(const LAS bf16x8*)(lds + PG8_SA(b, h) + aoff + m * 2048 + k * 1024); } while (0)
#define PG8_LDB(dst, b, h) do { _Pragma("unroll") for (int n = 0; n < 2; ++n) _Pragma("unroll") for (int k = 0; k < 2; ++k) dst[n][k] = *(const LAS bf16x8*)(lds + PG8_SB(b, h) + boff + n * 2048 + k * 1024); } while (0)
#define PG8_MMA(ai, bj, At, Bt) do { __builtin_amdgcn_s_setprio(1); _Pragma("unroll") for (int m = 0; m < 4; ++m) _Pragma("unroll") for (int n = 0; n < 2; ++n) _Pragma("unroll") for (int k = 0; k < 2; ++k) \
        acc[ai][bj][m][n] = mma16<Epi::F16>(Bt[n][k], At[m][k], acc[ai][bj][m][n]); __builtin_amdgcn_s_setprio(0); } while (0)
#define PG8_WAIT_V(n) asm volatile("s_waitcnt vmcnt(" #n ")" ::: "memory")
#define PG8_WAIT_L(n) asm volatile("s_waitcnt lgkmcnt(" #n ")" ::: "memory")
#define PG8_BAR __builtin_amdgcn_s_barrier()
#define PG8_SCHED __builtin_amdgcn_sched_barrier(0)
    Unit cur, nxt; int ui = 0;
    if (!S.next(0, cur)) return;
    int tb = 0;
    E.prep(cur, 0, tid);
    f32x4 acc[2][2][4][2];
#pragma unroll
    for (int a = 0; a < 2; ++a)
#pragma unroll
        for (int b = 0; b < 2; ++b)
#pragma unroll
            for (int m = 0; m < 4; ++m)
#pragma unroll
                for (int n = 0; n < 2; ++n) acc[a][b][m][n] = (f32x4){0.f, 0.f, 0.f, 0.f};
    bf16x8 At[4][2], B0[2][2], B1[2][2];
    const GAS char* cA = cur.a; const GAS char* cB = cur.b;
    PG8_STAGE(PG8_SB(0, 0), cB, voffB); PG8_STAGE(PG8_SB(0, 1), cB + hstepB, voffB); PG8_STAGE(PG8_SA(0, 0), cA, voffA); PG8_STAGE(PG8_SA(0, 1), cA + hstepA, voffA);
    if (wr == 1) PG8_BAR;
    PG8_WAIT_V(2); PG8_BAR;
    PG8_STAGE(PG8_SB(1, 0), cB + kstep, voffB); PG8_STAGE(PG8_SA(1, 0), cA + kstepA, voffA); PG8_STAGE(PG8_SB(1, 1), cB + hstepB + kstep, voffB);
    PG8_WAIT_V(6); PG8_BAR;
#ifdef PROBE_TIMING
    unsigned long long pt_k = 0, pt_e = 0, pt_0 = 0; unsigned pt_n = 0;
#endif
    for (;;) {
#ifdef PROBE_TIMING
        pt_0 = __builtin_amdgcn_s_memrealtime();
#endif
        const bool has_next = S.next(ui + 1, nxt);
        const GAS char* nA = has_next ? nxt.a : cA; const GAS char* nB = has_next ? nxt.b : cB;
        for (int t = 0; t < nt; t += 2) {
            const bool last = (t == nt - 2);
            const GAS char* a1 = cA + (size_t)(t + 1) * kstepA;
            const GAS char* a2 = last ? nA : cA + (size_t)(t + 2) * kstepA; const GAS char* b2 = last ? nB : cB + (size_t)(t + 2) * kstep;
            const GAS char* a3 = a2 + kstepA; const GAS char* b3 = b2 + kstep;
            PG8_LDB(B0, 0, 0); PG8_LDB(B1, 0, 1); PG8_SCHED; PG8_LDA(At, 0, 0); PG8_STAGE(PG8_SA(1, 1), a1 + hstepA, voffA);
            PG8_WAIT_V(8); PG8_WAIT_L(0); PG8_BAR; PG8_MMA(0, 0, At, B0); PG8_MMA(0, 1, At, B1); PG8_BAR; PG8_SCHED;
            PG8_LDA(At, 0, 1); PG8_STAGE(PG8_SB(0, 0), b2, voffB); PG8_STAGE(PG8_SB(0, 1), b2 + hstepB, voffB); PG8_STAGE(PG8_SA(0, 0), a2, voffA);
            PG8_WAIT_V(8); PG8_WAIT_L(0); PG8_BAR; PG8_MMA(1, 0, At, B0); PG8_MMA(1, 1, At, B1); PG8_BAR; PG8_SCHED;
            PG8_LDB(B0, 1, 0); PG8_LDB(B1, 1, 1); PG8_SCHED; PG8_LDA(At, 1, 0); PG8_STAGE(PG8_SA(0, 1), a2 + hstepA, voffA);
            PG8_WAIT_V(8); PG8_WAIT_L(0); PG8_BAR; PG8_MMA(0, 0, At, B0); PG8_MMA(0, 1, At, B1); PG8_BAR; PG8_SCHED;
            PG8_LDA(At, 1, 1); PG8_STAGE(PG8_SB(1, 0), b3, voffB); PG8_STAGE(PG8_SB(1, 1), b3 + hstepB, voffB); PG8_STAGE(PG8_SA(1, 0), a3, voffA);
            PG8_WAIT_V(8); PG8_WAIT_L(0); PG8_BAR; PG8_MMA(1, 0, At, B0); PG8_MMA(1, 1, At, B1); PG8_BAR; PG8_SCHED;
        }
#ifdef PROBE_TIMING
        { const unsigned long long t = __builtin_amdgcn_s_memrealtime(); pt_k += t - pt_0; pt_0 = t; }
#endif
        if (wr == 0) PG8_BAR;
        E(acc, cur, wr, wc, fr, fq, tb);
        if (has_next && nxt.pm != cur.pm) { tb ^= 1; E.prep(nxt, tb, tid); }
#ifdef PROBE_TIMING
        { asm volatile("s_waitcnt vmcnt(0)" ::: "memory"); const unsigned long long t = __builtin_amdgcn_s_memrealtime(); pt_e += t - pt_0; ++pt_n; }
#endif
        if (!has_next) break;
        if (!Epi::keep(cur)) {
#pragma unroll
        for (int a = 0; a < 2; ++a)
#pragma unroll
            for (int b = 0; b < 2; ++b)
#pragma unroll
                for (int m = 0; m < 4; ++m)
#pragma unroll
                    for (int n = 0; n < 2; ++n) { f32x2 lo, hi; asm volatile("v_mov_b64 %0, 0" : "=v"(lo)); asm volatile("v_mov_b64 %0, 0" : "=v"(hi));
                        acc[a][b][m][n] = __builtin_shufflevector(lo, hi, 0, 1, 2, 3); }
        }
        cur = nxt; cA = nA; cB = nB; ++ui;
        if (wr == 1) PG8_BAR;
    }
    PG8_WAIT_V(0);
    PG8_BAR;
#ifdef PROBE_TIMING
    { volatile LAS unsigned* pl = (volatile LAS unsigned*)(lds + PROBE_LCTL_OFF); if (tid == 0 && pl[99]) { pl[100] = (unsigned)pt_k; pl[101] = (unsigned)pt_e; pl[102] = pt_n; } }
#endif
#undef PG8_SA
#undef PG8_SB
#undef PG8_STAGE
#undef PG8_LDA
#undef PG8_LDB
#undef PG8_MMA
#undef PG8_WAIT_V
#undef PG8_WAIT_L
#undef PG8_BAR
#undef PG8_SCHED
}
}
constexpr int NB = 16, SEQ = 2048, DM = 2048, T = NB * SEQ, NL = 4, MEML = 256, MT = NB * MEML;
constexpr int INW = 7680, GW = 6144, NCAT = INW + GW, XD = 512, DFF = 5632, YW = 3072;
constexpr int C_QA = 0, C_KA = 1024, C_VA = 1280, C_UB = 1536, C_VB = 2560, C_FC = 3584, C_IC = 4608, C_QC = 5632, C_GC = 6656;
constexpr float EPS = 1e-6f;
constexpr float LOG2E = 1.4426950408889634f;
constexpr int NWAVES = 8, NTHR = NWAVES * 64;

constexpr size_t MiB = 1u << 20;
constexpr size_t WS_CTL = 0, CTL_ZERO_BYTES = 1 * MiB;
constexpr size_t WS_WCAT = 1 * MiB;
constexpr size_t WS_WBR = WS_WCAT + 54 * MiB;
constexpr size_t WS_WOUT = WS_WBR + 12 * MiB;
constexpr size_t WS_WXQ = WS_WOUT + 8 * MiB;
constexpr size_t WS_WXO = WS_WXQ + 2 * MiB;
constexpr size_t WS_WF1 = WS_WXO + 2 * MiB;
constexpr size_t WS_WF2 = WS_WF1 + 44 * MiB;
constexpr size_t WS_WXKV = WS_WF2 + 22 * MiB;
constexpr size_t WS_MEMN = WS_WXKV + 16 * MiB;
constexpr size_t WS_KV = WS_MEMN + 16 * MiB;
constexpr size_t WS_H = WS_KV + 32 * MiB;
constexpr size_t WS_PROJ = WS_H + 128 * MiB;
constexpr size_t PJ_QKV = 0, PJ_UB = 96 * MiB, PJ_VB = 160 * MiB, PJ_HB = 224 * MiB  , PJ_STAT = 480 * MiB;
constexpr int QKVW = 1536;
constexpr size_t WS_GATE = WS_PROJ + 484 * MiB;
constexpr size_t WS_Y = WS_GATE + 384 * MiB;
constexpr size_t WS_SS = WS_Y + 192 * MiB;
constexpr size_t WS_END = WS_SS + 1 * MiB;
constexpr int CW_TMO = 0, CW_BAR = 4096, CW_Q = 8192;

constexpr int RING_BYTES = 143360;
constexpr int LDSCTL_OFF = RING_BYTES, LDS_RED = LDSCTL_OFF + 1024, LDS_RSTD = LDS_RED + 4096, LDS_BYTES = 155648;

#define RLX_AGENT __ATOMIC_RELAXED, __HIP_MEMORY_SCOPE_AGENT
#define LDS_WAIT() asm volatile("s_waitcnt lgkmcnt(0)" ::: "memory")
#define VM_WAIT() asm volatile("s_waitcnt vmcnt(0)" ::: "memory")

#define XB_TMO      128
#define XB_XCNT(j)  (256  + 64 * (j))
#define XB_XSUB(j)  (1280 + 64 * (j))
#define XB_XGEN(j)  (2304 + 64 * (j))
#define XB_TOP      3328
#define XB_TOPGEN   3392
#define XCD_BAR_WORDS 3456
#define XB_SPIN_CAP (1u << 18)
__device__ __forceinline__ unsigned xb_ld(unsigned* p)              { return __hip_atomic_load(p, __ATOMIC_RELAXED, __HIP_MEMORY_SCOPE_AGENT); }
__device__ __forceinline__ unsigned xb_add(unsigned* p, unsigned v) { return __hip_atomic_fetch_add(p, v, __ATOMIC_RELAXED, __HIP_MEMORY_SCOPE_AGENT); }
__device__ __forceinline__ unsigned xb_xcc_id() { return (unsigned)__builtin_amdgcn_s_getreg((3 << 11) | 20) & 0xFu; }
#define XB_SPIN(cond, bar) do { unsigned _sp = 0; while (cond) { __builtin_amdgcn_s_sleep(1); \
    if ((++_sp & 255u) == 0u) { if (xb_ld(&(bar)[XB_TMO])) break; if (_sp > XB_SPIN_CAP) { atomicAdd(&(bar)[XB_TMO], 1u); break; } } } } while (0)
struct XcdBarrier { unsigned* bar; unsigned x; volatile LAS unsigned* st; };
__device__ __forceinline__ XcdBarrier xcd_barrier_post(unsigned* bar, volatile LAS unsigned* st) {
    XcdBarrier b; b.bar = bar; b.x = xb_xcc_id(); b.st = st;
    if (threadIdx.x == 0) (void)xb_add(&bar[XB_XCNT(b.x)], 1u);
    return b;
}
__device__ __forceinline__ void xcd_barrier_complete(unsigned* bar, unsigned x, unsigned& nloc, unsigned& nx) {
    const unsigned G = gridDim.x * gridDim.y * gridDim.z;
    unsigned sum, cnt, mine, sp = 0u;
    for (;;) {
        sum = 0u; cnt = 0u; mine = 0u;
#pragma unroll
        for (unsigned j = 0; j < 16; ++j) { const unsigned c = xb_ld(&bar[XB_XCNT(j)]); sum += c; cnt += (c > 0u) ? 1u : 0u; mine = (j == x) ? c : mine; }
        if (sum == G) break;
        __builtin_amdgcn_s_sleep(1);
        if ((++sp & 255u) == 0u) { if (xb_ld(&bar[XB_TMO])) break; if (sp > XB_SPIN_CAP) { atomicAdd(&bar[XB_TMO], 1u); break; } }
    }
    nloc = mine > 0u ? mine : 1u; nx = cnt > 0u ? cnt : 1u;
}
__device__ __forceinline__ void xcd_barrier(const XcdBarrier& b) {
    asm volatile("s_waitcnt vmcnt(0)" ::: "memory");
    __syncthreads();
    if (threadIdx.x == 0) {
        unsigned* bar = b.bar;
        __builtin_amdgcn_s_waitcnt(0);
        unsigned nloc = b.st[0], nx = b.st[1];
        if (nloc == 0u) { xcd_barrier_complete(bar, b.x, nloc, nx); b.st[0] = nloc; b.st[1] = nx; }
        const unsigned old = xb_add(&bar[XB_XSUB(b.x)], 1u);
        const unsigned gen = old / nloc;
        if (old + 1u == (gen + 1u) * nloc) {
            __builtin_amdgcn_fence(__ATOMIC_RELEASE, "agent");
            asm volatile("s_waitcnt vmcnt(0)" ::: "memory");
            const unsigned og = xb_add(&bar[XB_TOP], 1u);
            const unsigned tg = og / nx;
            if (og + 1u == (tg + 1u) * nx) xb_add(&bar[XB_TOPGEN], 1u);
            else XB_SPIN(xb_ld(&bar[XB_TOPGEN]) == tg, bar);
            __builtin_amdgcn_fence(__ATOMIC_ACQUIRE, "agent");
            xb_add(&bar[XB_XGEN(b.x)], 1u);
            asm volatile("s_waitcnt vmcnt(0)" ::: "memory");
        } else {
            XB_SPIN(xb_ld(&bar[XB_XGEN(b.x)]) == gen, bar);
            __builtin_amdgcn_fence(__ATOMIC_ACQUIRE, "agent");
            asm volatile("s_waitcnt vmcnt(0)" ::: "memory");
        }
    }
    __syncthreads();
}

struct RowScale {
    const GAS float* ss; LAS float* tab;
    __device__ __forceinline__ void prep(const pg8::Unit& u, int buf, int tid) const {
        if (tid < 256) { const GAS f32x4* p = (const GAS f32x4*)(ss + ((size_t)u.pm * 256 + tid) * 8); const f32x4 a = p[0], b = p[1];
            tab[buf * 256 + tid] = __builtin_amdgcn_rsqf(((a.x + a.y) + (a.z + a.w) + (b.x + b.y) + (b.z + b.w)) * (1.f / DM) + EPS); }
    }
    __device__ __forceinline__ float get(int buf, int row) const { return tab[buf * 256 + row]; }
};
struct EpiCat {
    static constexpr bool PERM = true, F16 = (RES_F16 != 0); static __device__ __forceinline__ bool keep(const pg8::Unit&) { return false; }
    GAS unsigned char* pj; GAS bf16* gate; RowScale rs;
    __device__ __forceinline__ void prep(const pg8::Unit& u, int buf, int tid) const { rs.prep(u, buf, tid); }
    __device__ __forceinline__ void operator()(f32x4 (&acc)[2][2][4][2], const pg8::Unit& u, int wr, int wc, int fr, int fq, int buf) const {
        const int pn = u.pn; GAS char* base; int ldc, colt; size_t bjs = 256, rowbase = (size_t)u.pm * 256; bool isgate = false, blk = false;
        if (pn < 6) { base = (GAS char*)pj + PJ_QKV; ldc = QKVW; colt = pn * 256; blk = true; bjs = 4096; }
        else if (pn < 14) { base = (GAS char*)pj + (pn < 10 ? PJ_UB : PJ_VB); ldc = 1024; colt = ((pn - 6) & 3) * 256; blk = true; bjs = 4096; }
        else if (pn < 30) { const int seg = (pn - 14) >> 2, hp = (pn - 14) & 3, b = u.pm >> 3, t0 = (u.pm & 7) * 256;
            base = (GAS char*)pj + PJ_HB + (size_t)seg * (64 * MiB) + ((size_t)((b * 8 + 2 * hp) * SEQ + t0) * 128) * 2; ldc = 128; colt = 0; bjs = (size_t)SEQ * 128 * 2; rowbase = 0; blk = true; }
        else { base = (GAS char*)gate; ldc = GW; colt = (pn - 30) * 256; isgate = true; }
        const unsigned toff = blk ? (unsigned)((wr * 4 * (ldc >> 5) + wc) * 1024 + fr * 64 + fq * 16) : (unsigned)((wr * 64 + fr) * ldc + wc * 32 + 8 * fq) * 2u, tidoff = (unsigned)threadIdx.x * 16u;
#pragma unroll
        for (int ai = 0; ai < 2; ++ai)
#pragma unroll
            for (int m = 0; m < 4; ++m) { GAS char* ub = blk ? base + ((size_t)((rowbase >> 4) + ai * 8 + m) * (ldc >> 5) + (colt >> 5)) * 1024 : base + ((rowbase + ai * 128 + m * 16) * ldc + colt) * 2;
                float rsd = rs.get(buf, ai * 128 + wr * 64 + m * 16 + fr); if (isgate) rsd *= -LOG2E;
#pragma unroll
                for (int bj = 0; bj < 2; ++bj) { f32x4 v0 = acc[ai][bj][m][0] * rsd, v1 = acc[ai][bj][m][1] * rsd;
                    if (isgate) {
#pragma unroll
                        for (int e = 0; e < 4; ++e) { v0[e] = __builtin_amdgcn_exp2f(v0[e]); v1[e] = __builtin_amdgcn_exp2f(v1[e]); }
                        v0 = v0 + 1.0f; v1 = v1 + 1.0f; }
                    u32x4 w; w.x = cvt_pk_bf16(v0[0], v0[1]); w.y = cvt_pk_bf16(v0[2], v0[3]); w.z = cvt_pk_bf16(v1[0], v1[1]); w.w = cvt_pk_bf16(v1[2], v1[3]);
                    if (isgate) { w.x = pk_min_u16(w.x, 0x60AD60ADu); w.y = pk_min_u16(w.y, 0x60AD60ADu); w.z = pk_min_u16(w.z, 0x60AD60ADu); w.w = pk_min_u16(w.w, 0x60AD60ADu); }
                    if (isgate) __builtin_nontemporal_store(w, (GAS u32x4*)((GAS char*)gate + ((size_t)(u.pm * 24 + pn - 30) * 16 + (ai * 4 + m) * 2 + bj) * (NTHR * 16) + tidoff));
                    else __builtin_nontemporal_store(w, (GAS u32x4*)(ub + bj * bjs + toff)); } }
    }
};
template <bool SCALE> struct EpiPlain {
    static constexpr bool PERM = true, F16 = SCALE && (RES_F16 != 0);     static __device__ __forceinline__ bool keep(const pg8::Unit&) { return false; }
    GAS bf16* O; int ldc; RowScale rs;
    __device__ __forceinline__ void prep(const pg8::Unit& u, int buf, int tid) const { if (SCALE) rs.prep(u, buf, tid); }
    __device__ __forceinline__ void operator()(f32x4 (&acc)[2][2][4][2], const pg8::Unit& u, int wr, int wc, int fr, int fq, int buf) const {
        const unsigned toff = SCALE ? (unsigned)((wr * 4 * (ldc >> 5) + wc) * 1024 + fr * 64 + fq * 16) : (unsigned)((wr * 64 + fr) * ldc + wc * 32 + 8 * fq) * 2u;
#pragma unroll
        for (int ai = 0; ai < 2; ++ai)
#pragma unroll
            for (int m = 0; m < 4; ++m) { GAS char* ub = SCALE ? (GAS char*)O + ((size_t)(u.pm * 16 + ai * 8 + m) * (ldc >> 5) + u.pn * 8) * 1024 : (GAS char*)O + ((size_t)(u.pm * 256 + ai * 128 + m * 16) * ldc + u.pn * 256) * 2;
                const float rsd = SCALE ? rs.get(buf, ai * 128 + wr * 64 + m * 16 + fr) : 1.f;
#pragma unroll
                for (int bj = 0; bj < 2; ++bj) { const f32x4 v0 = acc[ai][bj][m][0] * rsd, v1 = acc[ai][bj][m][1] * rsd;
                    u32x4 w; w.x = cvt_pk_bf16(v0[0], v0[1]); w.y = cvt_pk_bf16(v0[2], v0[3]); w.z = cvt_pk_bf16(v1[0], v1[1]); w.w = cvt_pk_bf16(v1[2], v1[3]);
                    *(GAS u32x4*)(ub + bj * (SCALE ? 4096 : 256) + toff) = w; } }
    }
};
struct EpiResid {
    static constexpr bool PERM = true, F16 = false; static __device__ __forceinline__ bool keep(const pg8::Unit&) { return false; }
    const GAS unsigned short* src; GAS unsigned short* dst; GAS float* ss; LAS float* red; GAS unsigned short* xm;
    __device__ __forceinline__ void prep(const pg8::Unit&, int, int) const {}
    __device__ __forceinline__ void operator()(f32x4 (&acc)[2][2][4][2], const pg8::Unit& u, int wr, int wc, int fr, int fq, int) const {
        const unsigned toff_ = (unsigned)((wr * 4 * (DM / 32) + wc) * 1024 + fr * 64 + fq * 16);
        unsigned toff = toff_; asm volatile("" : "+v"(toff));
        u32x4 sv[2][4][2];
#pragma unroll
        for (int ai = 0; ai < 2; ++ai)
#pragma unroll
            for (int m = 0; m < 4; ++m) { const GAS char* us = (const GAS char*)(xm ? (const GAS unsigned short*)xm : src) + ((size_t)(u.pm * 16 + ai * 8 + m) * (DM / 32) + u.pn * 8 + 2) * 1024;
#pragma unroll
                for (int bj = 0; bj < 2; ++bj) sv[ai][m][bj] = *(const GAS u32x4*)(us + (bj * 4096 - 2048) + toff); }
#pragma unroll
        for (int ai = 0; ai < 2; ++ai) {
#pragma unroll
            for (int m = 0; m < 4; ++m) { const size_t uo = ((size_t)(u.pm * 16 + ai * 8 + m) * (DM / 32) + u.pn * 8 + 2) * 1024; GAS char* ud = (GAS char*)dst + uo; GAS char* um = (GAS char*)xm + uo;
                float q = 0.f;
                if (!xm) {
                    f32x2 qv = (f32x2){0.f, 0.f};
#pragma unroll
                    for (int bj = 0; bj < 2; ++bj) { const u32x4 x = sv[ai][m][bj]; const f32x4 a0 = acc[ai][bj][m][0], a1 = acc[ai][bj][m][1];
                        const f32x2 p0 = (f32x2){res_lo(x.x), res_hi(x.x)} + (f32x2){a0[0], a0[1]}, p1 = (f32x2){res_lo(x.y), res_hi(x.y)} + (f32x2){a0[2], a0[3]};
                        const f32x2 p2 = (f32x2){res_lo(x.z), res_hi(x.z)} + (f32x2){a1[0], a1[1]}, p3 = (f32x2){res_lo(x.w), res_hi(x.w)} + (f32x2){a1[2], a1[3]};
                        u32x4 w; w.x = cvt_pk_res(p0.x, p0.y); w.y = cvt_pk_res(p1.x, p1.y); w.z = cvt_pk_res(p2.x, p2.y); w.w = cvt_pk_res(p3.x, p3.y);
                        *(GAS u32x4*)(ud + (bj * 4096 - 2048) + toff) = w;
                        qv = p0 * p0 + qv; qv = p1 * p1 + qv; qv = p2 * p2 + qv; qv = p3 * p3 + qv; }
                    q = qv.x + qv.y; }
                else
#pragma unroll
                for (int bj = 0; bj < 2; ++bj) { const u32x4 x = sv[ai][m][bj]; const f32x4 a0 = acc[ai][bj][m][0], a1 = acc[ai][bj][m][1];
                    float v0, v1, v2, v3, v4, v5, v6, v7;
                    if (xm) { v0 = h_lo(x.x) + a0[0]; v1 = h_hi(x.x) + a0[1]; v2 = h_lo(x.y) + a0[2]; v3 = h_hi(x.y) + a0[3]; v4 = h_lo(x.z) + a1[0]; v5 = h_hi(x.z) + a1[1]; v6 = h_lo(x.w) + a1[2]; v7 = h_hi(x.w) + a1[3];
                        u32x4 wm; wm.x = cvt_pk_f16(v0, v1); wm.y = cvt_pk_f16(v2, v3); wm.z = cvt_pk_f16(v4, v5); wm.w = cvt_pk_f16(v6, v7); *(GAS u32x4*)(um + (bj * 4096 - 2048) + toff) = wm; }
                    else { v0 = res_lo(x.x) + a0[0]; v1 = res_hi(x.x) + a0[1]; v2 = res_lo(x.y) + a0[2]; v3 = res_hi(x.y) + a0[3]; v4 = res_lo(x.z) + a1[0]; v5 = res_hi(x.z) + a1[1]; v6 = res_lo(x.w) + a1[2]; v7 = res_hi(x.w) + a1[3]; }
                    u32x4 w; w.x = cvt_pk_res(v0, v1); w.y = cvt_pk_res(v2, v3); w.z = cvt_pk_res(v4, v5); w.w = cvt_pk_res(v6, v7);
                    *(GAS u32x4*)(ud + (bj * 4096 - 2048) + toff) = w;
                    q += ((v0 * v0 + v1 * v1) + (v2 * v2 + v3 * v3)) + ((v4 * v4 + v5 * v5) + (v6 * v6 + v7 * v7)); }
                if (ss) { q += __shfl_xor(q, 16); q += __shfl_xor(q, 32); if (fq == 0) red[wc * 256 + ai * 128 + wr * 64 + m * 16 + fr] = q; } }
            }
        if (ss) { asm volatile("s_waitcnt lgkmcnt(0)" ::: "memory"); __builtin_amdgcn_s_barrier();
            const int t = threadIdx.x; if (t < 256) ss[((size_t)u.pm * 256 + t) * 8 + u.pn] = (red[t] + red[256 + t]) + (red[512 + t] + red[768 + t]); }
    }
};
struct EpiSwiglu {
    static constexpr bool PERM = true, F16 = (RES_F16 != 0); static __device__ __forceinline__ bool keep(const pg8::Unit&) { return false; }
    GAS bf16* O; RowScale rs;
    __device__ __forceinline__ void prep(const pg8::Unit& u, int buf, int tid) const { rs.prep(u, buf, tid); }
    __device__ __forceinline__ void operator()(f32x4 (&acc)[2][2][4][2], const pg8::Unit& u, int wr, int wc, int fr, int fq, int buf) const {
        const unsigned toff = (unsigned)((wr * 4 * (DFF / 32) + wc) * 1024 + fr * 64 + fq * 16);
#pragma unroll
        for (int ai = 0; ai < 2; ++ai)
#pragma unroll
            for (int m = 0; m < 4; ++m) { GAS char* ub = (GAS char*)O + ((size_t)(u.pm * 16 + ai * 8 + m) * (DFF / 32) + u.pn * 4) * 1024;
                const float rsd = rs.get(buf, ai * 128 + wr * 64 + m * 16 + fr); const float ca = rsd * -LOG2E, ir2 = __builtin_amdgcn_rcpf(rsd * rsd);
                unsigned wq[4];
#pragma unroll
                for (int q = 0; q < 4; ++q) { const int n = q >> 1, p = (q & 1) * 2;
                    const f32x2 g = (f32x2){acc[ai][0][m][n][p], acc[ai][0][m][n][p + 1]}, uu = (f32x2){acc[ai][1][m][n][p], acc[ai][1][m][n][p + 1]};
                    const f32x2 a = g * ca; const f32x2 d = (f32x2){__builtin_amdgcn_exp2f(a.x), __builtin_amdgcn_exp2f(a.y)} * ir2 + ir2;
                    const f32x2 o = (g * uu) * (f32x2){__builtin_amdgcn_rcpf(d.x), __builtin_amdgcn_rcpf(d.y)};
                    wq[q] = cvt_pk_bf16(o.x, o.y); }
                u32x4 w; w.x = wq[0]; w.y = wq[1]; w.z = wq[2]; w.w = wq[3];
                __builtin_nontemporal_store(w, (GAS u32x4*)(ub + toff)); }
    }
};
struct EpiBranch {
    static constexpr bool PERM = true, F16 = false; static __device__ __forceinline__ bool keep(const pg8::Unit& u) { return u.aux < 2; }
    const GAS bf16* gate; GAS bf16* merged;
    __device__ __forceinline__ void prep(const pg8::Unit&, int, int) const {}
    __device__ __forceinline__ void operator()(f32x4 (&acc)[2][2][4][2], const pg8::Unit& u, int wr, int wc, int fr, int fq, int) const {
        const int j = u.aux;
        const unsigned toffg_ = (unsigned)threadIdx.x * 16u, toffm_ = (unsigned)((wr * 4 * (DM / 32) + wc) * 1024 + fr * 64 + fq * 16);
#pragma unroll
        for (int ai = 0; ai < 2; ++ai) {
            unsigned toffg = toffg_, toffm = toffm_; asm volatile("" : "+v"(toffg), "+v"(toffm));
            u32x4 gw[4][2], gn[4][2];
#pragma unroll
            for (int m = 0; m < 4; ++m) { const GAS char* ug = (const GAS char*)gate + ((size_t)(u.pm * 24 + j * 8 + u.pn) * 16 + (ai * 4 + m) * 2) * (NTHR * 16);
#pragma unroll
                for (int bj = 0; bj < 2; ++bj) { gw[m][bj] = *(const GAS u32x4*)(ug + bj * (NTHR * 16) + toffg); if (j < 2) gn[m][bj] = *(const GAS u32x4*)(ug + (size_t)8 * 16 * (NTHR * 16) + bj * (NTHR * 16) + toffg); } }
#pragma unroll
            for (int m = 0; m < 4; ++m) { GAS char* um = (GAS char*)merged + ((size_t)(u.pm * 16 + ai * 8 + m) * (DM / 32) + u.pn * 8 + 2) * 1024;
#pragma unroll
                for (int bj = 0; bj < 2; ++bj) { const u32x4 g0 = gw[m][bj];
                    float s[8] = {bf_lo(g0.x), bf_hi(g0.x), bf_lo(g0.y), bf_hi(g0.y), bf_lo(g0.z), bf_hi(g0.z), bf_lo(g0.w), bf_hi(g0.w)};
#pragma unroll
                    for (int e = 0; e < 8; ++e) s[e] = __builtin_amdgcn_rcpf(s[e]);
                    if (j < 2) { const u32x4 g1 = gn[m][bj];
                        const float d[8] = {bf_lo(g1.x), bf_hi(g1.x), bf_lo(g1.y), bf_hi(g1.y), bf_lo(g1.z), bf_hi(g1.z), bf_lo(g1.w), bf_hi(g1.w)};
#pragma unroll
                        for (int e = 0; e < 8; ++e) s[e] = s[e] * d[e]; }
                    if (j < 2) { acc[ai][bj][m][0] *= (f32x4){s[0], s[1], s[2], s[3]}; acc[ai][bj][m][1] *= (f32x4){s[4], s[5], s[6], s[7]}; }
                    else { f32x4 v0 = acc[ai][bj][m][0], v1 = acc[ai][bj][m][1];
                        v0[0] *= s[0]; v0[1] *= s[1]; v0[2] *= s[2]; v0[3] *= s[3]; v1[0] *= s[4]; v1[1] *= s[5]; v1[2] *= s[6]; v1[3] *= s[7];
                        u32x4 w; w.x = cvt_pk_bf16(v0[0], v0[1]); w.y = cvt_pk_bf16(v0[2], v0[3]); w.z = cvt_pk_bf16(v1[0], v1[1]); w.w = cvt_pk_bf16(v1[2], v1[3]);
                        *(GAS u32x4*)(um + (bj * 4096 - 2048) + toffm) = w; } } }
            }
    }
};

__device__ __forceinline__ void tr_item(const GAS float* W, int N, GAS bf16* WT, int ldd, int k0, int n0, int drow0, LAS float* scr, int lane, const GAS float* gain = nullptr) {
    const float gv = gain ? gain[k0 + lane] : 1.f;
#pragma unroll 8
    for (int i = 0; i < 32; ++i) { const int kk = 2 * i + (lane >> 5); scr[kk * 33 + (lane & 31)] = W[(size_t)(k0 + kk) * N + n0 + (lane & 31)] * __shfl(gv, kk); }
    LDS_WAIT(); asm volatile("" ::: "memory");
    const int c = lane & 7;
#pragma unroll
    for (int j = 0; j < 4; ++j) { const int n = (lane >> 3) + 8 * j; const LAS float* s = scr + (8 * c) * 33 + n;
        u32x4 o;
        if (gain && RES_F16) { o.x = cvt_pk_f16(s[0 * 33], s[1 * 33]); o.y = cvt_pk_f16(s[2 * 33], s[3 * 33]); o.z = cvt_pk_f16(s[4 * 33], s[5 * 33]); o.w = cvt_pk_f16(s[6 * 33], s[7 * 33]); }
        else { o.x = cvt_pk_bf16(s[0 * 33], s[1 * 33]); o.y = cvt_pk_bf16(s[2 * 33], s[3 * 33]); o.z = cvt_pk_bf16(s[4 * 33], s[5 * 33]); o.w = cvt_pk_bf16(s[6 * 33], s[7 * 33]); }
        *(GAS u32x4*)((GAS char*)WT + pg8::blk16x32((size_t)(drow0 + n), k0 + 8 * c, ldd)) = o; }
    LDS_WAIT(); asm volatile("" ::: "memory");
}
__device__ __forceinline__ void rms_row_bf16(const GAS float* xrow, const f32x4 (&gv)[8], GAS bf16* orow, int lane) {
    const GAS f32x4* xr = (const GAS f32x4*)xrow + lane;
    f32x4 v[8]; float s = 0.f;
#pragma unroll
    for (int j = 0; j < 8; ++j) { v[j] = xr[64 * j]; s += (v[j].x * v[j].x + v[j].y * v[j].y) + (v[j].z * v[j].z + v[j].w * v[j].w); }
    const float rstd = __builtin_amdgcn_rsqf(wave_sum(s) * (1.f / DM) + EPS);
    GAS u32x2* o8 = (GAS u32x2*)orow + lane;
#pragma unroll
    for (int j = 0; j < 8; ++j) { const f32x4 y = v[j] * rstd * gv[j]; u32x2 w; w.x = cvt_pk_bf16(y.x, y.y); w.y = cvt_pk_bf16(y.z, y.w); o8[64 * j] = w; }
}
__device__ __forceinline__ void norm_phase(const GAS float* src, const GAS float* gain, GAS bf16* dst, int nrows, int gw, int NGW, int lane) {
    f32x4 gv[8];
#pragma unroll
    for (int j = 0; j < 8; ++j) gv[j] = ((const GAS f32x4*)gain)[lane + 64 * j];
    for (int m = gw; m < nrows; m += NGW) rms_row_bf16(src + (size_t)m * DM, gv, dst + (size_t)m * DM, lane);
}
__device__ __forceinline__ void xb_phase(const GAS float* src, GAS bf16* xb, GAS unsigned short* xm, GAS float* ss, int gw, int NGW, int lane) {
    for (int m = gw; m < T; m += NGW) {
        const GAS f32x4* xr = (const GAS f32x4*)(src + (size_t)m * DM) + lane; GAS char* o8 = (GAS char*)xb + (size_t)(m >> 4) * (DM / 32) * 1024 + (m & 15) * 64 + (lane >> 3) * 1024 + (lane & 7) * 8;   GAS u32x2* m8 = (GAS u32x2*)(xm + (size_t)m * DM) + lane;
        f32x4 v[8]; float q[8];
#pragma unroll
        for (int j = 0; j < 8; ++j) { v[j] = xr[64 * j]; q[j] = (v[j].x * v[j].x + v[j].y * v[j].y) + (v[j].z * v[j].z + v[j].w * v[j].w); }
#pragma unroll
        for (int j = 0; j < 8; ++j) { u32x2 w; w.x = cvt_pk_res(v[j].x, v[j].y); w.y = cvt_pk_res(v[j].z, v[j].w); *(GAS u32x2*)(o8 + j * 8192) = w;
            if (xm) { u32x2 wm; wm.x = cvt_pk_f16(v[j].x, v[j].y); wm.y = cvt_pk_f16(v[j].z, v[j].w); m8[64 * j] = wm; } }
#pragma unroll
        for (int o = 1; o < 64; o <<= 1)
#pragma unroll
            for (int j = 0; j < 8; ++j) q[j] += __shfl_xor(q[j], o);
        if (lane == 0) { GAS f32x4* sp = (GAS f32x4*)(ss + (size_t)m * 8); sp[0] = (f32x4){q[0], q[1], q[2], q[3]}; sp[1] = (f32x4){q[4], q[5], q[6], q[7]}; }
    }
}
__device__ __forceinline__ void final_norm_phase(const GAS unsigned short* xh, GAS float* out, const GAS float* gain, const GAS float* ss, int gw, int NGW, int lane) {
    f32x4 gv[8];
#pragma unroll
    for (int j = 0; j < 8; ++j) gv[j] = ((const GAS f32x4*)gain)[lane + 64 * j];
    for (int m = gw; m < T; m += NGW) {
        const GAS char* xr = (const GAS char*)xh + (size_t)(m >> 4) * (DM / 32) * 1024 + (m & 15) * 64 + (lane >> 3) * 1024 + (lane & 7) * 8; GAS f32x4* orow = (GAS f32x4*)(out + (size_t)m * DM) + lane;
        const GAS f32x4* sp = (const GAS f32x4*)(ss + (size_t)m * 8); const f32x4 a = sp[0], b = sp[1];
        const float rstd = __builtin_amdgcn_rsqf(((a.x + a.y) + (a.z + a.w) + (b.x + b.y) + (b.z + b.w)) * (1.f / DM) + EPS);
        u32x2 v[8];
#pragma unroll
        for (int j = 0; j < 8; ++j) v[j] = *(const GAS u32x2*)(xr + j * 8192);
#pragma unroll
        for (int j = 0; j < 8; ++j) orow[64 * j] = (f32x4){res_lo(v[j].x), res_hi(v[j].x), res_lo(v[j].y), res_hi(v[j].y)} * rstd * gv[j];
    }
}
typedef short s16x4 __attribute__((ext_vector_type(4)));
__device__ __forceinline__ s16x4 tr_read(const LAS unsigned char* p) { return __builtin_bit_cast(s16x4, __builtin_amdgcn_ds_read_tr16_b64_v4i16((LAS s16x4*)p)); }
template <int HD, bool SWA>
__device__ __forceinline__ void attn_wave32(const LAS unsigned char* Ks, int kstr, const LAS unsigned char* Vt, int vstr, const bf16x8 (&qf)[2][HD / 32], f32x4 (&o)[2][HD / 16],
                                            float m0, float l0, float c2, int kt_lo, int kt_hi, int t0, bool first_blk, int lane) {
    const int fr = lane & 15, g = lane >> 4;
    float mrow[2] = {m0, m0}, lrow[2] = {l0, l0};
#pragma unroll
    for (int mt = 0; mt < 2; ++mt)
#pragma unroll
        for (int dt = 0; dt < HD / 16; ++dt) o[mt][dt] = (f32x4){0.f, 0.f, 0.f, 0.f};
    for (int kt = kt_lo; kt <= kt_hi; ++kt) {
        f32x4 s[2][4];
#pragma unroll
        for (int mt = 0; mt < 2; ++mt)
#pragma unroll
            for (int nt = 0; nt < 4; ++nt) s[mt][nt] = (f32x4){0.f, 0.f, 0.f, 0.f};
#pragma unroll
        for (int nt = 0; nt < 4; ++nt)
#pragma unroll
            for (int kk = 0; kk < HD / 32; ++kk) {
                const bf16x8 kf = *(const LAS bf16x8*)(Ks + (kt * 64 + nt * 16 + fr) * kstr + (kk * 32 + g * 8) * 2);
#pragma unroll
                for (int mt = 0; mt < 2; ++mt) s[mt][nt] = __builtin_amdgcn_mfma_f32_16x16x32_bf16(kf, qf[mt][kk], s[mt][nt], 0, 0, 0);
            }
#pragma unroll
        for (int mt = 0; mt < 2; ++mt) {
            float rm = -INFINITY;
#pragma unroll
            for (int nt = 0; nt < 4; ++nt)
#pragma unroll
                for (int e = 0; e < 4; ++e) {
                    float v = s[mt][nt][e] * c2;
                    if (SWA) { const int sidx = kt * 64 + nt * 16 + g * 4 + e, t = t0 + mt * 16 + fr;
                        const bool valid = (sidx > t) && (sidx <= t + 128) && (!first_blk || sidx >= 128); v = valid ? v : -INFINITY; }
                    s[mt][nt][e] = v; rm = fmaxf(rm, v);
                }
            rm = fmaxf(rm, __shfl_xor(rm, 16)); rm = fmaxf(rm, __shfl_xor(rm, 32));
            const float mn = fmaxf(mrow[mt], rm);
            const float alpha = __builtin_amdgcn_exp2f(mrow[mt] - mn);
            float rs = 0.f;
#pragma unroll
            for (int nt = 0; nt < 4; ++nt)
#pragma unroll
                for (int e = 0; e < 4; ++e) { const float p = __builtin_amdgcn_exp2f(s[mt][nt][e] - mn); s[mt][nt][e] = p; rs += p; }
            rs += __shfl_xor(rs, 16); rs += __shfl_xor(rs, 32);
            lrow[mt] = lrow[mt] * alpha + rs; mrow[mt] = mn;
#pragma unroll
            for (int dt = 0; dt < HD / 16; ++dt) o[mt][dt] *= alpha;
        }
        bf16x8 pf[2][2];
#pragma unroll
        for (int mt = 0; mt < 2; ++mt)
#pragma unroll
            for (int k2 = 0; k2 < 2; ++k2) {
                u32x4 w; w.x = cvt_pk_bf16(s[mt][2 * k2][0], s[mt][2 * k2][1]); w.y = cvt_pk_bf16(s[mt][2 * k2][2], s[mt][2 * k2][3]);
                w.z = cvt_pk_bf16(s[mt][2 * k2 + 1][0], s[mt][2 * k2 + 1][1]); w.w = cvt_pk_bf16(s[mt][2 * k2 + 1][2], s[mt][2 * k2 + 1][3]);
                pf[mt][k2] = __builtin_bit_cast(bf16x8, w);
            }
#pragma unroll
        for (int dt = 0; dt < HD / 16; ++dt)
#pragma unroll
            for (int k2 = 0; k2 < 2; ++k2) {
                const LAS unsigned char* vblk = Vt + (kt * 64 + k2 * 32 + g * 4 + (fr >> 2)) * vstr + (dt * 16 + (fr & 3) * 4) * 2;
                const s16x4 lo = tr_read(vblk), hi = tr_read(vblk + 16 * vstr);
                const bf16x8 vf = __builtin_shufflevector(lo, hi, 0, 1, 2, 3, 4, 5, 6, 7);
#pragma unroll
                for (int mt = 0; mt < 2; ++mt) o[mt][dt] = __builtin_amdgcn_mfma_f32_16x16x32_bf16(vf, pf[mt][k2], o[mt][dt], 0, 0, 0);
            }
    }
#pragma unroll
    for (int mt = 0; mt < 2; ++mt) { const float inv = 1.0f / lrow[mt];
#pragma unroll
        for (int dt = 0; dt < HD / 16; ++dt) o[mt][dt] *= inv; }
}

__device__ __forceinline__ void vt_scatter(LAS unsigned char* Vt, int vstr, int d0, int key, u32x4 v) {
    LAS unsigned char* p = Vt + d0 * vstr + key * 2;
    *(LAS bf16*)(p + 0 * vstr) = (bf16)(v.x & 0xffffu); *(LAS bf16*)(p + 1 * vstr) = (bf16)(v.x >> 16);
    *(LAS bf16*)(p + 2 * vstr) = (bf16)(v.y & 0xffffu); *(LAS bf16*)(p + 3 * vstr) = (bf16)(v.y >> 16);
    *(LAS bf16*)(p + 4 * vstr) = (bf16)(v.z & 0xffffu); *(LAS bf16*)(p + 5 * vstr) = (bf16)(v.z >> 16);
    *(LAS bf16*)(p + 6 * vstr) = (bf16)(v.w & 0xffffu); *(LAS bf16*)(p + 7 * vstr) = (bf16)(v.w >> 16);
}

__device__ __forceinline__ void swa_loop(unsigned* qctr, volatile LAS unsigned* lctl, const GAS bf16* proj, const GAS float* sinks_l, GAS bf16* Y, LAS unsigned char* lds, int tid) {
    const int lane = tid & 63, w = __builtin_amdgcn_readfirstlane(tid >> 6), fr = lane & 15, g = lane >> 4;
    constexpr int KSTR = 144, VSTR = 160, NU = NB * 64;
    LAS unsigned char* Ks = lds; LAS unsigned char* Vt = lds + 256 * KSTR;
    u32x4 kr[4], vr[4];
    unsigned kvoff = (unsigned)((((tid >> 7) * 48 + ((tid & 7) >> 2)) << 10) + ((tid >> 3) & 15) * 64 + (tid & 3) * 16); asm volatile("" : "+v"(kvoff));
#define SWA_LOADKV(unit) do { const int b_ = (unit) >> 6, kvh_ = ((unit) >> 4) & 3, blk_ = (unit) & 15; _Pragma("unroll") for (int i = 0; i < 4; ++i) { \
        const int rb_ = (blk_ == 0) ? b_ * 128 + 4 * (i & 1) : b_ * 128 + (blk_ - 1) * 8 + 4 * i;     \
        const GAS char* src = (const GAS char*)proj + ((size_t)rb_ * 48 + (C_KA >> 5) + kvh_ * 2) * 1024 + kvoff; \
        kr[i] = *(const GAS u32x4*)src; vr[i] = *(const GAS u32x4*)(src + ((C_VA - C_KA) >> 5) * 1024); } } while (0)
    unsigned pend = 0u;
    __syncthreads();
    if (tid == 0) { lctl[4] = xb_add(qctr, 1u); lctl[5] = xb_add(qctr, 1u); pend = xb_add(qctr, 1u); }
    __syncthreads();
    int idx = (int)lctl[4], nidx = (int)lctl[5];
    if (idx < NU) SWA_LOADKV(idx);
    int par = 0;
    while (idx < NU) {
        const int b = idx >> 6, kvh = (idx >> 4) & 3, blk = idx & 15;
        __syncthreads();
#pragma unroll
        for (int i = 0; i < 4; ++i) { const int c = tid + NTHR * i, key = c >> 3, part = c & 7; *(LAS u32x4*)(Ks + key * KSTR + part * 16) = kr[i]; *(LAS u32x4*)(Vt + key * VSTR + part * 16) = vr[i]; }
        if (tid == 0) { lctl[6 + par] = pend; pend = xb_add(qctr, 1u); }
        __syncthreads();
        const int nnidx = (int)lctl[6 + par]; par ^= 1;
        const int head = kvh * 4 + (w >> 1), half = w & 1;
        const float sink2 = sinks_l[head] * LOG2E;
        bf16x8 qf[2][2][2]; unsigned qoff = (unsigned)(fr * 64 + g * 16); asm volatile("" : "+v"(qoff));
#pragma unroll
        for (int pass = 0; pass < 2; ++pass)
#pragma unroll
            for (int mt = 0; mt < 2; ++mt)
#pragma unroll
                for (int kk = 0; kk < 2; ++kk) qf[pass][mt][kk] = *(const GAS bf16x8*)((const GAS char*)proj + ((size_t)(b * 128 + blk * 8 + half * 4 + pass * 2 + mt) * 48 + head * 2 + kk) * 1024 + qoff);
        if (nidx < NU) SWA_LOADKV(nidx);
#pragma unroll
        for (int pass = 0; pass < 2; ++pass) {
            const int t0 = half * 64 + pass * 32;
            int kt_lo = (t0 + 1) >> 6; const int kt_hi = (t0 + 159) >> 6; if (blk == 0 && kt_lo < 2) kt_lo = 2;
            f32x4 o[2][4];
            attn_wave32<64, true>(Ks, KSTR, Vt, VSTR, qf[pass], o, sink2, 1.0f, 0.125f * LOG2E, kt_lo, kt_hi, t0, blk == 0, lane);
#pragma unroll
            for (int mt = 0; mt < 2; ++mt)
#pragma unroll
                for (int dt = 0; dt < 4; ++dt) { u32x2 wv; wv.x = cvt_pk_bf16(o[mt][dt][0], o[mt][dt][1]); wv.y = cvt_pk_bf16(o[mt][dt][2], o[mt][dt][3]);
                    *(GAS u32x2*)((GAS char*)Y + pg8::blk16x32((size_t)(b * SEQ + blk * 128 + t0 + mt * 16 + fr), head * 64 + dt * 16 + g * 4, YW)) = wv; }
        }
        idx = nidx; nidx = nnidx;
    }
    __syncthreads();
#undef SWA_LOADKV
}

__device__ __forceinline__ void xattn_unit(int unit, int l, const GAS bf16* KV, const GAS bf16* XQ, GAS bf16* XO, LAS unsigned char* lds, int tid, bool stage) {
    const int b = unit >> 5, head = (unit >> 3) & 3, qb = unit & 7;
    const int lane = tid & 63, w = __builtin_amdgcn_readfirstlane(tid >> 6), fr = lane & 15, g = lane >> 4;
    constexpr int KSTR = 272, VSTR = 288;
    LAS unsigned char* Ks = lds; LAS unsigned char* Vt = lds + 256 * KSTR;
    const size_t row0 = (size_t)b * SEQ + qb * 256 + w * 32;
    bf16x8 qf[2][4]; unsigned xoff = (unsigned)(fr * 64 + g * 16), yoff = (unsigned)(fr * 64 + g * 8); asm volatile("" : "+v"(xoff), "+v"(yoff));
#pragma unroll
    for (int mt = 0; mt < 2; ++mt)
#pragma unroll
        for (int kk = 0; kk < 4; ++kk) qf[mt][kk] = *(const GAS bf16x8*)((const GAS char*)XQ + (((row0 >> 4) + mt) * 16 + head * 4 + kk) * 1024 + xoff);
    if (stage) {
        __syncthreads();
#pragma unroll
        for (int i = 0; i < 8; ++i) { const int c = tid + NTHR * i, key = c >> 4, part = c & 15;
            const GAS bf16* src = KV + (size_t)(b * MEML + key) * 4096 + l * 1024 + head * 128 + part * 8;
            const u32x4 kv = *(const GAS u32x4*)src; const u32x4 vv = *(const GAS u32x4*)(src + 512);
            *(LAS u32x4*)(Ks + key * KSTR + part * 16) = kv; *(LAS u32x4*)(Vt + key * VSTR + part * 16) = vv; }
        __syncthreads();
    }
    f32x4 o[2][8];
    attn_wave32<128, false>(Ks, KSTR, Vt, VSTR, qf, o, -INFINITY, 0.0f, 0.08838834764831845f * LOG2E, 0, 3, 0, false, lane);
#pragma unroll
    for (int mt = 0; mt < 2; ++mt)
#pragma unroll
        for (int dt = 0; dt < 8; ++dt) { u32x2 wv; wv.x = cvt_pk_bf16(o[mt][dt][0], o[mt][dt][1]); wv.y = cvt_pk_bf16(o[mt][dt][2], o[mt][dt][3]);
            *(GAS u32x2*)((GAS char*)XO + (((row0 >> 4) + mt) * 16 + head * 4 + (dt >> 1)) * 1024 + (dt & 1) * 32 + yoff) = wv; }
}

__device__ __forceinline__ void sgu_unit(int unit, const GAS bf16* ubuf, const GAS bf16* vbuf, const GAS float* ln_g, const GAS float* ln_b, const GAS float* sw, const GAS float* sb, GAS bf16* Y, LAS unsigned char* lds, int tid) {
    const int b = unit >> 4, c = unit & 15;
    const int lane = tid & 63, w = __builtin_amdgcn_readfirstlane(tid >> 6), fr = lane & 15, g = lane >> 4;
    constexpr int VSTR = 288, WSTR = 272;
    LAS unsigned char* VN = lds; LAS unsigned char* Ws = lds + 128 * VSTR; LAS float* stat = (LAS float*)(lds + 128 * VSTR + 128 * WSTR);
    const size_t tok0 = (size_t)b * SEQ + c * 128;
    u32x4 va[4]; f32x4 wv[8]; u32x2 uu[8];
    unsigned vaoff = (unsigned)((((tid >> 8) * 32 + ((tid & 15) >> 2)) << 10) + ((tid >> 4) & 15) * 64 + (tid & 3) * 16), uuoff = (unsigned)(w * 32768 + fr * 64 + g * 8), stoff = (unsigned)(w * 32768 + (lane >> 1) * 1024 + (lane & 1) * 32);
    asm volatile("" : "+v"(vaoff), "+v"(uuoff), "+v"(stoff));
#define SGU_LOAD(gg) do { _Pragma("unroll") for (int i = 0; i < 4; ++i) { const int cc = tid + NTHR * i, s = cc >> 4, part = cc & 15; (void)s; (void)part; va[i] = *(const GAS u32x4*)((const GAS char*)vbuf + (((tok0 >> 4) + 2 * i) * 32 + (gg) * 4) * 1024 + vaoff); }     \
        _Pragma("unroll") for (int i = 0; i < 8; ++i) { const int idx = tid + NTHR * i; wv[i] = *(const GAS f32x4*)(sw + (size_t)(gg) * 16384 + idx * 4); } \
        _Pragma("unroll") for (int et = 0; et < 8; ++et) uu[et] = *(const GAS u32x2*)((const GAS char*)ubuf + ((tok0 >> 4) * 32 + (gg) * 4) * 1024 + uuoff + ((et >> 1) * 1024 + (et & 1) * 32)); } while (0)
    SGU_LOAD(0);
    __syncthreads();
    for (int bt = 0; bt < 2; ++bt) {
        u32x4 a0[8], a1[8];
#pragma unroll
        for (int i = 0; i < 8; ++i) { const GAS char* src = (const GAS char*)vbuf + (tok0 >> 4) * 32768 + stoff + (bt * 8 + i) * 64; a0[i] = *(const GAS u32x4*)src; a1[i] = *(const GAS u32x4*)(src + 16); }
        float s1[8], s2[8];
#pragma unroll
        for (int i = 0; i < 8; ++i) { float x[16];
            x[0] = geluf_(bf_lo(a0[i].x)); x[1] = geluf_(bf_hi(a0[i].x)); x[2] = geluf_(bf_lo(a0[i].y)); x[3] = geluf_(bf_hi(a0[i].y));
            x[4] = geluf_(bf_lo(a0[i].z)); x[5] = geluf_(bf_hi(a0[i].z)); x[6] = geluf_(bf_lo(a0[i].w)); x[7] = geluf_(bf_hi(a0[i].w));
            x[8] = geluf_(bf_lo(a1[i].x)); x[9] = geluf_(bf_hi(a1[i].x)); x[10] = geluf_(bf_lo(a1[i].y)); x[11] = geluf_(bf_hi(a1[i].y));
            x[12] = geluf_(bf_lo(a1[i].z)); x[13] = geluf_(bf_hi(a1[i].z)); x[14] = geluf_(bf_lo(a1[i].w)); x[15] = geluf_(bf_hi(a1[i].w));
            float p1 = 0.f, p2 = 0.f;
#pragma unroll
            for (int e = 0; e < 16; ++e) { p1 += x[e]; p2 += x[e] * x[e]; }
            s1[i] = p1; s2[i] = p2; }
#pragma unroll
        for (int o = 1; o < 64; o <<= 1)
#pragma unroll
            for (int i = 0; i < 8; ++i) { s1[i] += __shfl_xor(s1[i], o); s2[i] += __shfl_xor(s2[i], o); }
        if (lane < 8) { float m1 = s1[0], m2 = s2[0];
#pragma unroll
            for (int i = 1; i < 8; ++i) { m1 = (lane == i) ? s1[i] : m1; m2 = (lane == i) ? s2[i] : m2; }
            const float mean = m1 * (1.f / 1024.f); const float var = fmaxf(m2 * (1.f / 1024.f) - mean * mean, 0.f);
            const int s = w * 16 + bt * 8 + lane; stat[2 * s] = mean; stat[2 * s + 1] = __builtin_amdgcn_rsqf(var + EPS); }
    }
    __syncthreads();
    for (int grp = 0; grp < 8; ++grp) {
#pragma unroll
        for (int i = 0; i < 4; ++i) { const int cc = tid + NTHR * i, s = cc >> 4, part = cc & 15; const int ch = grp * 128 + part * 8;
            const f32x4 g0 = *(const GAS f32x4*)(ln_g + ch), g1 = *(const GAS f32x4*)(ln_g + ch + 4), b0 = *(const GAS f32x4*)(ln_b + ch), b1 = *(const GAS f32x4*)(ln_b + ch + 4);
            const float mean = stat[2 * s], rstd = stat[2 * s + 1]; const u32x4 a0 = va[i];
            float y[8];
            y[0] = (geluf_(bf_lo(a0.x)) - mean) * rstd * g0.x + b0.x; y[1] = (geluf_(bf_hi(a0.x)) - mean) * rstd * g0.y + b0.y;
            y[2] = (geluf_(bf_lo(a0.y)) - mean) * rstd * g0.z + b0.z; y[3] = (geluf_(bf_hi(a0.y)) - mean) * rstd * g0.w + b0.w;
            y[4] = (geluf_(bf_lo(a0.z)) - mean) * rstd * g1.x + b1.x; y[5] = (geluf_(bf_hi(a0.z)) - mean) * rstd * g1.y + b1.y;
            y[6] = (geluf_(bf_lo(a0.w)) - mean) * rstd * g1.z + b1.z; y[7] = (geluf_(bf_hi(a0.w)) - mean) * rstd * g1.w + b1.w;
            u32x4 pk; pk.x = cvt_pk_bf16(y[0], y[1]); pk.y = cvt_pk_bf16(y[2], y[3]); pk.z = cvt_pk_bf16(y[4], y[5]); pk.w = cvt_pk_bf16(y[6], y[7]);
            *(LAS u32x4*)(VN + s * VSTR + part * 16) = pk; }
#pragma unroll
        for (int i = 0; i < 8; ++i) { const int idx = tid + NTHR * i, t = idx >> 5, s4 = (idx & 31) * 4; f32x4 x = wv[i];
            x.x = (s4 + 0 <= t) ? x.x : 0.f; x.y = (s4 + 1 <= t) ? x.y : 0.f; x.z = (s4 + 2 <= t) ? x.z : 0.f; x.w = (s4 + 3 <= t) ? x.w : 0.f;
            u32x2 pk; pk.x = cvt_pk_bf16(x.x, x.y); pk.y = cvt_pk_bf16(x.z, x.w);
            *(LAS u32x2*)(Ws + t * WSTR + s4 * 2) = pk; }
        u32x2 uc[8];
#pragma unroll
        for (int et = 0; et < 8; ++et) uc[et] = uu[et];
        __syncthreads();
        if (grp + 1 < 8) SGU_LOAD(grp + 1);
        f32x4 acc[8];
#pragma unroll
        for (int et = 0; et < 8; ++et) acc[et] = (f32x4){0.f, 0.f, 0.f, 0.f};
        const int nkk = ((w * 16 + 15) >> 5) + 1;
        for (int kk = 0; kk < nkk; ++kk) {
            const LAS unsigned char* wrow = Ws + (w * 16 + fr) * WSTR + (kk * 32 + g * 4) * 2;
            const u32x2 ylo = *(const LAS u32x2*)wrow, yhi = *(const LAS u32x2*)(wrow + 32);
            u32x4 yw; yw.x = ylo.x; yw.y = ylo.y; yw.z = yhi.x; yw.w = yhi.y; const bf16x8 yf = __builtin_bit_cast(bf16x8, yw);
#pragma unroll
            for (int et = 0; et < 8; ++et) { const LAS unsigned char* vblk = VN + (kk * 32 + g * 4 + (fr >> 2)) * VSTR + (et * 16 + (fr & 3) * 4) * 2;
                const s16x4 lo = tr_read(vblk), hi = tr_read(vblk + 16 * VSTR);
                acc[et] = __builtin_amdgcn_mfma_f32_16x16x32_bf16(__builtin_shufflevector(lo, hi, 0, 1, 2, 3, 4, 5, 6, 7), yf, acc[et], 0, 0, 0); }
        }
        const int t = w * 16 + fr; const float bias = sb[grp * 128 + t];
#pragma unroll
        for (int et = 0; et < 8; ++et) { const int ch = grp * 128 + et * 16 + g * 4; const u32x2 u2 = uc[et];
            const float o0 = geluf_(bf_lo(u2.x)) * (acc[et][0] + bias), o1 = geluf_(bf_hi(u2.x)) * (acc[et][1] + bias), o2 = geluf_(bf_lo(u2.y)) * (acc[et][2] + bias), o3 = geluf_(bf_hi(u2.y)) * (acc[et][3] + bias);
            u32x2 wo; wo.x = cvt_pk_bf16(o0, o1); wo.y = cvt_pk_bf16(o2, o3);
            *(GAS u32x2*)((GAS char*)Y + pg8::blk16x32((size_t)(tok0 + t), 1024 + ch, YW)) = wo; }
        __syncthreads();
    }
#undef SGU_LOAD
}

__device__ __forceinline__ void hgrn_unit(int unit, int l, const GAS bf16* hb, const GAS float* hgrn_lb, const GAS float* norm_g, GAS bf16* Y, LAS unsigned char* lds, int tid) {
    const int b = unit >> 3, h = unit & 7;
    const int lane = tid & 63, w = __builtin_amdgcn_readfirstlane(tid >> 6), fr = lane & 15, g = lane >> 4;
    const int d = tid & 127, J = tid >> 7, Ju = w >> 1;
    constexpr int US = 160, WS = 352, TS = 144;
    LAS unsigned char* U = lds; LAS unsigned char* Qe = lds + 20480; LAS unsigned char* Wm = lds + 40960; LAS unsigned char* KeT = lds + 86016; LAS unsigned char* VT = lds + 104448;
    LAS unsigned char* Am = lds + 122880; LAS float* Gs = (LAS float*)(lds + 132096); LAS float* DEC = (LAS float*)(lds + 134144); LAS float* SS = (LAS float*)(lds + 134656);
    const int ch = h * 128 + d;
    float lb;
    { const float v0 = hgrn_lb[ch], v1 = hgrn_lb[1024 + ch], v2 = hgrn_lb[2048 + ch], v3 = hgrn_lb[3072 + ch];
      const float mx = fmaxf(fmaxf(v0, v1), fmaxf(v2, v3));
      const float e0 = __expf(v0 - mx), e1 = __expf(v1 - mx), e2 = __expf(v2 - mx), e3 = __expf(v3 - mx); const float inv = 1.0f / (e0 + e1 + e2 + e3);
      lb = (l >= 1 ? e1 * inv : 0.f) + (l >= 2 ? e2 * inv : 0.f) + (l >= 3 ? e3 * inv : 0.f); }
    __syncthreads();
    for (int i = tid; i < 9216 / 4; i += NTHR) ((LAS unsigned*)Am)[i] = 0u;
    f32x4 st[8];
#pragma unroll
    for (int dt = 0; dt < 8; ++dt) st[dt] = (f32x4){0.f, 0.f, 0.f, 0.f};
    const int base_J = (J == 0) ? 0 : (J == 1) ? 16 : (J == 2) ? 48 : 96;
    constexpr size_t HBS = (size_t)32 << 20;
    const GAS bf16* pb = hb + (size_t)((b * 8 + h) * SEQ) * 128;
    const f32x4 ngv = *(const GAS f32x4*)(norm_g + w * 16 + g * 4);
    unsigned fraw[16], qraw[16], iraw[16];
#define HG_LOAD(cc) do { const GAS bf16* cb_ = pb + (size_t)(((cc) * 4 + Ju) * 4 + (w & 1) * 2) * 512 + hgoff;     \
        _Pragma("unroll") for (int tt = 0; tt < 16; ++tt) { fraw[tt] = cb_[tt * 32]; iraw[tt] = cb_[HBS + tt * 32]; qraw[tt] = cb_[2 * HBS + tt * 32]; } } while (0)
    unsigned hgoff = (unsigned)((lane >> 5) * 512 + (lane & 31)); asm volatile("" : "+v"(hgoff));
    HG_LOAD(0);
    for (int c = 0; c < 32; ++c) {
        const int tok0 = c * 64;
        u32x2 ggv[4];
#pragma unroll
        for (int tt = 0; tt < 4; ++tt) ggv[tt] = *(const GAS u32x2*)(pb + 3 * HBS + (size_t)((c * 4 + tt) * 4 + (w >> 1)) * 512 + (fr * 32 + (w & 1) * 16 + g * 4));
        float f[16], qs[16]; unsigned vraw[8];
        {
            float gp = 1.f;
#pragma unroll
            for (int tt = 0; tt < 16; ++tt) {
                const float fl = __builtin_bit_cast(float, fraw[tt] << 16), qv = __builtin_bit_cast(float, qraw[tt] << 16); const unsigned iv = iraw[tt];
                f[tt] = lb + (1.f - lb) * sigmoidf_(fl); qs[tt] = siluf_(qv) * 0.08838834764831845f; gp *= f[tt];
                if (tt & 1) vraw[tt >> 1] |= iv << 16; else vraw[tt >> 1] = iv; }
            Gs[J * 128 + d] = gp;
        }
        __syncthreads();
        {
            const float G0 = Gs[d], G1 = Gs[128 + d], G2 = Gs[256 + d], G3 = Gs[384 + d];
            const float EJ = (J == 0) ? 1.f : (J == 1) ? G0 : (J == 2) ? G0 * G1 : G0 * G1 * G2;
            const float TJ = (J == 0) ? G1 * G2 * G3 : (J == 1) ? G2 * G3 : (J == 2) ? G3 : 1.f;
            if (J == 0) DEC[d] = G0 * G1 * G2 * G3;
            *(LAS u32x4*)(VT + d * TS + J * 32) = (u32x4){vraw[0], vraw[1], vraw[2], vraw[3]};
            *(LAS u32x4*)(VT + d * TS + J * 32 + 16) = (u32x4){vraw[4], vraw[5], vraw[6], vraw[7]};
            float p = 1.f; unsigned up[8], qp[8], wd[8];
#pragma unroll
            for (int t2 = 0; t2 < 8; ++t2) { float u0, u1, k0, k1;
                p *= f[2 * t2]; u0 = qs[2 * t2] * p; k0 = (1.f - f[2 * t2]) * __builtin_amdgcn_rcpf(fmaxf(p, 1e-30f));
                p *= f[2 * t2 + 1]; u1 = qs[2 * t2 + 1] * p; k1 = (1.f - f[2 * t2 + 1]) * __builtin_amdgcn_rcpf(fmaxf(p, 1e-30f));
                up[t2] = cvt_pk_bf16(u0, u1); qp[t2] = cvt_pk_bf16(u0 * EJ, u1 * EJ); wd[t2] = cvt_pk_bf16(k0, k1); }
            { LAS unsigned char* pu = U + d * US + J * 32; *(LAS u32x4*)pu = (u32x4){up[0], up[1], up[2], up[3]}; *(LAS u32x4*)(pu + 16) = (u32x4){up[4], up[5], up[6], up[7]};
              LAS unsigned char* pq = Qe + d * US + J * 32; *(LAS u32x4*)pq = (u32x4){qp[0], qp[1], qp[2], qp[3]}; *(LAS u32x4*)(pq + 16) = (u32x4){qp[4], qp[5], qp[6], qp[7]};
              LAS unsigned char* pw = Wm + d * WS + (base_J + 16 * J) * 2; *(LAS u32x4*)pw = (u32x4){wd[0], wd[1], wd[2], wd[3]}; *(LAS u32x4*)(pw + 16) = (u32x4){wd[4], wd[5], wd[6], wd[7]}; }
            float sfx = 1.f, ksv[16];
#pragma unroll
            for (int tt = 15; tt >= 0; --tt) { ksv[tt] = (1.f - f[tt]) * sfx; sfx *= f[tt]; }
            unsigned kep[8];
#pragma unroll
            for (int t2 = 0; t2 < 8; ++t2) kep[t2] = cvt_pk_bf16(ksv[2 * t2] * TJ, ksv[2 * t2 + 1] * TJ);
            *(LAS u32x4*)(KeT + d * TS + J * 32) = (u32x4){kep[0], kep[1], kep[2], kep[3]};
            *(LAS u32x4*)(KeT + d * TS + J * 32 + 16) = (u32x4){kep[4], kep[5], kep[6], kep[7]};
            if (J < 3) {
                const float m1 = (J == 0) ? G1 : G2, m2 = G1 * G2;
                unsigned w0[8], w1[8], w2[8];
#pragma unroll
                for (int t2 = 0; t2 < 8; ++t2) { w0[t2] = cvt_pk_bf16(ksv[2 * t2], ksv[2 * t2 + 1]); w1[t2] = cvt_pk_bf16(ksv[2 * t2] * m1, ksv[2 * t2 + 1] * m1); w2[t2] = cvt_pk_bf16(ksv[2 * t2] * m2, ksv[2 * t2 + 1] * m2); }
                const int s1 = (J == 0) ? 16 : (J == 1) ? 48 : 96;
                LAS unsigned char* p1 = Wm + d * WS + (s1 + 16 * J) * 2; *(LAS u32x4*)p1 = (u32x4){w0[0], w0[1], w0[2], w0[3]}; *(LAS u32x4*)(p1 + 16) = (u32x4){w0[4], w0[5], w0[6], w0[7]};
                if (J < 2) { const int s2 = (J == 0) ? 48 : 96; LAS unsigned char* p2 = Wm + d * WS + (s2 + 16 * J) * 2; *(LAS u32x4*)p2 = (u32x4){w1[0], w1[1], w1[2], w1[3]}; *(LAS u32x4*)(p2 + 16) = (u32x4){w1[4], w1[5], w1[6], w1[7]}; }
                if (J == 0) { LAS unsigned char* p3 = Wm + d * WS + 96 * 2; *(LAS u32x4*)p3 = (u32x4){w2[0], w2[1], w2[2], w2[3]}; *(LAS u32x4*)(p3 + 16) = (u32x4){w2[4], w2[5], w2[6], w2[7]}; }
            }
        }
        __syncthreads();
        if (c + 1 < 32) HG_LOAD(c + 1);
        __builtin_amdgcn_sched_barrier(0);
        for (int ti = w; ti < 10; ti += 8) {
            const int I = (ti == 0) ? 0 : (ti < 3) ? 1 : (ti < 6) ? 2 : 3; const int Jt = ti - ((I * (I + 1)) >> 1);
            const int bI = (I == 0) ? 0 : (I == 1) ? 16 : (I == 2) ? 48 : 96;
            f32x4 a = (f32x4){0.f, 0.f, 0.f, 0.f};
#pragma unroll
            for (int kk = 0; kk < 4; ++kk) { const LAS unsigned char* wb = Wm + (kk * 32 + g * 4 + (fr >> 2)) * WS + (bI + 16 * Jt + (fr & 3) * 4) * 2;
                const LAS unsigned char* ub = U + (kk * 32 + g * 4 + (fr >> 2)) * US + (16 * I + (fr & 3) * 4) * 2;
                const s16x4 xl = tr_read(wb), xh = tr_read(wb + 16 * WS), yl = tr_read(ub), yh = tr_read(ub + 16 * US);
                a = __builtin_amdgcn_mfma_f32_16x16x32_bf16(__builtin_shufflevector(xl, xh, 0, 1, 2, 3, 4, 5, 6, 7), __builtin_shufflevector(yl, yh, 0, 1, 2, 3, 4, 5, 6, 7), a, 0, 0, 0); }
            if (Jt == I) {
#pragma unroll
                for (int e = 0; e < 4; ++e) a[e] = (4 * g + e > fr) ? 0.f : a[e]; }
            u32x2 pk; pk.x = cvt_pk_bf16(a[0], a[1]); pk.y = cvt_pk_bf16(a[2], a[3]);
            *(LAS u32x2*)(Am + (16 * I + fr) * TS + (16 * Jt + 4 * g) * 2) = pk;
        }
        f32x4 o[4];
#pragma unroll
        for (int tt = 0; tt < 4; ++tt) o[tt] = (f32x4){0.f, 0.f, 0.f, 0.f};
#pragma unroll
        for (int kk = 0; kk < 4; ++kk) {
            u32x4 sw; sw.x = cvt_pk_bf16(st[2 * kk][0], st[2 * kk][1]); sw.y = cvt_pk_bf16(st[2 * kk][2], st[2 * kk][3]);
            sw.z = cvt_pk_bf16(st[2 * kk + 1][0], st[2 * kk + 1][1]); sw.w = cvt_pk_bf16(st[2 * kk + 1][2], st[2 * kk + 1][3]);
            const bf16x8 sx = __builtin_bit_cast(bf16x8, sw);
#pragma unroll
            for (int tt = 0; tt < 4; ++tt) { const LAS unsigned char* qb = Qe + (kk * 32 + g * 4 + (fr >> 2)) * US + (16 * tt + (fr & 3) * 4) * 2;
                const s16x4 lo = tr_read(qb), hi = tr_read(qb + 16 * US);
                o[tt] = __builtin_amdgcn_mfma_f32_16x16x32_bf16(sx, __builtin_shufflevector(lo, hi, 0, 1, 2, 3, 4, 5, 6, 7), o[tt], 0, 0, 0); }
        }
        __syncthreads();
        bf16x8 vfr[2];
#pragma unroll
        for (int kk = 0; kk < 2; ++kk) vfr[kk] = *(const LAS bf16x8*)(VT + (16 * w + fr) * TS + (kk * 32 + g * 8) * 2);
#pragma unroll
        for (int tt = 0; tt < 4; ++tt)
#pragma unroll
            for (int kk = 0; kk < 2; ++kk) if (kk <= (tt >> 1)) {
                const bf16x8 yf = *(const LAS bf16x8*)(Am + (16 * tt + fr) * TS + (kk * 32 + g * 8) * 2);
                o[tt] = __builtin_amdgcn_mfma_f32_16x16x32_bf16(vfr[kk], yf, o[tt], 0, 0, 0); }
#pragma unroll
        for (int dt = 0; dt < 8; ++dt) { const f32x4 dec = *(const LAS f32x4*)(DEC + 16 * dt + 4 * g); st[dt] *= dec;
#pragma unroll
            for (int kk = 0; kk < 2; ++kk) { const bf16x8 xf = *(const LAS bf16x8*)(KeT + (16 * dt + fr) * TS + (kk * 32 + g * 8) * 2);
                st[dt] = __builtin_amdgcn_mfma_f32_16x16x32_bf16(xf, vfr[kk], st[dt], 0, 0, 0); } }
#pragma unroll
        for (int tt = 0; tt < 4; ++tt) { float q2 = o[tt][0] * o[tt][0] + o[tt][1] * o[tt][1] + o[tt][2] * o[tt][2] + o[tt][3] * o[tt][3];
            q2 += __shfl_xor(q2, 16); q2 += __shfl_xor(q2, 32);
            if (g == 0) SS[w * 64 + 16 * tt + fr] = q2; }
        __syncthreads();
#pragma unroll
        for (int tt = 0; tt < 4; ++tt) { const int t = 16 * tt + fr; float tot = 0.f;
#pragma unroll
            for (int ww = 0; ww < 8; ++ww) tot += SS[ww * 64 + t];
            const float rstd = __builtin_amdgcn_rsqf(tot * (1.f / 128.f) + EPS);
            const size_t tok = (size_t)b * SEQ + tok0 + t; const int e0 = h * 128 + w * 16 + g * 4;
            const u32x2 gg = ggv[tt];
            const float y0 = o[tt][0] * rstd * ngv.x * siluf_(bf_lo(gg.x)), y1 = o[tt][1] * rstd * ngv.y * siluf_(bf_hi(gg.x));
            const float y2 = o[tt][2] * rstd * ngv.z * siluf_(bf_lo(gg.y)), y3 = o[tt][3] * rstd * ngv.w * siluf_(bf_hi(gg.y));
            u32x2 wv; wv.x = cvt_pk_bf16(y0, y1); wv.y = cvt_pk_bf16(y2, y3);
            *(GAS u32x2*)((GAS char*)Y + pg8::blk16x32(tok, 2048 + e0, YW)) = wv; }
    }
#undef HG_LOAD
}
#ifndef MK_MULTI
#define MK_MULTI 0
#endif
#ifndef PH_MASK
#define PH_MASK 0xFFFFF
#endif
#define HASP(p) (((PH_MASK) >> (p)) & 1)
#ifndef RES_MASTER_HALF
#define RES_MASTER_HALF 0
#endif
#ifndef DUP_MASK
#define DUP_MASK 0
#endif
#define DUPP(p) (((DUP_MASK) >> (p)) & 1)
constexpr int NPH_LAYER = 12, NPH = NL * NPH_LAYER + 1;
struct Args { const float* in[25]; float* out; unsigned char* ws; int ph_lo, ph_hi; };
enum { I_X = 0, I_MEM, I_NORM_MIX, I_W_IN, I_W_GATE, I_SINKS, I_SGU_LN_G, I_SGU_LN_B, I_SGU_W, I_SGU_B, I_HGRN_LB, I_HGRN_NORM, I_W_BR_A, I_W_BR_B, I_W_BR_C, I_W_OUT, I_NORM_X, I_MEM_NORM,
       I_W_XQ, I_W_XKV, I_W_XO, I_NORM_FFN, I_W_FFN_IN, I_W_FFN_OUT, I_FINAL_NORM };

#define CIN(i) ((const GAS float*)(((uintptr_t)(unsigned)__builtin_amdgcn_readfirstlane((int)lctl[17 + 2 * (i)]) << 32) | (uintptr_t)(unsigned)__builtin_amdgcn_readfirstlane((int)lctl[16 + 2 * (i)])))
__device__ __forceinline__ void conv_phase(volatile LAS unsigned* lctl, int l, GAS unsigned char* ws, LAS float* scr, int gw, int NGW, int lane) {
    constexpr int I_IN = 32 * 240, I_GT = 32 * 192, I_BR = 16 * 64, I_OUT = 32 * 64, I_XQ = 32 * 16, I_XO = 8 * 64, I_F1 = 32 * 352, I_F2 = 88 * 64;
    constexpr int NITEMS = I_IN + I_GT + 3 * I_BR + I_OUT + I_XQ + I_XO + I_F1 + I_F2;
    GAS bf16* cWcat = (GAS bf16*)(ws + WS_WCAT); GAS bf16* cWbr = (GAS bf16*)(ws + WS_WBR); GAS bf16* cWout = (GAS bf16*)(ws + WS_WOUT); GAS bf16* cWxq = (GAS bf16*)(ws + WS_WXQ); GAS bf16* cWxo = (GAS bf16*)(ws + WS_WXO);
    GAS bf16* cWf1 = (GAS bf16*)(ws + WS_WF1); GAS bf16* cWf2 = (GAS bf16*)(ws + WS_WF2);
    for (int it = gw; it < NITEMS; it += NGW) {
        int r = it;
        if (r < I_IN) { const int kb = r / 240, nb = r % 240; tr_item(CIN(I_W_IN) + (size_t)l * DM * INW, INW, cWcat, DM, 64 * kb, 32 * nb, 32 * nb, scr, lane, CIN(I_NORM_MIX) + l * DM); continue; } r -= I_IN;
        if (r < I_GT) { const int kb = r / 192, nb = r % 192; tr_item(CIN(I_W_GATE) + (size_t)l * DM * GW, GW, cWcat, DM, 64 * kb, 32 * nb, INW + 32 * nb, scr, lane, CIN(I_NORM_MIX) + l * DM); continue; } r -= I_GT;
        if (r < 3 * I_BR) { const int j = r / I_BR, q = r % I_BR, kb = q / 64, nb = q % 64;
            tr_item(CIN(I_W_BR_A + j) + (size_t)l * 1024 * DM, DM, cWbr + (size_t)j * DM * 1024, 1024, 64 * kb, 32 * nb, 32 * nb, scr, lane); continue; } r -= 3 * I_BR;
        if (r < I_OUT) { const int kb = r / 64, nb = r % 64; tr_item(CIN(I_W_OUT) + (size_t)l * DM * DM, DM, cWout, DM, 64 * kb, 32 * nb, 32 * nb, scr, lane); continue; } r -= I_OUT;
        if (r < I_XQ) { const int kb = r / 16, nb = r % 16; tr_item(CIN(I_W_XQ) + (size_t)l * DM * XD, XD, cWxq, DM, 64 * kb, 32 * nb, 32 * nb, scr, lane, CIN(I_NORM_X) + l * DM); continue; } r -= I_XQ;
        if (r < I_XO) { const int kb = r / 64, nb = r % 64; tr_item(CIN(I_W_XO) + (size_t)l * XD * DM, DM, cWxo, XD, 64 * kb, 32 * nb, 32 * nb, scr, lane); continue; } r -= I_XO;
        if (r < I_F1) { const int kb = r / 352, nb = r % 352; const int n0 = 32 * nb; const int cc = (n0 < DFF) ? n0 : n0 - DFF; const int drow = 256 * (cc >> 7) + (cc & 127) + ((n0 < DFF) ? 0 : 128);
            tr_item(CIN(I_W_FFN_IN) + (size_t)l * DM * 2 * DFF, 2 * DFF, cWf1, DM, 64 * kb, n0, drow, scr, lane, CIN(I_NORM_FFN) + l * DM); continue; } r -= I_F1;
        { const int kb = r / 64, nb = r % 64; tr_item(CIN(I_W_FFN_OUT) + (size_t)l * DFF * DM, DM, cWf2, DFF, 64 * kb, 32 * nb, 32 * nb, scr, lane); }
    }
    if (l == 0) {
        GAS bf16* cWxkv = (GAS bf16*)(ws + WS_WXKV);
        for (int it = gw; it < 4 * 1024; it += NGW) { const int ll = it >> 10, q = it & 1023, kb = q >> 5, nb = q & 31;
            tr_item(CIN(I_W_XKV) + (size_t)ll * DM * 1024, 1024, cWxkv, DM, 64 * kb, 32 * nb, ll * 1024 + 32 * nb, scr, lane); }
        norm_phase(CIN(I_MEM), CIN(I_MEM_NORM), (GAS bf16*)(ws + WS_MEMN), MT, gw, NGW, lane);
    }
}

__global__ void __launch_bounds__(NTHR, 2) fwd_kernel(Args a) {
    extern __shared__ __attribute__((aligned(16))) unsigned char lds_raw[];
    LAS unsigned char* lds = (LAS unsigned char*)lds_raw;
    volatile LAS unsigned* lctl = (volatile LAS unsigned*)(lds + LDSCTL_OFF);
    const int tid0 = threadIdx.x;
    const int G = gridDim.x, bx = blockIdx.x;
    unsigned* ctl0 = (unsigned*)(a.ws + WS_CTL);
    for (int u = tid0; u < (LDS_BYTES - LDSCTL_OFF) / 4; u += NTHR) lctl[u] = 0u;
    __syncthreads();
    if (tid0 < 25) { lctl[16 + 2 * tid0] = (unsigned)(uintptr_t)a.in[tid0]; lctl[17 + 2 * tid0] = (unsigned)((uintptr_t)a.in[tid0] >> 32); }
    if (tid0 == 0) { lctl[8] = (unsigned)(uintptr_t)a.ws; lctl[9] = (unsigned)((uintptr_t)a.ws >> 32); lctl[10] = (unsigned)(uintptr_t)a.out; lctl[11] = (unsigned)((uintptr_t)a.out >> 32); }
    __syncthreads();
    const int lo = a.ph_lo, hi = a.ph_hi;
    XcdBarrier bar; bar.bar = ctl0 + CW_BAR; bar.x = 0; bar.st = nullptr;
    if (hi - lo > 1) bar = xcd_barrier_post(ctl0 + CW_BAR, lctl);
#define IN(k) (lo <= (k) && (k) < hi)
#define SEAM(k) do { if (IN(k) && IN((k) + 1)) xcd_barrier(bar); } while (0)

#define OPQ_PTR(TY, w) ((TY)(((uintptr_t)(unsigned)__builtin_amdgcn_readfirstlane((int)lctl[(w) + 1]) << 32) | (uintptr_t)(unsigned)__builtin_amdgcn_readfirstlane((int)lctl[(w)])))
#define PH_BEGIN int tid = threadIdx.x; asm volatile("" : "+v"(tid)); \
        GAS unsigned char* ws = OPQ_PTR(GAS unsigned char*, 8); GAS float* out = OPQ_PTR(GAS float*, 10); const int lane = tid & 63, wave = __builtin_amdgcn_readfirstlane(tid >> 6); const int gw = bx * NWAVES + wave, NGW = G * NWAVES; \
        (void)ws; (void)out; (void)lane; (void)gw; (void)NGW;
#define WSP(off) ((GAS bf16*)(ws + (off)))
#ifdef PROBE_TIMING
#define PROBE_MARK(p) do { if (threadIdx.x == 0) lctl[99] = ((p) == PROBE_PHASE && l == 1) ? 1u : 0u; __syncthreads(); } while (0)
#else
#define PROBE_MARK(p) do {} while (0)
#endif
#define GIN(i) OPQ_PTR(const GAS float*, 16 + 2 * (i))
    for (int l = 0; l < NL; ++l) {
        const int pb = l * NPH_LAYER;
        if (HASP(0) && IN(pb + 0)) for (int rep = 0; rep <= DUPP(0); ++rep) { if (rep) xcd_barrier(bar); PH_BEGIN
            conv_phase(lctl, l, ws, (LAS float*)(lds + wave * 16384), gw, NGW, lane);
            if (l == 0) xb_phase(GIN(I_X), WSP(WS_H), RES_MASTER_HALF ? (GAS unsigned short*)out : (GAS unsigned short*)nullptr, (GAS float*)(ws + WS_SS), gw, NGW, lane);
        }
        SEAM(pb + 0);
        if (HASP(1) && IN(pb + 1)) for (int rep = 0; rep <= DUPP(1); ++rep) { if (rep) xcd_barrier(bar); PH_BEGIN PROBE_MARK(1);
            { pg8::PlainOrder S; S.init(T, NCAT, G, bx, WSP(WS_H), DM, WSP(WS_WCAT), DM); EpiCat E{ws + WS_PROJ, WSP(WS_GATE), RowScale{(const GAS float*)(ws + WS_SS), (LAS float*)(lds + LDS_RSTD)}};
              pg8::gemm_phase(lds, pg8::GemmK{DM, DM, DM, 1}, S, E); }
            if (l == 0) { pg8::PlainOrder S; S.init(MT, 4096, G, bx, WSP(WS_MEMN), DM, WSP(WS_WXKV), DM); EpiPlain<false> E{WSP(WS_KV), 4096, RowScale{nullptr, nullptr}};
              pg8::gemm_phase(lds, pg8::GemmK{DM, DM, DM, 0}, S, E); }
        }
        SEAM(pb + 1);
        if (HASP(2) && IN(pb + 2)) for (int rep = 0; rep <= DUPP(2); ++rep) { if (rep) xcd_barrier(bar);
            for (int r2 = 0; r2 <= DUPP(16); ++r2) { PH_BEGIN unsigned* q = (unsigned*)(a.ws + WS_CTL) + CW_Q + 256 * l + 16 * rep + 8 * r2;
              for (;;) { __syncthreads(); if (tid == 0) lctl[4] = xb_add(q, 1u); __syncthreads(); const int idx = (int)lctl[4]; if (idx >= NB * 8) break;
                hgrn_unit(idx, l, WSP(WS_PROJ + PJ_HB), GIN(I_HGRN_LB), GIN(I_HGRN_NORM) + l * 128, WSP(WS_Y), lds, tid); } }
            for (int r2 = 0; r2 <= DUPP(17); ++r2) { PH_BEGIN unsigned* q = (unsigned*)(a.ws + WS_CTL) + CW_Q + 256 * l + 16 * rep + 8 * r2;
              swa_loop(q + 64, lctl, WSP(WS_PROJ), GIN(I_SINKS) + l * 16, WSP(WS_Y), lds, tid); }
            for (int r2 = 0; r2 <= DUPP(18); ++r2) { PH_BEGIN unsigned* q = (unsigned*)(a.ws + WS_CTL) + CW_Q + 256 * l + 16 * rep + 8 * r2;
              for (;;) { __syncthreads(); if (tid == 0) lctl[4] = xb_add(q + 128, 1u); __syncthreads(); const int idx = (int)lctl[4]; if (idx >= NB * 16) break;
                sgu_unit(idx, WSP(WS_PROJ + PJ_UB), WSP(WS_PROJ + PJ_VB), GIN(I_SGU_LN_G) + l * 1024, GIN(I_SGU_LN_B) + l * 1024, GIN(I_SGU_W) + (size_t)l * 8 * 16384, GIN(I_SGU_B) + l * 1024, WSP(WS_Y), lds, tid); } }
            __syncthreads();
        }
        SEAM(pb + 2);
        if (HASP(3) && IN(pb + 3)) for (int rep = 0; rep <= DUPP(3); ++rep) { if (rep) xcd_barrier(bar); PH_BEGIN PROBE_MARK(3);
            pg8::PlainOrder S; S.init(T, DM, G, bx, WSP(WS_Y), YW, WSP(WS_WBR), 1024, 3, (size_t)32 * 1024, (size_t)DM * 1024 * 2);
            EpiBranch E{WSP(WS_GATE), WSP(WS_PROJ)};
            pg8::gemm_phase(lds, pg8::GemmK{1024, YW, 1024, 1}, S, E);
        }
        SEAM(pb + 3);
        if (HASP(4) && IN(pb + 4)) for (int rep = 0; rep <= DUPP(4); ++rep) { if (rep) xcd_barrier(bar); PH_BEGIN PROBE_MARK(4);
            pg8::PlainOrder S; S.init(T, DM, G, bx, WSP(WS_PROJ), DM, WSP(WS_WOUT), DM); EpiResid E{WSP(WS_H), rep ? WSP(WS_GATE) : WSP(WS_H), rep ? (GAS float*)nullptr : (GAS float*)(ws + WS_SS), (LAS float*)(lds + LDS_RED), (RES_MASTER_HALF && !rep) ? (GAS unsigned short*)out : (GAS unsigned short*)nullptr};
            pg8::gemm_phase(lds, pg8::GemmK{DM, DM, DM, 1}, S, E);
        }
        SEAM(pb + 4);
        if (HASP(6) && IN(pb + 6)) for (int rep = 0; rep <= DUPP(6); ++rep) { if (rep) xcd_barrier(bar); PH_BEGIN PROBE_MARK(6);
            pg8::PlainOrder S; S.init(T, XD, G, bx, WSP(WS_H), DM, WSP(WS_WXQ), DM); EpiPlain<true> E{WSP(WS_Y), XD, RowScale{(const GAS float*)(ws + WS_SS), (LAS float*)(lds + LDS_RSTD)}};
            pg8::gemm_phase(lds, pg8::GemmK{DM, DM, DM, 1}, S, E);
        }
        SEAM(pb + 6);
        if (HASP(7) && IN(pb + 7)) for (int rep = 0; rep <= DUPP(7); ++rep) { if (rep) xcd_barrier(bar); PH_BEGIN for (int u = 2 * bx, up = -1; u < NB * 32; u += (u & 1) ? 2 * G - 1 : 1) { xattn_unit(u, l, WSP(WS_KV), WSP(WS_Y), WSP(WS_Y + 32 * MiB), lds, tid, (u >> 3) != up); up = u >> 3; } __syncthreads(); }
        SEAM(pb + 7);
        if (HASP(8) && IN(pb + 8)) for (int rep = 0; rep <= DUPP(8); ++rep) { if (rep) xcd_barrier(bar); PH_BEGIN PROBE_MARK(8);
            pg8::PlainOrder S; S.init(T, DM, G, bx, WSP(WS_Y + 32 * MiB), XD, WSP(WS_WXO), XD); EpiResid E{WSP(WS_H), rep ? WSP(WS_GATE) : WSP(WS_H), rep ? (GAS float*)nullptr : (GAS float*)(ws + WS_SS), (LAS float*)(lds + LDS_RED), (RES_MASTER_HALF && !rep) ? (GAS unsigned short*)out : (GAS unsigned short*)nullptr};
            pg8::gemm_phase(lds, pg8::GemmK{XD, XD, XD, 1}, S, E);
        }
        SEAM(pb + 8);
        if (HASP(10) && IN(pb + 10)) for (int rep = 0; rep <= DUPP(10); ++rep) { if (rep) xcd_barrier(bar); PH_BEGIN PROBE_MARK(10);
            pg8::PlainOrder S; S.init(T, 2 * DFF, G, bx, WSP(WS_H), DM, WSP(WS_WF1), DM); EpiSwiglu E{WSP(WS_PROJ), RowScale{(const GAS float*)(ws + WS_SS), (LAS float*)(lds + LDS_RSTD)}};
            pg8::gemm_phase(lds, pg8::GemmK{DM, DM, DM, 1}, S, E);
        }
        SEAM(pb + 10);
        if (HASP(11) && IN(pb + 11)) for (int rep = 0; rep <= DUPP(11); ++rep) { if (rep) xcd_barrier(bar); PH_BEGIN PROBE_MARK(11);
            pg8::PlainOrder S; S.init(T, DM, G, bx, WSP(WS_PROJ), DFF, WSP(WS_WF2), DFF); EpiResid E{WSP(WS_H), rep ? WSP(WS_GATE) : WSP(WS_H), rep ? (GAS float*)nullptr : (GAS float*)(ws + WS_SS), (LAS float*)(lds + LDS_RED), (RES_MASTER_HALF && !rep) ? (GAS unsigned short*)out : (GAS unsigned short*)nullptr};
            pg8::gemm_phase(lds, pg8::GemmK{DFF, DFF, DFF, 1}, S, E);
        }
        SEAM(pb + 11);
    }
    if (HASP(12) && IN(NPH - 1)) { int tq = tid0; asm volatile("" : "+v"(tq)); const int lane = tq & 63, wave = __builtin_amdgcn_readfirstlane(tq >> 6); final_norm_phase((const GAS unsigned short*)(a.ws + WS_H), (GAS float*)a.out, GIN(I_FINAL_NORM), (const GAS float*)(a.ws + WS_SS), bx * NWAVES + wave, G * NWAVES, lane); }
#ifdef PROBE_TIMING
    if (bx == 0 && tid0 == 0) { asm volatile("s_waitcnt vmcnt(0)" ::: "memory"); a.out[0] = (float)lctl[100 + PROBE_WHAT]; }
#endif
#undef IN
#undef SEAM
#undef PH_BEGIN
#undef OPQ_PTR
#undef WSP
#undef GIN
}

extern "C" void kernel_launch(void* const* d_in, const int* in_sizes, int n_in, void* d_out, int out_size, void* d_ws, size_t ws_size, hipStream_t stream) {
    static int grid = 0;
    if (grid == 0) {
        if (n_in != 25 || out_size != T * DM || ws_size < WS_END) { fprintf(stderr, "kernel_launch: unexpected shapes (n_in %d, out %d, ws %zu, need %zu)\n", n_in, out_size, ws_size, (size_t)WS_END); grid = -1; return; }
        int dev = 0, cus = 0, per_cu = 0;
        if (hipGetDevice(&dev) != hipSuccess || hipDeviceGetAttribute(&cus, hipDeviceAttributeMultiprocessorCount, dev) != hipSuccess) { grid = -1; return; }
        if (hipFuncSetAttribute((const void*)fwd_kernel, hipFuncAttributeMaxDynamicSharedMemorySize, LDS_BYTES) != hipSuccess) { fprintf(stderr, "kernel_launch: hipFuncSetAttribute failed\n"); grid = -1; return; }
        if (hipOccupancyMaxActiveBlocksPerMultiprocessor(&per_cu, (const void*)fwd_kernel, NTHR, LDS_BYTES) != hipSuccess || per_cu < 1)
            fprintf(stderr, "kernel_launch: occupancy query reports %d workgroups per CU\n", per_cu);
        (void)hipGetLastError();
        grid = cus;
    }
    if (grid < 0) return;
    if (hipMemsetAsync((char*)d_ws + WS_CTL, 0, CTL_ZERO_BYTES, stream) != hipSuccess) return;
    Args a{};
    for (int i = 0; i < 25; ++i) a.in[i] = (const float*)d_in[i];
    a.out = (float*)d_out; a.ws = (unsigned char*)d_ws;
#if MK_MULTI
    for (int p = 0; p < NPH; ++p) { a.ph_lo = p; a.ph_hi = p + 1; hipLaunchKernelGGL(fwd_kernel, dim3(grid), dim3(NTHR), LDS_BYTES, stream, a); }
#else
    a.ph_lo = 0; a.ph_hi = NPH;
    hipLaunchKernelGGL(fwd_kernel, dim3(grid), dim3(NTHR), LDS_BYTES, stream, a);
#endif
}
```
